# Optimizing an MI355X kernel written in HIP

```python
import math
import jax, jax.numpy as jnp
from jax import lax
import numpy as np

D_MODEL = 1024
BATCH = 4
SEQ = 4096
DEPTH = 2

HEAD_DIM = 64
SSM_HEADS = 16
SSM_HEAD_DIM = HEAD_DIM
SSM_D_INNER = SSM_HEADS * SSM_HEAD_DIM
SSM_GROUPS = 2
SSM_HEADS_PER_GROUP = SSM_HEADS // SSM_GROUPS
SSM_STATE = 128
SSM_CONV = 4
SSM_CHUNK = 128
SSM_CONV_DIM = SSM_D_INNER + 2 * SSM_GROUPS * SSM_STATE
SB_HEADS = 8
SB_WIDTH = SB_HEADS * HEAD_DIM
DIFF_HEADS = 4
DIFF_QK_DIM = HEAD_DIM
DIFF_V_DIM = 2 * HEAD_DIM
DIFF_QK_WIDTH = DIFF_HEADS * 2 * DIFF_QK_DIM
DIFF_WIDTH = DIFF_HEADS * DIFF_V_DIM
MIX_WIDTH = SSM_D_INNER + SB_WIDTH + DIFF_WIDTH
IN_SPLITS = (SSM_D_INNER, SSM_CONV_DIM, SSM_HEADS,
             SB_WIDTH, SB_WIDTH, SB_WIDTH,
             DIFF_QK_WIDTH, DIFF_QK_WIDTH, DIFF_WIDTH)
IN_DIM = sum(IN_SPLITS)
D_FF = 2816
FFN_HALF = 0.5
N_REL_BUCKETS = 32
REL_MAX_DIST = 128
Q_BLOCK = 128
N_MOD = 9
EPS = 1e-6

kernel_name = "hybrid_ssd_stickbreak_diffattn_macaron_block"


def _rmsnorm(x, g):
    xf = x.astype(jnp.float32)
    y = xf * lax.rsqrt(jnp.mean(xf * xf, axis=-1, keepdims=True) + EPS)
    return (y * g.astype(jnp.float32)).astype(x.dtype)


def _modulate(h, shift, scale):
    return h * (1 + scale[:, None, :]) + shift[:, None, :]


def _swiglu(h, w13, w2):
    a, u = jnp.split(h @ w13, 2, axis=-1)
    return (jax.nn.silu(a) * u) @ w2


def _causal_depthwise_conv(u, w, b):
    k = w.shape[-1]
    rhs = jnp.transpose(w)[:, None, :].astype(u.dtype)
    out = lax.conv_general_dilated(u, rhs, window_strides=(1,), padding=[(k - 1, 0)],
                                   dimension_numbers=("NWC", "WIO", "NWC"),
                                   feature_group_count=u.shape[-1])
    return out + b.astype(u.dtype)


def _t5_bucket(dist):
    max_exact = N_REL_BUCKETS // 2
    d = jnp.maximum(dist.astype(jnp.float32), float(max_exact))
    large = max_exact + (jnp.log(d / max_exact) / math.log(REL_MAX_DIST / max_exact)
                         * (N_REL_BUCKETS - max_exact)).astype(jnp.int32)
    large = jnp.minimum(large, N_REL_BUCKETS - 1)
    return jnp.where(dist < max_exact, dist, large)


def _sweep_query_blocks(fn, seq):
    starts = jnp.arange(seq // Q_BLOCK, dtype=jnp.int32) * Q_BLOCK
    out = lax.map(fn, starts)
    nb, b, qb = out.shape[:3]
    return jnp.moveaxis(out, 0, 1).reshape((b, nb * qb) + out.shape[3:])


def _ssd_mixer(z, xbc, dt_raw, conv_w, conv_b, dt_bias, a_log, d_skip, norm_g):
    f32 = jnp.float32
    b, s, _ = z.shape
    nc = s // SSM_CHUNK
    xbc = jax.nn.silu(_causal_depthwise_conv(xbc, conv_w, conv_b))
    xs, bm, cm = jnp.split(xbc, [SSM_D_INNER, SSM_D_INNER + SSM_GROUPS * SSM_STATE], axis=-1)
    dt = jax.nn.softplus(dt_raw.astype(f32) + dt_bias.astype(f32))
    a = -jnp.exp(a_log.astype(f32))
    xh = xs.astype(f32).reshape(b, s, SSM_HEADS, SSM_HEAD_DIM)
    xd = (xh * dt[..., None]).reshape(b, nc, SSM_CHUNK, SSM_GROUPS, SSM_HEADS_PER_GROUP, SSM_HEAD_DIM)
    bc = bm.astype(f32).reshape(b, nc, SSM_CHUNK, SSM_GROUPS, SSM_STATE)
    cc = cm.astype(f32).reshape(b, nc, SSM_CHUNK, SSM_GROUPS, SSM_STATE)
    da = (dt * a).reshape(b, nc, SSM_CHUNK, SSM_GROUPS, SSM_HEADS_PER_GROUP)
    da = jnp.transpose(da, (0, 3, 4, 1, 2))
    a_cum = jnp.cumsum(da, axis=-1)
    causal = jnp.tril(jnp.ones((SSM_CHUNK, SSM_CHUNK), dtype=bool))
    seg = a_cum[..., :, None] - a_cum[..., None, :]
    decay = jnp.exp(jnp.where(causal, seg, -jnp.inf))
    cb = jnp.einsum("bclgn,bcsgn->bgcls", cc, bc)
    y_diag = jnp.einsum("bgecls,bcsgep->bclgep", cb[:, :, None] * decay, xd)
    decay_to_end = jnp.exp(a_cum[..., -1:] - a_cum)
    chunk_states = jnp.einsum("bclgn,bgecl,bclgep->bcgepn", bc, decay_to_end, xd)
    chunk_decay = jnp.exp(a_cum[..., -1])

    def carry_state(h, inp):
        st, dec = inp
        return h * dec[..., None, None] + st, h

    h0 = jnp.zeros_like(chunk_states[:, 0])
    _, prev = lax.scan(carry_state, h0,
                       (jnp.moveaxis(chunk_states, 1, 0), jnp.moveaxis(chunk_decay, -1, 0)))
    prev = jnp.moveaxis(prev, 0, 1)
    y_off = jnp.einsum("bclgn,bcgepn,bgecl->bclgep", cc, prev, jnp.exp(a_cum))
    y = (y_diag + y_off).reshape(b, s, SSM_HEADS, SSM_HEAD_DIM) + d_skip.astype(f32)[:, None] * xh
    y = y.reshape(b, s, SSM_D_INNER) * jax.nn.silu(z.astype(f32))
    yg = y.reshape(b, s, SSM_GROUPS, SSM_D_INNER // SSM_GROUPS)
    yg = yg * lax.rsqrt(jnp.mean(yg * yg, axis=-1, keepdims=True) + EPS)
    return (yg.reshape(b, s, SSM_D_INNER) * norm_g.astype(f32)).astype(z.dtype)


def _stick_breaking_attention(q, k, v):
    b, s, h, d = q.shape
    scale = d ** -0.5
    kpos = jnp.arange(s, dtype=jnp.int32)

    def block(start):
        qb = lax.dynamic_slice_in_dim(q, start, Q_BLOCK, axis=1)
        qpos = start + jnp.arange(Q_BLOCK, dtype=jnp.int32)
        strict = kpos[None, :] < qpos[:, None]
        logits = jnp.einsum("bqhd,bkhd->bhqk", qb, k).astype(jnp.float32) * scale
        log_1m_beta = jnp.where(strict, jax.nn.log_sigmoid(-logits), 0.0)
        log_stick = lax.cumsum(log_1m_beta, axis=3, reverse=True) - log_1m_beta
        weights = jnp.where(strict, jnp.exp(jax.nn.log_sigmoid(logits) + log_stick), 0.0)
        return jnp.einsum("bhqk,bkhd->bqhd", weights.astype(v.dtype), v)

    return _sweep_query_blocks(block, s).reshape(b, s, h * d)


def _diff_attention(q, k, v, rel_bias, lam, lambda_init, subln_g):
    b, s, h, _, dk = q.shape
    scale = dk ** -0.5
    kpos = jnp.arange(s, dtype=jnp.int32)

    def block(start):
        qb = lax.dynamic_slice_in_dim(q, start, Q_BLOCK, axis=1)
        qpos = start + jnp.arange(Q_BLOCK, dtype=jnp.int32)
        causal = kpos[None, :] <= qpos[:, None]
        bucket = _t5_bucket(jnp.maximum(qpos[:, None] - kpos[None, :], 0))
        bias = jnp.transpose(rel_bias[bucket], (2, 0, 1)).astype(jnp.float32)
        logits = jnp.einsum("bqhmd,bkhmd->bmhqk", qb, k).astype(jnp.float32) * scale + bias
        p = jax.nn.softmax(jnp.where(causal, logits, -jnp.inf), axis=-1)
        attn = p[:, 0] - lam * p[:, 1]
        return jnp.einsum("bhqk,bkhe->bqhe", attn.astype(v.dtype), v)

    o = _sweep_query_blocks(block, s)
    o = _rmsnorm(o, subln_g) * (1.0 - lambda_init)
    return o.reshape(b, s, h * DIFF_V_DIM)


def _hybrid_mixer(h, w_in, conv_w, conv_b, dt_bias, a_log, d_skip, ssm_norm,
                  lq1, lk1, lq2, lk2, subln_g, rel_bias, w_out, lambda_init):
    b, s, _ = h.shape
    offsets = [int(o) for o in np.cumsum(IN_SPLITS)[:-1]]
    z, xbc, dt_raw, sq, sk, sv, dq, dkk, dv = jnp.split(h @ w_in, offsets, axis=-1)
    y_ssm = _ssd_mixer(z, xbc, dt_raw, conv_w, conv_b, dt_bias, a_log, d_skip, ssm_norm)
    y_sb = _stick_breaking_attention(sq.reshape(b, s, SB_HEADS, HEAD_DIM),
                                     sk.reshape(b, s, SB_HEADS, HEAD_DIM),
                                     sv.reshape(b, s, SB_HEADS, HEAD_DIM))
    lam = (jnp.exp(jnp.sum(lq1.astype(jnp.float32) * lk1.astype(jnp.float32)))
           - jnp.exp(jnp.sum(lq2.astype(jnp.float32) * lk2.astype(jnp.float32))) + lambda_init)
    y_diff = _diff_attention(dq.reshape(b, s, DIFF_HEADS, 2, DIFF_QK_DIM),
                             dkk.reshape(b, s, DIFF_HEADS, 2, DIFF_QK_DIM),
                             dv.reshape(b, s, DIFF_HEADS, DIFF_V_DIM),
                             rel_bias, lam, lambda_init, subln_g)
    y = jnp.concatenate([y_ssm.astype(h.dtype), y_sb.astype(h.dtype), y_diff.astype(h.dtype)], axis=-1)
    return y @ w_out


def setup_inputs(seed: int = 0) -> dict:
    key = jax.random.key(seed)
    ks = jax.random.split(key, 32)
    f32 = jnp.float32

    def nrm(k, shape, scale):
        return jax.random.normal(k, shape, f32) * scale

    def gain(k, shape):
        return 1.0 + 0.01 * jax.random.normal(k, shape, f32)

    gate_rows = jnp.zeros((N_MOD, D_MODEL), f32).at[2::3].set(1.0).reshape(-1)
    dt = jnp.exp(jax.random.uniform(ks[9], (DEPTH, SSM_HEADS), f32)
                 * (math.log(0.1) - math.log(0.001)) + math.log(0.001))
    dt = jnp.maximum(dt, 1e-4)
    return {
        "x": jax.random.normal(ks[0], (BATCH, SEQ, D_MODEL), f32),
        "c": jax.random.normal(ks[1], (BATCH, D_MODEL), f32),
        "ada_w": nrm(ks[2], (DEPTH, D_MODEL, N_MOD * D_MODEL), 0.1 * D_MODEL ** -0.5),
        "ada_b": 0.01 * jax.random.normal(ks[3], (DEPTH, N_MOD * D_MODEL), f32) + gate_rows,
        "ffn1_norm": gain(ks[4], (DEPTH, D_MODEL)),
        "ffn1_w13": nrm(ks[5], (DEPTH, D_MODEL, 2 * D_FF), D_MODEL ** -0.5),
        "ffn1_w2": nrm(ks[6], (DEPTH, D_FF, D_MODEL), D_FF ** -0.5),
        "mix_norm": gain(ks[7], (DEPTH, D_MODEL)),
        "w_in": nrm(ks[8], (DEPTH, D_MODEL, IN_DIM), D_MODEL ** -0.5),
        "ssm_conv_w": nrm(ks[10], (DEPTH, SSM_CONV_DIM, SSM_CONV), SSM_CONV ** -0.5),
        "ssm_conv_b": nrm(ks[11], (DEPTH, SSM_CONV_DIM), 0.01),
        "ssm_dt_bias": dt + jnp.log(-jnp.expm1(-dt)),
        "ssm_a_log": jnp.log(jax.random.uniform(ks[12], (DEPTH, SSM_HEADS), f32, 1.0, 16.0)),
        "ssm_d": gain(ks[13], (DEPTH, SSM_HEADS)),
        "ssm_norm": gain(ks[14], (DEPTH, SSM_D_INNER)),
        "diff_lambda_q1": nrm(ks[15], (DEPTH, DIFF_QK_DIM), 0.1),
        "diff_lambda_k1": nrm(ks[16], (DEPTH, DIFF_QK_DIM), 0.1),
        "diff_lambda_q2": nrm(ks[17], (DEPTH, DIFF_QK_DIM), 0.1),
        "diff_lambda_k2": nrm(ks[18], (DEPTH, DIFF_QK_DIM), 0.1),
        "diff_subln": gain(ks[19], (DEPTH, DIFF_V_DIM)),
        "rel_bias": nrm(ks[20], (N_REL_BUCKETS, DIFF_HEADS), 0.5),
        "w_out": nrm(ks[21], (DEPTH, MIX_WIDTH, D_MODEL), MIX_WIDTH ** -0.5),
        "ffn2_norm": gain(ks[22], (DEPTH, D_MODEL)),
        "ffn2_w13": nrm(ks[23], (DEPTH, D_MODEL, 2 * D_FF), D_MODEL ** -0.5),
        "ffn2_w2": nrm(ks[24], (DEPTH, D_FF, D_MODEL), D_FF ** -0.5),
        "final_norm": gain(ks[25], (D_MODEL,)),
    }


def reference(x, c, ada_w, ada_b, ffn1_norm, ffn1_w13, ffn1_w2, mix_norm, w_in,
              ssm_conv_w, ssm_conv_b, ssm_dt_bias, ssm_a_log, ssm_d, ssm_norm,
              diff_lambda_q1, diff_lambda_k1, diff_lambda_q2, diff_lambda_k2, diff_subln,
              rel_bias, w_out, ffn2_norm, ffn2_w13, ffn2_w2, final_norm):
    b = x.shape[0]
    cond = jax.nn.silu(c)
    for l in range(DEPTH):
        mod = (cond @ ada_w[l] + ada_b[l]).reshape(b, N_MOD, D_MODEL)
        h = _modulate(_rmsnorm(x, ffn1_norm[l]), mod[:, 0], mod[:, 1])
        x = x + FFN_HALF * mod[:, 2][:, None, :] * _swiglu(h, ffn1_w13[l], ffn1_w2[l])
        lambda_init = 0.8 - 0.6 * math.exp(-0.3 * l)
        h = _modulate(_rmsnorm(x, mix_norm[l]), mod[:, 3], mod[:, 4])
        y = _hybrid_mixer(h, w_in[l], ssm_conv_w[l], ssm_conv_b[l], ssm_dt_bias[l], ssm_a_log[l],
                          ssm_d[l], ssm_norm[l], diff_lambda_q1[l], diff_lambda_k1[l],
                          diff_lambda_q2[l], diff_lambda_k2[l], diff_subln[l], rel_bias,
                          w_out[l], lambda_init)
        x = x + mod[:, 5][:, None, :] * y
        h = _modulate(_rmsnorm(x, ffn2_norm[l]), mod[:, 6], mod[:, 7])
        x = x + FFN_HALF * mod[:, 8][:, None, :] * _swiglu(h, ffn2_w13[l], ffn2_w2[l])
    return _rmsnorm(x, final_norm)
```

```cpp
#include <hip/hip_runtime.h>
#include <cstdio>
#include <cstdint>

#define DEV __device__ __forceinline__
#define LAS __attribute__((address_space(3)))
typedef unsigned short bf16_t;
typedef unsigned u32x4 __attribute__((ext_vector_type(4)));
typedef unsigned u32x2 __attribute__((ext_vector_type(2)));
typedef float f32x4 __attribute__((ext_vector_type(4)));

constexpr int D = 1024, NB = 4, S = 4096, M = NB * S, NL = 2, DFF = 2816, MODW = 9 * D;
constexpr int PW = 5632, NIN = 5888;
constexpr int PZ = 0, PSQ = 1024, PDQ = 1536, PSK = 2048, PSV = 2560, PDK = 3072, PDV = 3584, PXBC = 4096;
constexpr int PXS = PXBC, PBM = PXBC + 1024, PCM = PXBC + 1280;
constexpr int CH = 128, NCHUNK = S / CH, GCH = NB * NCHUNK;
constexpr float EPS = 1e-6f;
constexpr int NTHREADS = 512, NWAVES = 8;

constexpr size_t KiB = 1024, MiB = 1024 * 1024;
constexpr size_t WS_BAR = 0;
constexpr size_t WS_MOD = 64 * KiB;
constexpr size_t WS_ROWSS = 352 * KiB;
constexpr size_t WS_CD = 480 * KiB;
constexpr size_t WS_MISC = 488 * KiB;
constexpr size_t WS_HALO = 512 * KiB;
constexpr size_t WS_WT = 2 * MiB;
constexpr size_t WT_13A = 0, WT_2A = 11 * MiB, WT_IN = 16 * MiB + 512 * KiB, WT_OUT = 28 * MiB, WT_13B = 32 * MiB, WT_2B = 43 * MiB;
constexpr size_t WS_XN = 51 * MiB;
constexpr size_t WS_ST = 51 * MiB;
constexpr size_t WS_P = 115 * MiB;
constexpr size_t WS_H = WS_P;
constexpr size_t WS_DT = 291 * MiB;
constexpr size_t WS_END = 292 * MiB;

struct Params { const float* in[26]; float* out; unsigned char* ws; };
enum { I_X = 0, I_C, I_ADAW, I_ADAB, I_N1, I_W13A, I_W2A, I_NM, I_WIN, I_CW, I_CB, I_DTB, I_ALOG, I_SD, I_SN, I_LQ1, I_LK1, I_LQ2, I_LK2, I_SUB, I_RB, I_WOUT, I_N2, I_W13B, I_W2B, I_FN };

DEV float bf2f(bf16_t v) { return __uint_as_float(((unsigned)v) << 16); }
DEV float bflo(unsigned w) { return __uint_as_float(w << 16); }
DEV float bfhi(unsigned w) { return __uint_as_float(w & 0xffff0000u); }
DEV unsigned f2bf(float f) { unsigned u = __float_as_uint(f); return (u + 0x7fffu + ((u >> 16) & 1u)) >> 16; }
DEV unsigned pk2(float lo, float hi) { return f2bf(lo) | (f2bf(hi) << 16); }
DEV float siluf(float x) { return x / (1.f + __expf(-x)); }
DEV float softplusf(float x) { return fmaxf(x, 0.f) + log1pf(__expf(-fabsf(x))); }
DEV float wave_sum(float v) {
#pragma unroll
    for (int o = 1; o < 64; o <<= 1) v += __shfl_xor(v, o);
    return v;
}
DEV float wave_max(float v) {
#pragma unroll
    for (int o = 1; o < 64; o <<= 1) v = fmaxf(v, __shfl_xor(v, o));
    return v;
}
DEV float wave_incl_scan(float v, int lane) {
#pragma unroll
    for (int o = 1; o < 64; o <<= 1) { float t = __shfl_up(v, o); if (lane >= o) v += t; }
    return v;
}
#define LDS_WAIT() asm volatile("s_waitcnt lgkmcnt(0)" ::: "memory")

DEV void transpose_item(const float* W, int K, int N, bf16_t* WT, int dst_n0, int src_n0, int nvalid, int k0, LAS float* scr, int lane) {
    const int c = lane & 31;
#pragma unroll 8
    for (int i = 0; i < 32; ++i) { const int kk = 2 * i + (lane >> 5); scr[kk * 33 + c] = (c < nvalid) ? W[(size_t)(k0 + kk) * N + src_n0 + c] : 0.f; }
    LDS_WAIT();
    const int c8 = lane & 7;
#pragma unroll
    for (int j = 0; j < 4; ++j) { const int n = (lane >> 3) + 8 * j; const LAS float* s = scr + (8 * c8) * 33 + n;
        u32x4 o; o.x = pk2(s[0 * 33], s[1 * 33]); o.y = pk2(s[2 * 33], s[3 * 33]); o.z = pk2(s[4 * 33], s[5 * 33]); o.w = pk2(s[6 * 33], s[7 * 33]);
        *(u32x4*)(WT + (size_t)(dst_n0 + n) * K + k0 + 8 * c8) = o; }
    LDS_WAIT();
}
DEV void src_map_swiglu(int n0, int& src, int& nv) { const int pn = n0 >> 8, bj = (n0 >> 7) & 1, i0 = n0 & 127; src = bj * DFF + pn * 128 + i0; nv = 32; }
DEV void src_map_in(int n0, int& src, int& nv) {
    nv = 32;
    if (n0 < 1024) src = n0;
    else if (n0 < 1536) src = 2576 + (n0 - 1024);
    else if (n0 < 2048) src = 4112 + (n0 - 1536);
    else if (n0 < 2560) src = 3088 + (n0 - 2048);
    else if (n0 < 3072) src = 3600 + (n0 - 2560);
    else if (n0 < 3584) src = 4624 + (n0 - 3072);
    else if (n0 < 4096) src = 5136 + (n0 - 3584);
    else if (n0 < 5632) src = 1024 + (n0 - 4096);
    else if (n0 == 5632) { src = 2560; nv = 16; }
    else { src = 0; nv = 0; }
}
DEV void ph_convert(const Params& p, int l, LAS unsigned char* lds, int gw, int ngw, int wave, int lane) {
    LAS float* scr = (LAS float*)(lds + wave * 16384);
    bf16_t* wt = (bf16_t*)(p.ws + WS_WT);
    constexpr int I13 = 16 * 176, I2 = 44 * 32, IIN = 16 * 184, IOUT = 32 * 32;
    constexpr int NITEMS = 2 * I13 + 2 * I2 + IIN + IOUT;
    for (int it = gw; it < NITEMS; it += ngw) {
        int r = it;
        if (r < 2 * I13) { const int which = r / I13; r %= I13; const int kb = r / 176, nb = r % 176; int src, nv; src_map_swiglu(nb * 32, src, nv);
            transpose_item(p.in[which ? I_W13B : I_W13A] + (size_t)l * D * 2 * DFF, D, 2 * DFF, wt + (which ? WT_13B : WT_13A) / 2, nb * 32, src, nv, kb * 64, scr, lane); continue; }
        r -= 2 * I13;
        if (r < 2 * I2) { const int which = r / I2; r %= I2; const int kb = r / 32, nb = r % 32;
            transpose_item(p.in[which ? I_W2B : I_W2A] + (size_t)l * DFF * D, DFF, D, wt + (which ? WT_2B : WT_2A) / 2, nb * 32, nb * 32, 32, kb * 64, scr, lane); continue; }
        r -= 2 * I2;
        if (r < IIN) { const int kb = r / 184, nb = r % 184; int src, nv; src_map_in(nb * 32, src, nv);
            transpose_item(p.in[I_WIN] + (size_t)l * D * 5648, D, 5648, wt + WT_IN / 2, nb * 32, src, nv, kb * 64, scr, lane); continue; }
        r -= IIN;
        { const int kb = r / 32, nb = r % 32;
            transpose_item(p.in[I_WOUT] + (size_t)l * 2048 * D, 2048, D, wt + WT_OUT / 2, nb * 32, nb * 32, 32, kb * 64, scr, lane); }
    }
}

DEV void ph_mod(const Params& p, LAS unsigned char* lds, int tid, int wave, int lane) {
    LAS float* cond = (LAS float*)lds;
    LAS float* part = (LAS float*)(lds + 16384);
    __syncthreads();
    for (int i = tid; i < NB * D; i += NTHREADS) cond[i] = siluf(p.in[I_C][i]);
    __syncthreads();
    float* mod = (float*)(p.ws + WS_MOD);
    for (int unit = blockIdx.x; unit < NL * 144; unit += gridDim.x) {
        const int l = unit / 144, j = (unit % 144) * 64 + lane;
        const float* w = p.in[I_ADAW] + (size_t)l * D * MODW + j;
        float a0 = 0.f, a1 = 0.f, a2 = 0.f, a3 = 0.f;
        for (int k = wave * 128; k < wave * 128 + 128; ++k) { const float wv = w[(size_t)k * MODW]; a0 += cond[k] * wv; a1 += cond[D + k] * wv; a2 += cond[2 * D + k] * wv; a3 += cond[3 * D + k] * wv; }
        part[(wave * 4 + 0) * 64 + lane] = a0; part[(wave * 4 + 1) * 64 + lane] = a1; part[(wave * 4 + 2) * 64 + lane] = a2; part[(wave * 4 + 3) * 64 + lane] = a3;
        __syncthreads();
        if (wave < 4) { float s = 0.f;
#pragma unroll
            for (int w8 = 0; w8 < 8; ++w8) s += part[(w8 * 4 + wave) * 64 + lane];
            mod[((size_t)l * NB + wave) * MODW + j] = s + p.in[I_ADAB][(size_t)l * MODW + j]; }
        __syncthreads();
    }
    if (blockIdx.x == 0) {
        float* misc = (float*)(p.ws + WS_MISC);
        if (wave < NL) { const int l = wave;
            const float s1 = wave_sum(p.in[I_LQ1][l * 64 + lane] * p.in[I_LK1][l * 64 + lane]);
            const float s2 = wave_sum(p.in[I_LQ2][l * 64 + lane] * p.in[I_LK2][l * 64 + lane]);
            const float linit = 0.8f - 0.6f * expf(-0.3f * (float)l);
            if (lane == 0) misc[l] = expf(s1) - expf(s2) + linit; }
        if (tid < 512) { const int h = tid >> 7, d = tid & 127; int bk;
            if (d < 16) bk = d; else { bk = 16 + (int)(logf((float)d / 16.f) / logf(8.f) * 16.f); if (bk > 31) bk = 31; }
            misc[64 + h * 128 + d] = p.in[I_RB][bk * 4 + h]; }
    }
}

DEV void ph_norm(const float* xsrc, const float* g, const float* modl, int ishift, int iscale, bf16_t* XN, int gw, int ngw, int lane) {
    for (int m = gw; m < M; m += ngw) {
        const int b = m / S; const float* xr = xsrc + (size_t)m * D;
        f32x4 v[4]; float ss = 0.f;
#pragma unroll
        for (int j = 0; j < 4; ++j) { v[j] = *(const f32x4*)(xr + 4 * lane + 256 * j); ss += (v[j].x * v[j].x + v[j].y * v[j].y) + (v[j].z * v[j].z + v[j].w * v[j].w); }
        const float rstd = rsqrtf(wave_sum(ss) * (1.f / D) + EPS);
        const float* sh = modl + (size_t)b * MODW + ishift * D; const float* sc = modl + (size_t)b * MODW + iscale * D;
#pragma unroll
        for (int j = 0; j < 4; ++j) { const int c = 4 * lane + 256 * j; const f32x4 gg = *(const f32x4*)(g + c), s1 = *(const f32x4*)(sc + c), s0 = *(const f32x4*)(sh + c);
            const f32x4 o = v[j] * rstd * gg * (s1 + 1.f) + s0; u32x2 w; w.x = pk2(o.x, o.y); w.y = pk2(o.z, o.w); *(u32x2*)(XN + (size_t)m * D + c) = w; }
    }
}
DEV void ph_final_norm(float* x, const float* g, int gw, int ngw, int lane) {
    for (int m = gw; m < M; m += ngw) {
        float* xr = x + (size_t)m * D; f32x4 v[4]; float ss = 0.f;
#pragma unroll
        for (int j = 0; j < 4; ++j) { v[j] = *(const f32x4*)(xr + 4 * lane + 256 * j); ss += (v[j].x * v[j].x + v[j].y * v[j].y) + (v[j].z * v[j].z + v[j].w * v[j].w); }
        const float rstd = rsqrtf(wave_sum(ss) * (1.f / D) + EPS);
#pragma unroll
        for (int j = 0; j < 4; ++j) { const int c = 4 * lane + 256 * j; const f32x4 gg = *(const f32x4*)(g + c); *(f32x4*)(xr + c) = v[j] * rstd * gg; }
    }
}

struct EpiSwiglu { bf16_t* H;
    DEV void elem2(int row, int j, float a, float u) const { H[(size_t)row * DFF + j] = (bf16_t)f2bf(siluf(a) * u); } };
struct EpiResid { const float* xsrc; float* out; const float* gate; float f;
    DEV void elem(int row, int col, float v) const { const int b = row / S; const size_t o = (size_t)row * D + col; out[o] = xsrc[o] + f * gate[(size_t)b * MODW + col] * v; } };
struct EpiIn { bf16_t* P; float* DT; bf16_t* HALO;
    DEV void elem(int row, int col, float v) const {
        if (col < PW) { const bf16_t h = (bf16_t)f2bf(v); P[(size_t)row * PW + col] = h;
            if (col >= PXBC) { const int r = row & 127; if (r >= 125) HALO[((size_t)((row >> 7) + 1) * 3 + (r - 125)) * 1536 + (col - PXBC)] = h; } }
        else if (col < PW + 16) DT[(size_t)row * 16 + (col - PW)] = v; } };

template <bool SW, class Epi>
DEV void gemm_naive(const bf16_t* A, int lda, const bf16_t* Bt, int Ndest, int K, const Epi& E, LAS unsigned char* lds, int tid) {
    LAS float* As = (LAS float*)lds;
    LAS float* Bs = (LAS float*)(lds + 128 * 33 * 4);
    LAS float* Bs2 = (LAS float*)(lds + 192 * 33 * 4);
    const int ntn = SW ? (Ndest / 256) * 2 : Ndest / 64;
    const int ntiles = (M / 128) * ntn;
    const int ty = tid >> 4, tx = tid & 15;
    for (int tile = blockIdx.x; tile < ntiles; tile += gridDim.x) {
        const int tm = tile / ntn, tn = tile % ntn;
        const int m0 = tm * 128;
        const int n0 = SW ? (tn >> 1) * 256 + (tn & 1) * 64 : tn * 64;
        float acc[4][4], acc2[4][4];
#pragma unroll
        for (int i = 0; i < 4; ++i)
#pragma unroll
            for (int j = 0; j < 4; ++j) { acc[i][j] = 0.f; acc2[i][j] = 0.f; }
        for (int k0 = 0; k0 < K; k0 += 32) {
            { const int row = tid >> 2, kc = (tid & 3) * 8; const u32x4 v = *(const u32x4*)(A + (size_t)(m0 + row) * lda + k0 + kc); LAS float* d = As + row * 33 + kc;
              d[0] = bflo(v.x); d[1] = bfhi(v.x); d[2] = bflo(v.y); d[3] = bfhi(v.y); d[4] = bflo(v.z); d[5] = bfhi(v.z); d[6] = bflo(v.w); d[7] = bfhi(v.w); }
            if (tid < 256) { const int row = tid >> 2, kc = (tid & 3) * 8; const u32x4 v = *(const u32x4*)(Bt + (size_t)(n0 + row) * K + k0 + kc); LAS float* d = Bs + row * 33 + kc;
              d[0] = bflo(v.x); d[1] = bfhi(v.x); d[2] = bflo(v.y); d[3] = bfhi(v.y); d[4] = bflo(v.z); d[5] = bfhi(v.z); d[6] = bflo(v.w); d[7] = bfhi(v.w); }
            else if (SW) { const int t2 = tid - 256; const int row = t2 >> 2, kc = (t2 & 3) * 8; const u32x4 v = *(const u32x4*)(Bt + (size_t)(n0 + 128 + row) * K + k0 + kc); LAS float* d = Bs2 + row * 33 + kc;
              d[0] = bflo(v.x); d[1] = bfhi(v.x); d[2] = bflo(v.y); d[3] = bfhi(v.y); d[4] = bflo(v.z); d[5] = bfhi(v.z); d[6] = bflo(v.w); d[7] = bfhi(v.w); }
            __syncthreads();
#pragma unroll 8
            for (int kk = 0; kk < 32; ++kk) {
                float a[4], b[4], b2[4];
#pragma unroll
                for (int i = 0; i < 4; ++i) a[i] = As[(ty * 4 + i) * 33 + kk];
#pragma unroll
                for (int j = 0; j < 4; ++j) { b[j] = Bs[(tx * 4 + j) * 33 + kk]; if (SW) b2[j] = Bs2[(tx * 4 + j) * 33 + kk]; }
#pragma unroll
                for (int i = 0; i < 4; ++i)
#pragma unroll
                    for (int j = 0; j < 4; ++j) { acc[i][j] += a[i] * b[j]; if (SW) acc2[i][j] += a[i] * b2[j]; }
            }
            __syncthreads();
        }
#pragma unroll
        for (int i = 0; i < 4; ++i)
#pragma unroll
            for (int j = 0; j < 4; ++j) {
                if constexpr (SW) E.elem2(m0 + ty * 4 + i, (tn >> 1) * 128 + (tn & 1) * 64 + tx * 4 + j, acc[i][j], acc2[i][j]);
                else E.elem(m0 + ty * 4 + i, n0 + tx * 4 + j, acc[i][j]);
            }
    }
}

DEV void ph_conv(const Params& p, int l, int tid) {
    bf16_t* P = (bf16_t*)(p.ws + WS_P); const bf16_t* HALO = (const bf16_t*)(p.ws + WS_HALO);
    const float* cw = p.in[I_CW] + (size_t)l * 1536 * 4; const float* cb = p.in[I_CB] + (size_t)l * 1536;
    for (int task = blockIdx.x * NTHREADS + tid; task < GCH * 768; task += gridDim.x * NTHREADS) {
        const int gc = task / 768, ch = (task % 768) * 2; const int r0 = gc * CH;
        const f32x4 w0 = *(const f32x4*)(cw + ch * 4), w1 = *(const f32x4*)(cw + ch * 4 + 4); const float b0 = cb[ch], b1 = cb[ch + 1];
        float a3 = 0.f, a2 = 0.f, a1 = 0.f, c3 = 0.f, c2 = 0.f, c1 = 0.f;
        if (gc % NCHUNK != 0) { const bf16_t* hp = HALO + (size_t)gc * 3 * 1536 + ch;
            const unsigned h0 = *(const unsigned*)(hp), h1 = *(const unsigned*)(hp + 1536), h2 = *(const unsigned*)(hp + 2 * 1536);
            a3 = bflo(h0); c3 = bfhi(h0); a2 = bflo(h1); c2 = bfhi(h1); a1 = bflo(h2); c1 = bfhi(h2); }
        unsigned* col = (unsigned*)(P + (size_t)r0 * PW + PXBC + ch);
        for (int i = 0; i < CH; ++i) {
            const unsigned raw = col[(size_t)i * (PW / 2)]; const float a0 = bflo(raw), c0 = bfhi(raw);
            const float ya = b0 + w0.x * a3 + w0.y * a2 + w0.z * a1 + w0.w * a0, yc = b1 + w1.x * c3 + w1.y * c2 + w1.z * c1 + w1.w * c0;
            col[(size_t)i * (PW / 2)] = pk2(siluf(ya), siluf(yc));
            a3 = a2; a2 = a1; a1 = a0; c3 = c2; c2 = c1; c1 = c0;
        }
    }
}

DEV void ssd_head_scalars(const Params& p, int l, int r0, int h, LAS float* s_dt, LAS float* s_ac, int tid, int wave, int lane) {
    const float* DT = (const float*)(p.ws + WS_DT);
    if (tid < CH) { const float dtv = softplusf(DT[(size_t)(r0 + tid) * 16 + h] + p.in[I_DTB][l * 16 + h]); s_dt[tid] = dtv; s_ac[tid] = dtv * (-__expf(p.in[I_ALOG][l * 16 + h])); }
    __syncthreads();
    if (wave == 0) { const float v0 = s_ac[2 * lane], v1 = s_ac[2 * lane + 1]; const float s = v0 + v1; const float inc = wave_incl_scan(s, lane); s_ac[2 * lane] = inc - s + v0; s_ac[2 * lane + 1] = inc; }
    __syncthreads();
}
DEV void ph_ssd_state(const Params& p, int l, LAS unsigned char* lds, int tid, int wave, int lane) {
    LAS bf16_t* Bs = (LAS bf16_t*)lds;
    LAS float* xdd = (LAS float*)(lds + 34816);
    LAS float* s_dt = (LAS float*)(lds + 34816 + 32768);
    LAS float* s_ac = s_dt + 128;
    const bf16_t* P = (const bf16_t*)(p.ws + WS_P); float* ST = (float*)(p.ws + WS_ST); float* CD = (float*)(p.ws + WS_CD);
    for (int unit = blockIdx.x; unit < GCH * 16; unit += gridDim.x) {
        const int gc = unit >> 4, h = unit & 15, g = h >> 3, r0 = gc * CH;
        __syncthreads();
        ssd_head_scalars(p, l, r0, h, s_dt, s_ac, tid, wave, lane);
        { const int row = tid >> 2, c0 = (tid & 3) * 32; const bf16_t* src = P + (size_t)(r0 + row) * PW + PBM + g * 128 + c0;
#pragma unroll
          for (int q = 0; q < 4; ++q) *(LAS u32x4*)(Bs + row * 136 + c0 + q * 8) = *(const u32x4*)(src + q * 8); }
        { const int row = tid >> 2, p0 = (tid & 3) * 16; const bf16_t* src = P + (size_t)(r0 + row) * PW + PXS + h * 64 + p0; const float f = s_dt[row] * __expf(s_ac[127] - s_ac[row]);
#pragma unroll
          for (int q = 0; q < 2; ++q) { const u32x4 v = *(const u32x4*)(src + q * 8); LAS float* d = xdd + row * 64 + p0 + q * 8;
              d[0] = bflo(v.x) * f; d[1] = bfhi(v.x) * f; d[2] = bflo(v.y) * f; d[3] = bfhi(v.y) * f; d[4] = bflo(v.z) * f; d[5] = bfhi(v.z) * f; d[6] = bflo(v.w) * f; d[7] = bfhi(v.w) * f; } }
        __syncthreads();
        const int pp = tid >> 3, ng = tid & 7; float acc[16];
#pragma unroll
        for (int j = 0; j < 16; ++j) acc[j] = 0.f;
        for (int ll = 0; ll < CH; ++ll) { const float xv = xdd[ll * 64 + pp]; const u32x4 b0 = *(const LAS u32x4*)(Bs + ll * 136 + ng * 16), b1 = *(const LAS u32x4*)(Bs + ll * 136 + ng * 16 + 8);
            acc[0] += xv * bflo(b0.x); acc[1] += xv * bfhi(b0.x); acc[2] += xv * bflo(b0.y); acc[3] += xv * bfhi(b0.y); acc[4] += xv * bflo(b0.z); acc[5] += xv * bfhi(b0.z); acc[6] += xv * bflo(b0.w); acc[7] += xv * bfhi(b0.w);
            acc[8] += xv * bflo(b1.x); acc[9] += xv * bfhi(b1.x); acc[10] += xv * bflo(b1.y); acc[11] += xv * bfhi(b1.y); acc[12] += xv * bflo(b1.z); acc[13] += xv * bfhi(b1.z); acc[14] += xv * bflo(b1.w); acc[15] += xv * bfhi(b1.w); }
        float* dst = ST + (((size_t)gc * 16 + h) * 64 + pp) * 128 + ng * 16;
#pragma unroll
        for (int q = 0; q < 4; ++q) *(f32x4*)(dst + q * 4) = (f32x4){acc[q * 4], acc[q * 4 + 1], acc[q * 4 + 2], acc[q * 4 + 3]};
        if (tid == 0) CD[gc * 16 + h] = __expf(s_ac[127]);
    }
}
DEV void ph_ssd_scan(const Params& p, int tid) {
    float* ST = (float*)(p.ws + WS_ST); const float* CD = (const float*)(p.ws + WS_CD);
    for (int e = blockIdx.x * NTHREADS + tid; e < NB * 16 * 64 * 128; e += gridDim.x * NTHREADS) {
        const int b = e >> 17, h = (e >> 13) & 15, pn = e & 8191; float hc = 0.f;
        for (int c = 0; c < NCHUNK; ++c) { const int gc = b * NCHUNK + c; const size_t idx = ((size_t)gc * 16 + h) * 8192 + pn; const float t = ST[idx]; ST[idx] = hc; hc = hc * CD[gc * 16 + h] + t; }
    }
}
DEV void ph_ssd_out(const Params& p, int l, LAS unsigned char* lds, int tid, int wave, int lane) {
    LAS bf16_t* Cs = (LAS bf16_t*)lds;
    LAS bf16_t* Bs = (LAS bf16_t*)(lds + 34816);
    LAS float* prev = (LAS float*)(lds + 34816);
    LAS bf16_t* CBs = (LAS bf16_t*)(lds + 2 * 34816);
    LAS float* xd = (LAS float*)(lds + 3 * 34816);
    LAS float* s_dt = (LAS float*)(lds + 4 * 34816); LAS float* s_ac = s_dt + 128; LAS float* s_ss = s_dt + 256;
    bf16_t* P = (bf16_t*)(p.ws + WS_P); const float* ST = (const float*)(p.ws + WS_ST); float* ROWSS = (float*)(p.ws + WS_ROWSS);
    for (int unit = blockIdx.x; unit < GCH * 2; unit += gridDim.x) {
        const int gc = unit >> 1, g = unit & 1, r0 = gc * CH;
        __syncthreads();
        { const int row = tid >> 2, c0 = (tid & 3) * 32; const bf16_t* sc = P + (size_t)(r0 + row) * PW + PCM + g * 128 + c0; const bf16_t* sb = P + (size_t)(r0 + row) * PW + PBM + g * 128 + c0;
#pragma unroll
          for (int q = 0; q < 4; ++q) { *(LAS u32x4*)(Cs + row * 136 + c0 + q * 8) = *(const u32x4*)(sc + q * 8); *(LAS u32x4*)(Bs + row * 136 + c0 + q * 8) = *(const u32x4*)(sb + q * 8); } }
        if (tid < CH) s_ss[tid] = 0.f;
        __syncthreads();
        { const int lr = tid >> 2, s0 = (tid & 3) * 32; float acc[32];
#pragma unroll
          for (int j = 0; j < 32; ++j) acc[j] = 0.f;
          for (int n = 0; n < 128; n += 8) { const u32x4 cv = *(const LAS u32x4*)(Cs + lr * 136 + n);
              const float c0 = bflo(cv.x), c1 = bfhi(cv.x), c2 = bflo(cv.y), c3 = bfhi(cv.y), c4 = bflo(cv.z), c5 = bfhi(cv.z), c6 = bflo(cv.w), c7 = bfhi(cv.w);
#pragma unroll
              for (int j = 0; j < 32; ++j) { const u32x4 bv = *(const LAS u32x4*)(Bs + (s0 + j) * 136 + n);
                  acc[j] += c0 * bflo(bv.x) + c1 * bfhi(bv.x) + c2 * bflo(bv.y) + c3 * bfhi(bv.y) + c4 * bflo(bv.z) + c5 * bfhi(bv.z) + c6 * bflo(bv.w) + c7 * bfhi(bv.w); } }
#pragma unroll
          for (int j = 0; j < 32; j += 2) *(LAS unsigned*)(CBs + lr * 136 + s0 + j) = pk2(acc[j], acc[j + 1]); }
        for (int e = 0; e < 8; ++e) {
            const int h = g * 8 + e;
            __syncthreads();
            ssd_head_scalars(p, l, r0, h, s_dt, s_ac, tid, wave, lane);
            { const int pp = tid >> 3, n0 = (tid & 7) * 16; const float* src = ST + (((size_t)gc * 16 + h) * 64 + pp) * 128 + n0;
#pragma unroll
              for (int q = 0; q < 4; ++q) { const f32x4 v = *(const f32x4*)(src + q * 4); LAS float* d = prev + pp * 129 + n0 + q * 4; d[0] = v.x; d[1] = v.y; d[2] = v.z; d[3] = v.w; } }
            const int lr = tid >> 2, p0 = (tid & 3) * 16; float xraw[16];
            { const bf16_t* src = P + (size_t)(r0 + lr) * PW + PXS + h * 64 + p0; const float f = s_dt[lr];
#pragma unroll
              for (int q = 0; q < 2; ++q) { const u32x4 v = *(const u32x4*)(src + q * 8);
                  xraw[q * 8 + 0] = bflo(v.x); xraw[q * 8 + 1] = bfhi(v.x); xraw[q * 8 + 2] = bflo(v.y); xraw[q * 8 + 3] = bfhi(v.y); xraw[q * 8 + 4] = bflo(v.z); xraw[q * 8 + 5] = bfhi(v.z); xraw[q * 8 + 6] = bflo(v.w); xraw[q * 8 + 7] = bfhi(v.w); }
#pragma unroll
              for (int j = 0; j < 16; ++j) xd[lr * 68 + p0 + j] = xraw[j] * f; }
            __syncthreads();
            float y[16], yo[16];
#pragma unroll
            for (int j = 0; j < 16; ++j) { y[j] = 0.f; yo[j] = 0.f; }
            const float al = s_ac[lr];
            for (int s = 0; s <= lr; ++s) { const float cb = bf2f(CBs[lr * 136 + s]) * __expf(al - s_ac[s]);
#pragma unroll
                for (int q = 0; q < 4; ++q) { const f32x4 xv = *(const LAS f32x4*)(xd + s * 68 + p0 + q * 4); y[q * 4] += cb * xv.x; y[q * 4 + 1] += cb * xv.y; y[q * 4 + 2] += cb * xv.z; y[q * 4 + 3] += cb * xv.w; } }
            for (int n = 0; n < 128; ++n) { const float c = bf2f(Cs[lr * 136 + n]);
#pragma unroll
                for (int j = 0; j < 16; ++j) yo[j] += c * prev[(p0 + j) * 129 + n]; }
            const float ea = __expf(al), dh = p.in[I_SD][l * 16 + h];
            bf16_t* zp = P + (size_t)(r0 + lr) * PW + PZ + h * 64 + p0; float ssl = 0.f; unsigned ow[8];
            { const u32x4 z0 = *(const u32x4*)zp, z1 = *(const u32x4*)(zp + 8); float zz[16];
              zz[0] = bflo(z0.x); zz[1] = bfhi(z0.x); zz[2] = bflo(z0.y); zz[3] = bfhi(z0.y); zz[4] = bflo(z0.z); zz[5] = bfhi(z0.z); zz[6] = bflo(z0.w); zz[7] = bfhi(z0.w);
              zz[8] = bflo(z1.x); zz[9] = bfhi(z1.x); zz[10] = bflo(z1.y); zz[11] = bfhi(z1.y); zz[12] = bflo(z1.z); zz[13] = bfhi(z1.z); zz[14] = bflo(z1.w); zz[15] = bfhi(z1.w);
#pragma unroll
              for (int j = 0; j < 16; ++j) { const float v = (y[j] + ea * yo[j] + dh * xraw[j]) * siluf(zz[j]); ssl += v * v; y[j] = v; }
#pragma unroll
              for (int j = 0; j < 8; ++j) ow[j] = pk2(y[2 * j], y[2 * j + 1]); }
            *(u32x4*)zp = (u32x4){ow[0], ow[1], ow[2], ow[3]}; *(u32x4*)(zp + 8) = (u32x4){ow[4], ow[5], ow[6], ow[7]};
            ssl += __shfl_xor(ssl, 1); ssl += __shfl_xor(ssl, 2);
            if ((tid & 3) == 0) s_ss[lr] += ssl;
        }
        __syncthreads();
        if (tid < CH) ROWSS[(size_t)(r0 + tid) * 2 + g] = s_ss[tid];
    }
}
DEV void ph_mixfinal(const Params& p, int l, int tid) {
    bf16_t* P = (bf16_t*)(p.ws + WS_P); const float* ROWSS = (const float*)(p.ws + WS_ROWSS); const float* ng = p.in[I_SN] + (size_t)l * 1024;
    for (int e = blockIdx.x * NTHREADS + tid; e < M * 512; e += gridDim.x * NTHREADS) {
        const int row = e >> 9, c = (e & 511) * 2; const float rs = rsqrtf(ROWSS[(size_t)row * 2 + (c >> 9)] * (1.f / 512.f) + EPS);
        unsigned* q = (unsigned*)(P + (size_t)row * PW + PZ + c); const unsigned w = *q; *q = pk2(bflo(w) * rs * ng[c], bfhi(w) * rs * ng[c + 1]);
    }
}

DEV void ph_sb_attn(const Params& p, LAS unsigned char* lds, int gw, int ngw, int wave, int lane) {
    LAS float* qs = (LAS float*)(lds + 65536 + wave * 512);
    bf16_t* P = (bf16_t*)(p.ws + WS_P);
    for (int task = gw; task < NB * 8 * S; task += ngw) {
        const int t = task % S, bh = task / S, h = bh & 7, b = bh >> 3; const size_t rowb = (size_t)b * S;
        bf16_t* qp = P + (rowb + t) * PW + PSQ + h * 64;
        qs[lane] = bf2f(qp[lane]) * 0.125f; LDS_WAIT();
        float o = 0.f, R = 0.f;
        for (int k1 = t - 1; k1 >= 0; k1 -= 64) {
            const int s = k1 - lane; const bool valid = s >= 0; float z = 0.f;
            if (valid) { const bf16_t* kp = P + (rowb + s) * PW + PSK + h * 64;
#pragma unroll
                for (int q = 0; q < 8; ++q) { const u32x4 kv = *(const u32x4*)(kp + q * 8); const LAS float* qq = qs + q * 8;
                    z += qq[0] * bflo(kv.x) + qq[1] * bfhi(kv.x) + qq[2] * bflo(kv.y) + qq[3] * bfhi(kv.y) + qq[4] * bflo(kv.z) + qq[5] * bfhi(kv.z) + qq[6] * bflo(kv.w) + qq[7] * bfhi(kv.w); } }
            const float Lg = valid ? -softplusf(z) : 0.f;
            const float cum = wave_incl_scan(Lg, lane);
            const float w = valid ? __expf(z + R + cum) : 0.f;
            const int nv = (k1 + 1 < 64) ? k1 + 1 : 64;
            for (int i = 0; i < nv; ++i) { const float wi = __shfl(w, i); o += wi * bf2f(P[(rowb + (k1 - i)) * PW + PSV + h * 64 + lane]); }
            R += __shfl(cum, 63);
            if (R < -104.f) break;
        }
        qp[lane] = (bf16_t)f2bf(o);
        LDS_WAIT();
    }
}
DEV void ph_diff_attn(const Params& p, int l, LAS unsigned char* lds, int gw, int ngw, int wave, int lane) {
    LAS float* qs = (LAS float*)(lds + 65536 + 4096 + wave * 512);
    bf16_t* P = (bf16_t*)(p.ws + WS_P); const float* misc = (const float*)(p.ws + WS_MISC);
    const float lam = misc[l]; const float linit = 0.8f - 0.6f * expf(-0.3f * (float)l);
    for (int task = gw; task < NB * 4 * S; task += ngw) {
        const int t = task % S, bh = task / S, h = bh & 3, b = bh >> 2; const size_t rowb = (size_t)b * S;
        bf16_t* qp = P + (rowb + t) * PW + PDQ + h * 128;
        qs[lane] = bf2f(qp[lane]) * 0.125f; qs[64 + lane] = bf2f(qp[64 + lane]) * 0.125f; LDS_WAIT();
        const float* bt = misc + 64 + h * 128;
        float m0 = -INFINITY, m1 = -INFINITY, l0 = 0.f, l1 = 0.f, o0a = 0.f, o0b = 0.f, o1a = 0.f, o1b = 0.f;
        for (int k1 = t; k1 >= 0; k1 -= 64) {
            const int s = k1 - lane; const bool valid = s >= 0; float z0 = 0.f, z1 = 0.f;
            if (valid) { const bf16_t* kp = P + (rowb + s) * PW + PDK + h * 128;
#pragma unroll
                for (int q = 0; q < 8; ++q) { const u32x4 kv = *(const u32x4*)(kp + q * 8); const LAS float* qq = qs + q * 8;
                    z0 += qq[0] * bflo(kv.x) + qq[1] * bfhi(kv.x) + qq[2] * bflo(kv.y) + qq[3] * bfhi(kv.y) + qq[4] * bflo(kv.z) + qq[5] * bfhi(kv.z) + qq[6] * bflo(kv.w) + qq[7] * bfhi(kv.w); }
#pragma unroll
                for (int q = 0; q < 8; ++q) { const u32x4 kv = *(const u32x4*)(kp + 64 + q * 8); const LAS float* qq = qs + 64 + q * 8;
                    z1 += qq[0] * bflo(kv.x) + qq[1] * bfhi(kv.x) + qq[2] * bflo(kv.y) + qq[3] * bfhi(kv.y) + qq[4] * bflo(kv.z) + qq[5] * bfhi(kv.z) + qq[6] * bflo(kv.w) + qq[7] * bfhi(kv.w); } }
            const int dist = t - s; const float bias = bt[dist < 127 ? dist : 127];
            z0 = valid ? z0 + bias : -INFINITY; z1 = valid ? z1 + bias : -INFINITY;
            const float n0 = fmaxf(m0, wave_max(z0)), n1 = fmaxf(m1, wave_max(z1));
            const float sc0 = __expf(m0 - n0), sc1 = __expf(m1 - n1);
            const float p0 = valid ? __expf(z0 - n0) : 0.f, p1 = valid ? __expf(z1 - n1) : 0.f;
            l0 = l0 * sc0 + wave_sum(p0); l1 = l1 * sc1 + wave_sum(p1); o0a *= sc0; o0b *= sc0; o1a *= sc1; o1b *= sc1; m0 = n0; m1 = n1;
            const int nv = (k1 + 1 < 64) ? k1 + 1 : 64;
            for (int i = 0; i < nv; ++i) { const float a = __shfl(p0, i), c = __shfl(p1, i); const unsigned vv = *(const unsigned*)(P + (rowb + (k1 - i)) * PW + PDV + h * 128 + 2 * lane);
                const float va = bflo(vv), vb = bfhi(vv); o0a += a * va; o0b += a * vb; o1a += c * va; o1b += c * vb; }
        }
        const float ya = o0a / l0 - lam * o1a / l1, yb = o0b / l0 - lam * o1b / l1;
        const float rs = rsqrtf(wave_sum(ya * ya + yb * yb) * (1.f / 128.f) + EPS) * (1.f - linit);
        const float* sg = p.in[I_SUB] + (size_t)l * 128 + 2 * lane;
        *(unsigned*)(qp + 2 * lane) = pk2(ya * rs * sg[0], yb * rs * sg[1]);
        LDS_WAIT();
    }
}

constexpr int PH_PER_LAYER = 15, N_PHASES = NL * PH_PER_LAYER + 1;
template <int ST>
__global__ void __launch_bounds__(NTHREADS, 2) mk_phase(Params p, int l) {
    extern __shared__ __attribute__((aligned(16))) unsigned char lds_raw[];
    LAS unsigned char* lds = (LAS unsigned char*)lds_raw;
    const int tid = threadIdx.x, lane = tid & 63, wave = __builtin_amdgcn_readfirstlane(tid >> 6);
    const int gw = blockIdx.x * NWAVES + wave, ngw = gridDim.x * NWAVES;
    bf16_t* wt = (bf16_t*)(p.ws + WS_WT); bf16_t* XN = (bf16_t*)(p.ws + WS_XN); bf16_t* P = (bf16_t*)(p.ws + WS_P); bf16_t* H = (bf16_t*)(p.ws + WS_H);
    float* DT = (float*)(p.ws + WS_DT); bf16_t* HALO = (bf16_t*)(p.ws + WS_HALO); const float* mod = (const float*)(p.ws + WS_MOD);
    if constexpr (ST == 15) { ph_final_norm(p.out, p.in[I_FN], gw, ngw, lane); return; }
    const float* modl = mod + (size_t)l * NB * MODW;
    const float* xcur = (l == 0 && ST <= 3) ? p.in[I_X] : p.out;
    if constexpr (ST == 0) { ph_convert(p, l, lds, gw, ngw, wave, lane); if (l == 0) ph_mod(p, lds, tid, wave, lane); }
    if constexpr (ST == 1) ph_norm(xcur, p.in[I_N1] + (size_t)l * D, modl, 0, 1, XN, gw, ngw, lane);
    if constexpr (ST == 2) { EpiSwiglu E{H}; gemm_naive<true>(XN, D, wt + WT_13A / 2, 2 * DFF, D, E, lds, tid); }
    if constexpr (ST == 3) { EpiResid E{xcur, p.out, modl + 2 * D, 0.5f}; gemm_naive<false>(H, DFF, wt + WT_2A / 2, D, DFF, E, lds, tid); }
    if constexpr (ST == 4) ph_norm(p.out, p.in[I_NM] + (size_t)l * D, modl, 3, 4, XN, gw, ngw, lane);
    if constexpr (ST == 5) { EpiIn E{P, DT, HALO}; gemm_naive<false>(XN, D, wt + WT_IN / 2, NIN, D, E, lds, tid); }
    if constexpr (ST == 6) ph_conv(p, l, tid);
    if constexpr (ST == 7) ph_ssd_state(p, l, lds, tid, wave, lane);
    if constexpr (ST == 16) ph_sb_attn(p, lds, gw, ngw, wave, lane);
    if constexpr (ST == 17) ph_diff_attn(p, l, lds, gw, ngw, wave, lane);
    if constexpr (ST == 8) ph_ssd_scan(p, tid);
    if constexpr (ST == 9) ph_ssd_out(p, l, lds, tid, wave, lane);
    if constexpr (ST == 10) ph_mixfinal(p, l, tid);
    if constexpr (ST == 11) { EpiResid E{p.out, p.out, modl + 5 * D, 1.0f}; gemm_naive<false>(P, PW, wt + WT_OUT / 2, D, 2048, E, lds, tid); }
    if constexpr (ST == 12) ph_norm(p.out, p.in[I_N2] + (size_t)l * D, modl, 6, 7, XN, gw, ngw, lane);
    if constexpr (ST == 13) { EpiSwiglu E{H}; gemm_naive<true>(XN, D, wt + WT_13B / 2, 2 * DFF, D, E, lds, tid); }
    if constexpr (ST == 14) { EpiResid E{p.out, p.out, modl + 8 * D, 0.5f}; gemm_naive<false>(H, DFF, wt + WT_2B / 2, D, DFF, E, lds, tid); }
}

constexpr int LDS_BYTES = 147456;
extern "C" void kernel_launch(void* const* d_in, const int* in_sizes, int n_in, void* d_out, int out_size, void* d_ws, size_t ws_size, hipStream_t stream) {
    static int grid = 0;
    if (grid == 0) {
        if (n_in != 26 || out_size != M * D || ws_size < WS_END) { fprintf(stderr, "kernel_launch: unexpected shapes (n_in %d out %d ws %zu)\n", n_in, out_size, ws_size); grid = -1; return; }
        int dev = 0, cus = 0;
        if (hipGetDevice(&dev) != hipSuccess || hipDeviceGetAttribute(&cus, hipDeviceAttributeMultiprocessorCount, dev) != hipSuccess) { grid = -1; return; }
#define SETATTR(ST) if (hipFuncSetAttribute((const void*)mk_phase<ST>, hipFuncAttributeMaxDynamicSharedMemorySize, LDS_BYTES) != hipSuccess) { grid = -1; return; }
        SETATTR(0) SETATTR(1) SETATTR(2) SETATTR(3) SETATTR(4) SETATTR(5) SETATTR(6) SETATTR(7) SETATTR(8) SETATTR(9) SETATTR(10) SETATTR(11) SETATTR(12) SETATTR(13) SETATTR(14) SETATTR(15) SETATTR(16) SETATTR(17)
        grid = cus;
    }
    if (grid < 0) return;
    Params p{};
    for (int i = 0; i < 26; ++i) p.in[i] = (const float*)d_in[i];
    p.out = (float*)d_out; p.ws = (unsigned char*)d_ws;
#define LAUNCH(ST, l) hipLaunchKernelGGL(mk_phase<ST>, dim3(grid), dim3(NTHREADS), LDS_BYTES, stream, p, l)
    for (int l = 0; l < NL; ++l) {
        LAUNCH(0, l); LAUNCH(1, l); LAUNCH(2, l); LAUNCH(3, l); LAUNCH(4, l); LAUNCH(5, l); LAUNCH(6, l); LAUNCH(7, l); LAUNCH(16, l); LAUNCH(17, l);
        LAUNCH(8, l); LAUNCH(9, l); LAUNCH(10, l); LAUNCH(11, l); LAUNCH(12, l); LAUNCH(13, l); LAUNCH(14, l);
    }
    LAUNCH(15, 0);
}
```

```cpp
#include <hip/hip_runtime.h>
#include <cstdio>
#include <cstdint>

#define DEV __device__ __forceinline__
#define LAS __attribute__((address_space(3)))
typedef unsigned short bf16_t;
typedef unsigned u32x4 __attribute__((ext_vector_type(4)));
typedef unsigned u32x2 __attribute__((ext_vector_type(2)));
typedef float f32x4 __attribute__((ext_vector_type(4)));

constexpr int D = 1024, NB = 4, S = 4096, M = NB * S, NL = 2, DFF = 2816, MODW = 9 * D;
constexpr int PW = 5632, NIN = 5888;
constexpr int PZ = 0, PSQ = 1024, PDQ = 1536, PSK = 2048, PSV = 2560, PDK = 3072, PDV = 3584, PXBC = 4096;
constexpr int PXS = PXBC, PBM = PXBC + 1024, PCM = PXBC + 1280;
constexpr int CH = 128, NCHUNK = S / CH, GCH = NB * NCHUNK;
constexpr float EPS = 1e-6f;
constexpr int NTHREADS = 512, NWAVES = 8;

constexpr size_t KiB = 1024, MiB = 1024 * 1024;
constexpr size_t WS_BAR = 0;
constexpr size_t WS_MOD = 64 * KiB;
constexpr size_t WS_ROWSS = 352 * KiB;
constexpr size_t WS_CD = 480 * KiB;
constexpr size_t WS_MISC = 488 * KiB;
constexpr size_t WS_HALO = 512 * KiB;
constexpr size_t WS_WT = 2 * MiB;
constexpr size_t WT_13A = 0, WT_2A = 11 * MiB, WT_IN = 16 * MiB + 512 * KiB, WT_OUT = 28 * MiB, WT_13B = 32 * MiB, WT_2B = 43 * MiB;
constexpr size_t WS_XN = 51 * MiB;
constexpr size_t WS_ST = 51 * MiB;
constexpr size_t WS_P = 115 * MiB;
constexpr size_t WS_H = WS_P;
constexpr size_t WS_DT = 291 * MiB;
constexpr size_t WS_END = 292 * MiB;

struct Params { const float* in[26]; float* out; unsigned char* ws; };
enum { I_X = 0, I_C, I_ADAW, I_ADAB, I_N1, I_W13A, I_W2A, I_NM, I_WIN, I_CW, I_CB, I_DTB, I_ALOG, I_SD, I_SN, I_LQ1, I_LK1, I_LQ2, I_LK2, I_SUB, I_RB, I_WOUT, I_N2, I_W13B, I_W2B, I_FN };

DEV float bf2f(bf16_t v) { return __uint_as_float(((unsigned)v) << 16); }
DEV float bflo(unsigned w) { return __uint_as_float(w << 16); }
DEV float bfhi(unsigned w) { return __uint_as_float(w & 0xffff0000u); }
DEV unsigned f2bf(float f) { unsigned u = __float_as_uint(f); return (u + 0x7fffu + ((u >> 16) & 1u)) >> 16; }
DEV unsigned pk2(float lo, float hi) { return f2bf(lo) | (f2bf(hi) << 16); }
DEV float siluf(float x) { return x / (1.f + __expf(-x)); }
DEV float softplusf(float x) { return fmaxf(x, 0.f) + log1pf(__expf(-fabsf(x))); }
DEV float wave_sum(float v) {
#pragma unroll
    for (int o = 1; o < 64; o <<= 1) v += __shfl_xor(v, o);
    return v;
}
DEV float wave_max(float v) {
#pragma unroll
    for (int o = 1; o < 64; o <<= 1) v = fmaxf(v, __shfl_xor(v, o));
    return v;
}
DEV float wave_incl_scan(float v, int lane) {
#pragma unroll
    for (int o = 1; o < 64; o <<= 1) { float t = __shfl_up(v, o); if (lane >= o) v += t; }
    return v;
}
#define BIDX obid()
#define GDIM ((int)gridDim.x)
#define LDS_WAIT() asm volatile("s_waitcnt lgkmcnt(0)" ::: "memory")
DEV int otid() { int t = threadIdx.x; asm volatile("" : "+v"(t)); return t; }
DEV int obid() { int b = blockIdx.x; asm volatile("" : "+s"(b)); return b; }

DEV void transpose_item(const float* W, int K, int N, bf16_t* WT, int dst_n0, int src_n0, int nvalid, int k0, LAS float* scr, int lane) {
    const int c = lane & 31;
#pragma unroll 8
    for (int i = 0; i < 32; ++i) { const int kk = 2 * i + (lane >> 5); scr[kk * 33 + c] = (c < nvalid) ? W[(size_t)(k0 + kk) * N + src_n0 + c] : 0.f; }
    LDS_WAIT();
    const int c8 = lane & 7;
#pragma unroll
    for (int j = 0; j < 4; ++j) { const int n = (lane >> 3) + 8 * j; const LAS float* s = scr + (8 * c8) * 33 + n;
        u32x4 o; o.x = pk2(s[0 * 33], s[1 * 33]); o.y = pk2(s[2 * 33], s[3 * 33]); o.z = pk2(s[4 * 33], s[5 * 33]); o.w = pk2(s[6 * 33], s[7 * 33]);
        *(u32x4*)(WT + (size_t)(dst_n0 + n) * K + k0 + 8 * c8) = o; }
    LDS_WAIT();
}
DEV void src_map_swiglu(int n0, int& src, int& nv) { const int pn = n0 >> 8, bj = (n0 >> 7) & 1, i0 = n0 & 127; src = bj * DFF + pn * 128 + i0; nv = 32; }
DEV void src_map_in(int n0, int& src, int& nv) {
    nv = 32;
    if (n0 < 1024) src = n0;
    else if (n0 < 1536) src = 2576 + (n0 - 1024);
    else if (n0 < 2048) src = 4112 + (n0 - 1536);
    else if (n0 < 2560) src = 3088 + (n0 - 2048);
    else if (n0 < 3072) src = 3600 + (n0 - 2560);
    else if (n0 < 3584) src = 4624 + (n0 - 3072);
    else if (n0 < 4096) src = 5136 + (n0 - 3584);
    else if (n0 < 5632) src = 1024 + (n0 - 4096);
    else if (n0 == 5632) { src = 2560; nv = 16; }
    else { src = 0; nv = 0; }
}
DEV void ph_convert(const Params& p, int l, LAS unsigned char* lds, int gw, int ngw, int wave, int lane) {
    LAS float* scr = (LAS float*)(lds + wave * 16384);
    bf16_t* wt = (bf16_t*)(p.ws + WS_WT);
    constexpr int I13 = 16 * 176, I2 = 44 * 32, IIN = 16 * 184, IOUT = 32 * 32;
    constexpr int NITEMS = 2 * I13 + 2 * I2 + IIN + IOUT;
    for (int it = gw; it < NITEMS; it += ngw) {
        int r = it;
        if (r < 2 * I13) { const int which = r / I13; r %= I13; const int kb = r / 176, nb = r % 176; int src, nv; src_map_swiglu(nb * 32, src, nv);
            transpose_item(p.in[which ? I_W13B : I_W13A] + (size_t)l * D * 2 * DFF, D, 2 * DFF, wt + (which ? WT_13B : WT_13A) / 2, nb * 32, src, nv, kb * 64, scr, lane); continue; }
        r -= 2 * I13;
        if (r < 2 * I2) { const int which = r / I2; r %= I2; const int kb = r / 32, nb = r % 32;
            transpose_item(p.in[which ? I_W2B : I_W2A] + (size_t)l * DFF * D, DFF, D, wt + (which ? WT_2B : WT_2A) / 2, nb * 32, nb * 32, 32, kb * 64, scr, lane); continue; }
        r -= 2 * I2;
        if (r < IIN) { const int kb = r / 184, nb = r % 184; int src, nv; src_map_in(nb * 32, src, nv);
            transpose_item(p.in[I_WIN] + (size_t)l * D * 5648, D, 5648, wt + WT_IN / 2, nb * 32, src, nv, kb * 64, scr, lane); continue; }
        r -= IIN;
        { const int kb = r / 32, nb = r % 32;
            transpose_item(p.in[I_WOUT] + (size_t)l * 2048 * D, 2048, D, wt + WT_OUT / 2, nb * 32, nb * 32, 32, kb * 64, scr, lane); }
    }
}

DEV void ph_mod(const Params& p, LAS unsigned char* lds, int tid, int wave, int lane) {
    LAS float* cond = (LAS float*)lds;
    LAS float* part = (LAS float*)(lds + 16384);
    __syncthreads();
    for (int i = tid; i < NB * D; i += NTHREADS) cond[i] = siluf(p.in[I_C][i]);
    __syncthreads();
    float* mod = (float*)(p.ws + WS_MOD);
    for (int unit = BIDX; unit < NL * 144; unit += GDIM) {
        const int l = unit / 144, j = (unit % 144) * 64 + lane;
        const float* w = p.in[I_ADAW] + (size_t)l * D * MODW + j;
        float a0 = 0.f, a1 = 0.f, a2 = 0.f, a3 = 0.f;
        for (int k = wave * 128; k < wave * 128 + 128; ++k) { const float wv = w[(size_t)k * MODW]; a0 += cond[k] * wv; a1 += cond[D + k] * wv; a2 += cond[2 * D + k] * wv; a3 += cond[3 * D + k] * wv; }
        part[(wave * 4 + 0) * 64 + lane] = a0; part[(wave * 4 + 1) * 64 + lane] = a1; part[(wave * 4 + 2) * 64 + lane] = a2; part[(wave * 4 + 3) * 64 + lane] = a3;
        __syncthreads();
        if (wave < 4) { float s = 0.f;
#pragma unroll
            for (int w8 = 0; w8 < 8; ++w8) s += part[(w8 * 4 + wave) * 64 + lane];
            mod[((size_t)l * NB + wave) * MODW + j] = s + p.in[I_ADAB][(size_t)l * MODW + j]; }
        __syncthreads();
    }
    if (BIDX == 0) {
        float* misc = (float*)(p.ws + WS_MISC);
        if (wave < NL) { const int l = wave;
            const float s1 = wave_sum(p.in[I_LQ1][l * 64 + lane] * p.in[I_LK1][l * 64 + lane]);
            const float s2 = wave_sum(p.in[I_LQ2][l * 64 + lane] * p.in[I_LK2][l * 64 + lane]);
            const float linit = 0.8f - 0.6f * expf(-0.3f * (float)l);
            if (lane == 0) misc[l] = expf(s1) - expf(s2) + linit; }
        if (tid < 512) { const int h = tid >> 7, d = tid & 127; int bk;
            if (d < 16) bk = d; else { bk = 16 + (int)(logf((float)d / 16.f) / logf(8.f) * 16.f); if (bk > 31) bk = 31; }
            misc[64 + h * 128 + d] = p.in[I_RB][bk * 4 + h]; }
    }
}

DEV void ph_norm(const float* xsrc, const float* g, const float* modl, int ishift, int iscale, bf16_t* XN, int gw, int ngw, int lane) {
    for (int m = gw; m < M; m += ngw) {
        const int b = m / S; const float* xr = xsrc + (size_t)m * D;
        f32x4 v[4]; float ss = 0.f;
#pragma unroll
        for (int j = 0; j < 4; ++j) { v[j] = *(const f32x4*)(xr + 4 * lane + 256 * j); ss += (v[j].x * v[j].x + v[j].y * v[j].y) + (v[j].z * v[j].z + v[j].w * v[j].w); }
        const float rstd = rsqrtf(wave_sum(ss) * (1.f / D) + EPS);
        const float* sh = modl + (size_t)b * MODW + ishift * D; const float* sc = modl + (size_t)b * MODW + iscale * D;
#pragma unroll
        for (int j = 0; j < 4; ++j) { const int c = 4 * lane + 256 * j; const f32x4 gg = *(const f32x4*)(g + c), s1 = *(const f32x4*)(sc + c), s0 = *(const f32x4*)(sh + c);
            const f32x4 o = v[j] * rstd * gg * (s1 + 1.f) + s0; u32x2 w; w.x = pk2(o.x, o.y); w.y = pk2(o.z, o.w); *(u32x2*)(XN + (size_t)m * D + c) = w; }
    }
}
DEV void ph_final_norm(float* x, const float* g, int gw, int ngw, int lane) {
    for (int m = gw; m < M; m += ngw) {
        float* xr = x + (size_t)m * D; f32x4 v[4]; float ss = 0.f;
#pragma unroll
        for (int j = 0; j < 4; ++j) { v[j] = *(const f32x4*)(xr + 4 * lane + 256 * j); ss += (v[j].x * v[j].x + v[j].y * v[j].y) + (v[j].z * v[j].z + v[j].w * v[j].w); }
        const float rstd = rsqrtf(wave_sum(ss) * (1.f / D) + EPS);
#pragma unroll
        for (int j = 0; j < 4; ++j) { const int c = 4 * lane + 256 * j; const f32x4 gg = *(const f32x4*)(g + c); *(f32x4*)(xr + c) = v[j] * rstd * gg; }
    }
}

struct EpiSwiglu { bf16_t* H;
    DEV void elem2(int row, int j, float a, float u) const { H[(size_t)row * DFF + j] = (bf16_t)f2bf(siluf(a) * u); } };
struct EpiResid { const float* xsrc; float* out; const float* gate; float f;
    DEV void elem(int row, int col, float v) const { const int b = row / S; const size_t o = (size_t)row * D + col; out[o] = xsrc[o] + f * gate[(size_t)b * MODW + col] * v; } };
struct EpiIn { bf16_t* P; float* DT; bf16_t* HALO;
    DEV void elem(int row, int col, float v) const {
        if (col < PW) { const bf16_t h = (bf16_t)f2bf(v); P[(size_t)row * PW + col] = h;
            if (col >= PXBC) { const int r = row & 127; if (r >= 125) HALO[((size_t)((row >> 7) + 1) * 3 + (r - 125)) * 1536 + (col - PXBC)] = h; } }
        else if (col < PW + 16) DT[(size_t)row * 16 + (col - PW)] = v; } };

template <bool SW, class Epi>
DEV void gemm_naive(const bf16_t* A, int lda, const bf16_t* Bt, int Ndest, int K, const Epi& E, LAS unsigned char* lds, int tid) {
    LAS float* As = (LAS float*)lds;
    LAS float* Bs = (LAS float*)(lds + 128 * 33 * 4);
    LAS float* Bs2 = (LAS float*)(lds + 192 * 33 * 4);
    const int ntn = SW ? (Ndest / 256) * 2 : Ndest / 64;
    const int ntiles = (M / 128) * ntn;
    const int ty = tid >> 4, tx = tid & 15;
    for (int tile = BIDX; tile < ntiles; tile += GDIM) {
        const int tm = tile / ntn, tn = tile % ntn;
        const int m0 = tm * 128;
        const int n0 = SW ? (tn >> 1) * 256 + (tn & 1) * 64 : tn * 64;
        float acc[4][4], acc2[4][4];
#pragma unroll
        for (int i = 0; i < 4; ++i)
#pragma unroll
            for (int j = 0; j < 4; ++j) { acc[i][j] = 0.f; acc2[i][j] = 0.f; }
        for (int k0 = 0; k0 < K; k0 += 32) {
            { const int row = tid >> 2, kc = (tid & 3) * 8; const u32x4 v = *(const u32x4*)(A + (size_t)(m0 + row) * lda + k0 + kc); LAS float* d = As + row * 33 + kc;
              d[0] = bflo(v.x); d[1] = bfhi(v.x); d[2] = bflo(v.y); d[3] = bfhi(v.y); d[4] = bflo(v.z); d[5] = bfhi(v.z); d[6] = bflo(v.w); d[7] = bfhi(v.w); }
            if (tid < 256) { const int row = tid >> 2, kc = (tid & 3) * 8; const u32x4 v = *(const u32x4*)(Bt + (size_t)(n0 + row) * K + k0 + kc); LAS float* d = Bs + row * 33 + kc;
              d[0] = bflo(v.x); d[1] = bfhi(v.x); d[2] = bflo(v.y); d[3] = bfhi(v.y); d[4] = bflo(v.z); d[5] = bfhi(v.z); d[6] = bflo(v.w); d[7] = bfhi(v.w); }
            else if (SW) { const int t2 = tid - 256; const int row = t2 >> 2, kc = (t2 & 3) * 8; const u32x4 v = *(const u32x4*)(Bt + (size_t)(n0 + 128 + row) * K + k0 + kc); LAS float* d = Bs2 + row * 33 + kc;
              d[0] = bflo(v.x); d[1] = bfhi(v.x); d[2] = bflo(v.y); d[3] = bfhi(v.y); d[4] = bflo(v.z); d[5] = bfhi(v.z); d[6] = bflo(v.w); d[7] = bfhi(v.w); }
            __syncthreads();
#pragma unroll 8
            for (int kk = 0; kk < 32; ++kk) {
                float a[4], b[4], b2[4];
#pragma unroll
                for (int i = 0; i < 4; ++i) a[i] = As[(ty * 4 + i) * 33 + kk];
#pragma unroll
                for (int j = 0; j < 4; ++j) { b[j] = Bs[(tx * 4 + j) * 33 + kk]; if (SW) b2[j] = Bs2[(tx * 4 + j) * 33 + kk]; }
#pragma unroll
                for (int i = 0; i < 4; ++i)
#pragma unroll
                    for (int j = 0; j < 4; ++j) { acc[i][j] += a[i] * b[j]; if (SW) acc2[i][j] += a[i] * b2[j]; }
            }
            __syncthreads();
        }
#pragma unroll
        for (int i = 0; i < 4; ++i)
#pragma unroll
            for (int j = 0; j < 4; ++j) {
                if constexpr (SW) E.elem2(m0 + ty * 4 + i, (tn >> 1) * 128 + (tn & 1) * 64 + tx * 4 + j, acc[i][j], acc2[i][j]);
                else E.elem(m0 + ty * 4 + i, n0 + tx * 4 + j, acc[i][j]);
            }
    }
}

namespace pg8 {
#define PG8_LAS __attribute__((address_space(3)))
typedef unsigned short bf16_t;
typedef short bf16x8 __attribute__((ext_vector_type(8)));
typedef float f32x4 __attribute__((ext_vector_type(4)));
typedef unsigned u32x4 __attribute__((ext_vector_type(4)));
constexpr int BM = 256, BK = 64, HALF = 128, HTB = HALF * BK * 2  , STAGE_BYTES = 8 * HTB, NXCD = 8, WGM = 8;

__host__ __device__ __forceinline__ int lds_byte(int r, int c) { const int st = (r >> 4) * 2 + (c >> 5), rr = r & 15, cc = c & 31, ob = rr * 64 + cc * 2; return st * 1024 + (ob ^ (((ob >> 9) & 1) << 5)); }
__host__ __device__ __forceinline__ void stage_rc(int b, int& R, int& C) { const int st = b / 1024, sb = b % 1024, swz = sb ^ (((sb >> 9) & 1) << 5); R = (st >> 1) * 16 + swz / 64; C = (st & 1) * 32 + (swz % 64) / 2; }
__host__ __device__ __forceinline__ int perm32(int rho) { const int n = rho >> 4, i = rho & 15; return 8 * (i >> 2) + 4 * n + (i & 3); }

struct Unit { int pm, pn; };
struct Gemm { const bf16_t* A; const bf16_t* Bt; int M, N, K, lda; };

struct StaticOrder {
    int nM, nN, nwg, G, c;
    __host__ __device__ void init(int M, int N, int G_, int c_) { nM = M / BM; nN = N / BM; nwg = nM * nN; G = G_; c = c_; }
    __host__ __device__ bool next(int i, Unit& u) const {
        const long L = (long)i * G + c; if (L >= nwg) return false;
        int wgid = (int)L; { const int q = nwg / NXCD, r = nwg % NXCD, xcd = wgid % NXCD, off = wgid / NXCD; wgid = (xcd < r ? xcd * (q + 1) : r * (q + 1) + (xcd - r) * q) + off; }
        const int nig = WGM * nN, gid = wgid / nig, fm = gid * WGM, gsz = (nM - fm) < WGM ? (nM - fm) : WGM;
        u.pm = fm + ((wgid % nig) % gsz); u.pn = (wgid % nig) / gsz; return true;
    }
    __device__ __forceinline__ void a_ready(const Unit&) const {}
    __device__ __forceinline__ void done(const Unit&) const {}
};
__device__ __forceinline__ unsigned cvt_pk_bf16(float lo, float hi) { unsigned r; asm volatile("v_cvt_pk_bf16_f32 %0, %1, %2" : "=v"(r) : "v"(lo), "v"(hi)); return r; }

__device__ __forceinline__ float silu1(float x) { return x * __builtin_amdgcn_rcpf(1.f + __expf(-x)); }
struct EpiSwigluT { static constexpr bool PERM = true, AFTER_DRAIN = false; bf16_t* H;
    __device__ __forceinline__ void operator()(const f32x4 (&acc)[2][2][4][2], const Unit& u, int wr, int wc, int fr, int fq) const {
        const int row0 = u.pm * BM + wr * 64 + fr, col0 = u.pn * HALF + wc * 32 + 8 * fq;
#pragma unroll
        for (int ai = 0; ai < 2; ++ai)
#pragma unroll
            for (int m = 0; m < 4; ++m) { bf16_t* rowp = H + (size_t)(row0 + ai * HALF + m * 16) * 2816 + col0;
                const f32x4 a0 = acc[ai][0][m][0], a1 = acc[ai][0][m][1], u0 = acc[ai][1][m][0], u1 = acc[ai][1][m][1]; u32x4 w;
                w.x = cvt_pk_bf16(silu1(a0[0]) * u0[0], silu1(a0[1]) * u0[1]); w.y = cvt_pk_bf16(silu1(a0[2]) * u0[2], silu1(a0[3]) * u0[3]);
                w.z = cvt_pk_bf16(silu1(a1[0]) * u1[0], silu1(a1[1]) * u1[1]); w.w = cvt_pk_bf16(silu1(a1[2]) * u1[2], silu1(a1[3]) * u1[3]);
                *(u32x4*)rowp = w; }
    }
};
struct EpiResidT { static constexpr bool PERM = false, AFTER_DRAIN = false; const float* xsrc; float* out; const float* gate; float f;
    __device__ __forceinline__ void operator()(const f32x4 (&acc)[2][2][4][2], const Unit& u, int wr, int wc, int fr, int fq) const {
        const int row0 = u.pm * BM + wr * 64 + fr, col0 = u.pn * BM + wc * 32 + 4 * fq; const int b = (u.pm * BM) / 4096;
#pragma unroll
        for (int bj = 0; bj < 2; ++bj)
#pragma unroll
            for (int n = 0; n < 2; ++n) { const int c = col0 + bj * HALF + n * 16; const f32x4 gv = *(const f32x4*)(gate + (size_t)b * 9216 + c) * f;
#pragma unroll
                for (int ai = 0; ai < 2; ++ai)
#pragma unroll
                    for (int m = 0; m < 4; ++m) { const size_t off = (size_t)(row0 + ai * HALF + m * 16) * 1024 + c; *(f32x4*)(out + off) = *(const f32x4*)(xsrc + off) + gv * acc[ai][bj][m][n]; } }
    }
};
struct EpiInT { static constexpr bool PERM = true, AFTER_DRAIN = false; bf16_t* P; float* DT; bf16_t* HALO;
    __device__ __forceinline__ void operator()(const f32x4 (&acc)[2][2][4][2], const Unit& u, int wr, int wc, int fr, int fq) const {
        const int row0 = u.pm * BM + wr * 64 + fr;
        if (u.pn < 22) { const int col0 = u.pn * BM + wc * 32 + 8 * fq;
#pragma unroll
            for (int ai = 0; ai < 2; ++ai)
#pragma unroll
                for (int m = 0; m < 4; ++m) { const int row = row0 + ai * HALF + m * 16;
#pragma unroll
                    for (int bj = 0; bj < 2; ++bj) { const f32x4 v0 = acc[ai][bj][m][0], v1 = acc[ai][bj][m][1]; u32x4 w;
                        w.x = cvt_pk_bf16(v0[0], v0[1]); w.y = cvt_pk_bf16(v0[2], v0[3]); w.z = cvt_pk_bf16(v1[0], v1[1]); w.w = cvt_pk_bf16(v1[2], v1[3]);
                        *(u32x4*)(P + (size_t)row * 5632 + col0 + bj * HALF) = w;
                        if (m == 3 && u.pn >= 16 && wr == 1 && fr >= 13) *(u32x4*)(HALO + ((size_t)((row >> 7) + 1) * 3 + (fr - 13)) * 1536 + (col0 + bj * HALF - 4096)) = w; } }
        } else if (wc == 0 && fq < 2) {
#pragma unroll
            for (int ai = 0; ai < 2; ++ai)
#pragma unroll
                for (int m = 0; m < 4; ++m) { const int row = row0 + ai * HALF + m * 16;
#pragma unroll
                    for (int n = 0; n < 2; ++n) *(f32x4*)(DT + (size_t)row * 16 + 8 * fq + 4 * n) = acc[ai][0][m][n]; }
        }
    }
};

template <class Epi, class Sched, bool ALIGN_EPI = false, bool SP2 = false>
__device__ __forceinline__ void gemm_phase(PG8_LAS unsigned char* lds, const Gemm g, const Sched& S, const Epi& E, const int tid) {
    const int wid = __builtin_amdgcn_readfirstlane(tid >> 6), lane = tid & 63, wr = wid >> 2, wc = wid & 3, fr = lane & 15, fq = lane >> 4;
    const int K = g.K, nt = K / BK;
    unsigned voffA[2], voffB[2];
#pragma unroll
    for (int i = 0; i < 2; ++i) { int R, C; stage_rc(tid * 16 + i * 8192, R, C); const int Rb = Epi::PERM ? ((R & ~31) + perm32(R & 31)) : R;
        voffA[i] = (unsigned)(R * g.lda + C) * 2u; voffB[i] = (unsigned)(Rb * K + C) * 2u; }
    const size_t kstep = (size_t)(BK * 2);
    const size_t hstep = (size_t)HALF * K * 2, hstepA = (size_t)HALF * g.lda * 2;
    const size_t tstep = 2 * hstep, tstepA = 2 * hstepA;
    const unsigned ldsw = (unsigned)wid * 1024u;
    const int aoff = lds_byte(wr * 64 + fr, fq * 8), boff = lds_byte(wc * 32 + fr, fq * 8);
#define PG8_SA(b, h) (((b) * 2 + (h)) * HTB)
#define PG8_SB(b, h) ((4 + (b) * 2 + (h)) * HTB)
#define PG8_STAGE(bufoff, gbase, voff) do { _Pragma("unroll") for (int _i = 0; _i < 2; ++_i) \
        __builtin_amdgcn_global_load_lds((const unsigned*)((const char*)(gbase) + (voff)[_i]), (PG8_LAS unsigned*)(lds + (bufoff) + ldsw + _i * 8192), 16, 0, 0); } while (0)
#define PG8_LDA(dst, b, h) do { _Pragma("unroll") for (int m = 0; m < 4; ++m) _Pragma("unroll") for (int k = 0; k < 2; ++k) dst[m][k] = *(const PG8_LAS bf16x8*)(lds + PG8_SA(b, h) + aoff + m * 2048 + k * 1024); } while (0)
#define PG8_LDB(dst, b, h) do { _Pragma("unroll") for (int n = 0; n < 2; ++n) _Pragma("unroll") for (int k = 0; k < 2; ++k) dst[n][k] = *(const PG8_LAS bf16x8*)(lds + PG8_SB(b, h) + boff + n * 2048 + k * 1024); } while (0)
#define PG8_MMA(ai, bj, At, Bt) do { __builtin_amdgcn_s_setprio(1); _Pragma("unroll") for (int m = 0; m < 4; ++m) _Pragma("unroll") for (int n = 0; n < 2; ++n) _Pragma("unroll") for (int k = 0; k < 2; ++k) \
        acc[ai][bj][m][n] = __builtin_amdgcn_mfma_f32_16x16x32_bf16(Bt[n][k], At[m][k], acc[ai][bj][m][n], 0, 0, 0); __builtin_amdgcn_s_setprio(0); } while (0)
#define PG8_WAIT_V(n) asm volatile("s_waitcnt vmcnt(" #n ")" ::: "memory")
#define PG8_WAIT_L(n) asm volatile("s_waitcnt lgkmcnt(" #n ")" ::: "memory")
#define PG8_BAR __builtin_amdgcn_s_barrier()
#define PG8_SCHED __builtin_amdgcn_sched_barrier(0)
    Unit cur, nxt; int ui = 0;
    if (!S.next(0, cur)) return;
    f32x4 acc[2][2][4][2];
#pragma unroll
    for (int a = 0; a < 2; ++a)
#pragma unroll
        for (int b = 0; b < 2; ++b)
#pragma unroll
            for (int m = 0; m < 4; ++m)
#pragma unroll
                for (int n = 0; n < 2; ++n) acc[a][b][m][n] = (f32x4){0.f, 0.f, 0.f, 0.f};
    bf16x8 At[4][2], B0[2][2], B1[2][2];
    const char* cA = (const char*)g.A + (size_t)cur.pm * tstepA; const char* cB = (const char*)g.Bt + (size_t)cur.pn * tstep;
    S.a_ready(cur);
    if constexpr (SP2) {
        PG8_STAGE(PG8_SB(0, 0), cB, voffB); PG8_STAGE(PG8_SB(0, 1), cB + hstep, voffB); PG8_STAGE(PG8_SA(0, 0), cA, voffA); PG8_STAGE(PG8_SA(0, 1), cA + hstepA, voffA);
        if (wr == 1) PG8_BAR;
        PG8_WAIT_V(2); PG8_BAR;
        PG8_STAGE(PG8_SB(1, 0), cB + kstep, voffB); PG8_STAGE(PG8_SA(1, 0), cA + kstep, voffA); PG8_STAGE(PG8_SB(1, 1), cB + hstep + kstep, voffB);
        PG8_WAIT_V(6); PG8_BAR;
    } else {
        PG8_STAGE(PG8_SB(0, 0), cB, voffB); PG8_STAGE(PG8_SA(0, 0), cA, voffA); PG8_STAGE(PG8_SB(0, 1), cB + hstep, voffB); PG8_STAGE(PG8_SA(0, 1), cA + hstepA, voffA);
        if (wr == 1) PG8_BAR;
        PG8_WAIT_V(4); PG8_BAR;
        PG8_STAGE(PG8_SB(1, 0), cB + kstep, voffB); PG8_STAGE(PG8_SA(1, 0), cA + kstep, voffA); PG8_STAGE(PG8_SB(1, 1), cB + hstep + kstep, voffB);
        PG8_WAIT_V(6); PG8_BAR;
    }
    for (;;) {
        const bool has_next = S.next(ui + 1, nxt);
        const char* nA = has_next ? (const char*)g.A + (size_t)nxt.pm * tstepA : cA; const char* nB = has_next ? (const char*)g.Bt + (size_t)nxt.pn * tstep : cB;
        for (int t = 0; t < nt; t += 2) {
            const bool last = (t == nt - 2);
            const char* a1 = cA + (size_t)(t + 1) * kstep;
            const char* a2 = last ? nA : cA + (size_t)(t + 2) * kstep; const char* b2 = last ? nB : cB + (size_t)(t + 2) * kstep;
            const char* a3 = a2 + kstep; const char* b3 = b2 + kstep;
            if (last && has_next) S.a_ready(nxt);
            if constexpr (SP2) {
            PG8_LDB(B0, 0, 0); PG8_LDB(B1, 0, 1); PG8_SCHED; PG8_LDA(At, 0, 0); PG8_STAGE(PG8_SA(1, 1), a1 + hstepA, voffA);
            PG8_WAIT_V(8); PG8_WAIT_L(0); PG8_BAR; PG8_MMA(0, 0, At, B0); PG8_MMA(0, 1, At, B1); PG8_BAR; PG8_SCHED;
            PG8_LDA(At, 0, 1); PG8_STAGE(PG8_SB(0, 0), b2, voffB); PG8_STAGE(PG8_SB(0, 1), b2 + hstep, voffB); PG8_STAGE(PG8_SA(0, 0), a2, voffA);
            PG8_WAIT_V(8); PG8_WAIT_L(0); PG8_BAR; PG8_MMA(1, 0, At, B0); PG8_MMA(1, 1, At, B1); PG8_BAR; PG8_SCHED;
            PG8_LDB(B0, 1, 0); PG8_LDB(B1, 1, 1); PG8_SCHED; PG8_LDA(At, 1, 0); PG8_STAGE(PG8_SA(0, 1), a2 + hstepA, voffA);
            PG8_WAIT_V(8); PG8_WAIT_L(0); PG8_BAR; PG8_MMA(0, 0, At, B0); PG8_MMA(0, 1, At, B1); PG8_BAR; PG8_SCHED;
            PG8_LDA(At, 1, 1); PG8_STAGE(PG8_SB(1, 0), b3, voffB); PG8_STAGE(PG8_SB(1, 1), b3 + hstep, voffB); PG8_STAGE(PG8_SA(1, 0), a3, voffA);
            PG8_WAIT_V(8); PG8_WAIT_L(0); PG8_BAR; PG8_MMA(1, 0, At, B0); PG8_MMA(1, 1, At, B1); PG8_BAR; PG8_SCHED;
            } else {
            PG8_LDB(B0, 0, 0); PG8_SCHED; PG8_LDA(At, 0, 0); PG8_STAGE(PG8_SA(1, 1), a1 + hstepA, voffA);
            PG8_WAIT_L(8); PG8_BAR; PG8_WAIT_L(0); PG8_MMA(0, 0, At, B0); PG8_BAR; PG8_SCHED;
            PG8_LDB(B1, 0, 1); PG8_STAGE(PG8_SB(0, 0), b2, voffB);
            PG8_BAR; PG8_WAIT_L(0); PG8_MMA(0, 1, At, B1); PG8_BAR;
            PG8_LDA(At, 0, 1); PG8_STAGE(PG8_SA(0, 0), a2, voffA);
            PG8_BAR; PG8_WAIT_L(0); PG8_MMA(1, 0, At, B0); PG8_BAR; PG8_SCHED;
            PG8_STAGE(PG8_SB(0, 1), b2 + hstep, voffB);
            PG8_WAIT_V(6); PG8_BAR; PG8_MMA(1, 1, At, B1); PG8_BAR;
            PG8_LDB(B0, 1, 0); PG8_SCHED; PG8_LDA(At, 1, 0); PG8_STAGE(PG8_SA(0, 1), a2 + hstepA, voffA);
            PG8_WAIT_L(8); PG8_BAR; PG8_WAIT_L(0); PG8_MMA(0, 0, At, B0); PG8_BAR; PG8_SCHED;
            PG8_LDB(B1, 1, 1); PG8_STAGE(PG8_SB(1, 0), b3, voffB);
            PG8_BAR; PG8_WAIT_L(0); PG8_MMA(0, 1, At, B1); PG8_BAR;
            PG8_LDA(At, 1, 1); PG8_STAGE(PG8_SA(1, 0), a3, voffA);
            PG8_BAR; PG8_WAIT_L(0); PG8_MMA(1, 0, At, B0); PG8_BAR; PG8_SCHED;
            PG8_STAGE(PG8_SB(1, 1), b3 + hstep, voffB);
            PG8_WAIT_V(6); PG8_BAR; PG8_MMA(1, 1, At, B1); PG8_BAR;
            }
        }
        if constexpr (ALIGN_EPI) { if (wr == 0) PG8_BAR; }
        if constexpr (!Epi::AFTER_DRAIN) { E(acc, cur, wr, wc, fr, fq); S.done(cur); }
        if (!has_next) break;
#pragma unroll
        for (int a = 0; a < 2; ++a)
#pragma unroll
            for (int b = 0; b < 2; ++b)
#pragma unroll
                for (int m = 0; m < 4; ++m)
#pragma unroll
                    for (int n = 0; n < 2; ++n) acc[a][b][m][n] = (f32x4){0.f, 0.f, 0.f, 0.f};
        cur = nxt; cA = nA; cB = nB; ++ui;
        if constexpr (ALIGN_EPI) { if (wr == 1) PG8_BAR; }
    }
    PG8_WAIT_V(0);
    if constexpr (!ALIGN_EPI) { if (wr == 0) PG8_BAR; }
    PG8_BAR;
    if constexpr (Epi::AFTER_DRAIN) { E.fused(acc, cur, wr, wc, fr, fq, lds, wid, lane); S.done(cur); }
#undef PG8_SA
#undef PG8_SB
#undef PG8_STAGE
#undef PG8_LDA
#undef PG8_LDB
#undef PG8_MMA
#undef PG8_WAIT_V
#undef PG8_WAIT_L
#undef PG8_BAR
#undef PG8_SCHED
}
}
DEV void ph_conv(const Params& p, int l, int tid) {
    bf16_t* P = (bf16_t*)(p.ws + WS_P); const bf16_t* HALO = (const bf16_t*)(p.ws + WS_HALO);
    const float* cw = p.in[I_CW] + (size_t)l * 1536 * 4; const float* cb = p.in[I_CB] + (size_t)l * 1536;
    for (int task = BIDX * NTHREADS + tid; task < GCH * 768; task += GDIM * NTHREADS) {
        const int gc = task / 768, ch = (task % 768) * 2; const int r0 = gc * CH;
        const f32x4 w0 = *(const f32x4*)(cw + ch * 4), w1 = *(const f32x4*)(cw + ch * 4 + 4); const float b0 = cb[ch], b1 = cb[ch + 1];
        float a3 = 0.f, a2 = 0.f, a1 = 0.f, c3 = 0.f, c2 = 0.f, c1 = 0.f;
        if (gc % NCHUNK != 0) { const bf16_t* hp = HALO + (size_t)gc * 3 * 1536 + ch;
            const unsigned h0 = *(const unsigned*)(hp), h1 = *(const unsigned*)(hp + 1536), h2 = *(const unsigned*)(hp + 2 * 1536);
            a3 = bflo(h0); c3 = bfhi(h0); a2 = bflo(h1); c2 = bfhi(h1); a1 = bflo(h2); c1 = bfhi(h2); }
        unsigned* col = (unsigned*)(P + (size_t)r0 * PW + PXBC + ch);
        for (int i = 0; i < CH; ++i) {
            const unsigned raw = col[(size_t)i * (PW / 2)]; const float a0 = bflo(raw), c0 = bfhi(raw);
            const float ya = b0 + w0.x * a3 + w0.y * a2 + w0.z * a1 + w0.w * a0, yc = b1 + w1.x * c3 + w1.y * c2 + w1.z * c1 + w1.w * c0;
            col[(size_t)i * (PW / 2)] = pk2(siluf(ya), siluf(yc));
            a3 = a2; a2 = a1; a1 = a0; c3 = c2; c2 = c1; c1 = c0;
        }
    }
}

DEV void ssd_head_scalars(const Params& p, int l, int r0, int h, LAS float* s_dt, LAS float* s_ac, int tid, int wave, int lane) {
    const float* DT = (const float*)(p.ws + WS_DT);
    if (tid < CH) { const float dtv = softplusf(DT[(size_t)(r0 + tid) * 16 + h] + p.in[I_DTB][l * 16 + h]); s_dt[tid] = dtv; s_ac[tid] = dtv * (-__expf(p.in[I_ALOG][l * 16 + h])); }
    __syncthreads();
    if (wave == 0) { const float v0 = s_ac[2 * lane], v1 = s_ac[2 * lane + 1]; const float s = v0 + v1; const float inc = wave_incl_scan(s, lane); s_ac[2 * lane] = inc - s + v0; s_ac[2 * lane + 1] = inc; }
    __syncthreads();
}
DEV void ph_ssd_state(const Params& p, int l, LAS unsigned char* lds, int tid, int wave, int lane) {
    LAS bf16_t* Bs = (LAS bf16_t*)lds;
    LAS float* xdd = (LAS float*)(lds + 34816);
    LAS float* s_dt = (LAS float*)(lds + 34816 + 32768);
    LAS float* s_ac = s_dt + 128;
    const bf16_t* P = (const bf16_t*)(p.ws + WS_P); float* ST = (float*)(p.ws + WS_ST); float* CD = (float*)(p.ws + WS_CD);
    for (int unit = BIDX; unit < GCH * 16; unit += GDIM) {
        const int gc = unit >> 4, h = unit & 15, g = h >> 3, r0 = gc * CH;
        __syncthreads();
        ssd_head_scalars(p, l, r0, h, s_dt, s_ac, tid, wave, lane);
        { const int row = tid >> 2, c0 = (tid & 3) * 32; const bf16_t* src = P + (size_t)(r0 + row) * PW + PBM + g * 128 + c0;
#pragma unroll
          for (int q = 0; q < 4; ++q) *(LAS u32x4*)(Bs + row * 136 + c0 + q * 8) = *(const u32x4*)(src + q * 8); }
        { const int row = tid >> 2, p0 = (tid & 3) * 16; const bf16_t* src = P + (size_t)(r0 + row) * PW + PXS + h * 64 + p0; const float f = s_dt[row] * __expf(s_ac[127] - s_ac[row]);
#pragma unroll
          for (int q = 0; q < 2; ++q) { const u32x4 v = *(const u32x4*)(src + q * 8); LAS float* d = xdd + row * 64 + p0 + q * 8;
              d[0] = bflo(v.x) * f; d[1] = bfhi(v.x) * f; d[2] = bflo(v.y) * f; d[3] = bfhi(v.y) * f; d[4] = bflo(v.z) * f; d[5] = bfhi(v.z) * f; d[6] = bflo(v.w) * f; d[7] = bfhi(v.w) * f; } }
        __syncthreads();
        const int pp = tid >> 3, ng = tid & 7; float acc[16];
#pragma unroll
        for (int j = 0; j < 16; ++j) acc[j] = 0.f;
        for (int ll = 0; ll < CH; ++ll) { const float xv = xdd[ll * 64 + pp]; const u32x4 b0 = *(const LAS u32x4*)(Bs + ll * 136 + ng * 16), b1 = *(const LAS u32x4*)(Bs + ll * 136 + ng * 16 + 8);
            acc[0] += xv * bflo(b0.x); acc[1] += xv * bfhi(b0.x); acc[2] += xv * bflo(b0.y); acc[3] += xv * bfhi(b0.y); acc[4] += xv * bflo(b0.z); acc[5] += xv * bfhi(b0.z); acc[6] += xv * bflo(b0.w); acc[7] += xv * bfhi(b0.w);
            acc[8] += xv * bflo(b1.x); acc[9] += xv * bfhi(b1.x); acc[10] += xv * bflo(b1.y); acc[11] += xv * bfhi(b1.y); acc[12] += xv * bflo(b1.z); acc[13] += xv * bfhi(b1.z); acc[14] += xv * bflo(b1.w); acc[15] += xv * bfhi(b1.w); }
        float* dst = ST + (((size_t)gc * 16 + h) * 64 + pp) * 128 + ng * 16;
#pragma unroll
        for (int q = 0; q < 4; ++q) *(f32x4*)(dst + q * 4) = (f32x4){acc[q * 4], acc[q * 4 + 1], acc[q * 4 + 2], acc[q * 4 + 3]};
        if (tid == 0) CD[gc * 16 + h] = __expf(s_ac[127]);
    }
}
DEV void ph_ssd_scan(const Params& p, int tid) {
    float* ST = (float*)(p.ws + WS_ST); const float* CD = (const float*)(p.ws + WS_CD);
    for (int e = BIDX * NTHREADS + tid; e < NB * 16 * 64 * 128; e += GDIM * NTHREADS) {
        const int b = e >> 17, h = (e >> 13) & 15, pn = e & 8191; float hc = 0.f;
        for (int c = 0; c < NCHUNK; ++c) { const int gc = b * NCHUNK + c; const size_t idx = ((size_t)gc * 16 + h) * 8192 + pn; const float t = ST[idx]; ST[idx] = hc; hc = hc * CD[gc * 16 + h] + t; }
    }
}
DEV void ph_ssd_out(const Params& p, int l, LAS unsigned char* lds, int tid, int wave, int lane) {
    LAS bf16_t* Cs = (LAS bf16_t*)lds;
    LAS bf16_t* Bs = (LAS bf16_t*)(lds + 34816);
    LAS float* prev = (LAS float*)(lds + 34816);
    LAS bf16_t* CBs = (LAS bf16_t*)(lds + 2 * 34816);
    LAS float* xd = (LAS float*)(lds + 3 * 34816);
    LAS float* s_dt = (LAS float*)(lds + 4 * 34816); LAS float* s_ac = s_dt + 128; LAS float* s_ss = s_dt + 256;
    bf16_t* P = (bf16_t*)(p.ws + WS_P); const float* ST = (const float*)(p.ws + WS_ST); float* ROWSS = (float*)(p.ws + WS_ROWSS);
    for (int unit = BIDX; unit < GCH * 2; unit += GDIM) {
        const int gc = unit >> 1, g = unit & 1, r0 = gc * CH;
        __syncthreads();
        { const int row = tid >> 2, c0 = (tid & 3) * 32; const bf16_t* sc = P + (size_t)(r0 + row) * PW + PCM + g * 128 + c0; const bf16_t* sb = P + (size_t)(r0 + row) * PW + PBM + g * 128 + c0;
#pragma unroll
          for (int q = 0; q < 4; ++q) { *(LAS u32x4*)(Cs + row * 136 + c0 + q * 8) = *(const u32x4*)(sc + q * 8); *(LAS u32x4*)(Bs + row * 136 + c0 + q * 8) = *(const u32x4*)(sb + q * 8); } }
        if (tid < CH) s_ss[tid] = 0.f;
        __syncthreads();
        { const int lr = tid >> 2, s0 = (tid & 3) * 32; float acc[32];
#pragma unroll
          for (int j = 0; j < 32; ++j) acc[j] = 0.f;
          for (int n = 0; n < 128; n += 8) { const u32x4 cv = *(const LAS u32x4*)(Cs + lr * 136 + n);
              const float c0 = bflo(cv.x), c1 = bfhi(cv.x), c2 = bflo(cv.y), c3 = bfhi(cv.y), c4 = bflo(cv.z), c5 = bfhi(cv.z), c6 = bflo(cv.w), c7 = bfhi(cv.w);
#pragma unroll
              for (int j = 0; j < 32; ++j) { const u32x4 bv = *(const LAS u32x4*)(Bs + (s0 + j) * 136 + n);
                  acc[j] += c0 * bflo(bv.x) + c1 * bfhi(bv.x) + c2 * bflo(bv.y) + c3 * bfhi(bv.y) + c4 * bflo(bv.z) + c5 * bfhi(bv.z) + c6 * bflo(bv.w) + c7 * bfhi(bv.w); } }
#pragma unroll
          for (int j = 0; j < 32; j += 2) *(LAS unsigned*)(CBs + lr * 136 + s0 + j) = pk2(acc[j], acc[j + 1]); }
        for (int e = 0; e < 8; ++e) {
            const int h = g * 8 + e;
            __syncthreads();
            ssd_head_scalars(p, l, r0, h, s_dt, s_ac, tid, wave, lane);
            { const int pp = tid >> 3, n0 = (tid & 7) * 16; const float* src = ST + (((size_t)gc * 16 + h) * 64 + pp) * 128 + n0;
#pragma unroll
              for (int q = 0; q < 4; ++q) { const f32x4 v = *(const f32x4*)(src + q * 4); LAS float* d = prev + pp * 129 + n0 + q * 4; d[0] = v.x; d[1] = v.y; d[2] = v.z; d[3] = v.w; } }
            const int lr = tid >> 2, p0 = (tid & 3) * 16; float xraw[16];
            { const bf16_t* src = P + (size_t)(r0 + lr) * PW + PXS + h * 64 + p0; const float f = s_dt[lr];
#pragma unroll
              for (int q = 0; q < 2; ++q) { const u32x4 v = *(const u32x4*)(src + q * 8);
                  xraw[q * 8 + 0] = bflo(v.x); xraw[q * 8 + 1] = bfhi(v.x); xraw[q * 8 + 2] = bflo(v.y); xraw[q * 8 + 3] = bfhi(v.y); xraw[q * 8 + 4] = bflo(v.z); xraw[q * 8 + 5] = bfhi(v.z); xraw[q * 8 + 6] = bflo(v.w); xraw[q * 8 + 7] = bfhi(v.w); }
#pragma unroll
              for (int j = 0; j < 16; ++j) xd[lr * 68 + p0 + j] = xraw[j] * f; }
            __syncthreads();
            float y[16], yo[16];
#pragma unroll
            for (int j = 0; j < 16; ++j) { y[j] = 0.f; yo[j] = 0.f; }
            const float al = s_ac[lr];
            for (int s = 0; s <= lr; ++s) { const float cb = bf2f(CBs[lr * 136 + s]) * __expf(al - s_ac[s]);
#pragma unroll
                for (int q = 0; q < 4; ++q) { const f32x4 xv = *(const LAS f32x4*)(xd + s * 68 + p0 + q * 4); y[q * 4] += cb * xv.x; y[q * 4 + 1] += cb * xv.y; y[q * 4 + 2] += cb * xv.z; y[q * 4 + 3] += cb * xv.w; } }
            for (int n = 0; n < 128; ++n) { const float c = bf2f(Cs[lr * 136 + n]);
#pragma unroll
                for (int j = 0; j < 16; ++j) yo[j] += c * prev[(p0 + j) * 129 + n]; }
            const float ea = __expf(al), dh = p.in[I_SD][l * 16 + h];
            bf16_t* zp = P + (size_t)(r0 + lr) * PW + PZ + h * 64 + p0; float ssl = 0.f; unsigned ow[8];
            { const u32x4 z0 = *(const u32x4*)zp, z1 = *(const u32x4*)(zp + 8); float zz[16];
              zz[0] = bflo(z0.x); zz[1] = bfhi(z0.x); zz[2] = bflo(z0.y); zz[3] = bfhi(z0.y); zz[4] = bflo(z0.z); zz[5] = bfhi(z0.z); zz[6] = bflo(z0.w); zz[7] = bfhi(z0.w);
              zz[8] = bflo(z1.x); zz[9] = bfhi(z1.x); zz[10] = bflo(z1.y); zz[11] = bfhi(z1.y); zz[12] = bflo(z1.z); zz[13] = bfhi(z1.z); zz[14] = bflo(z1.w); zz[15] = bfhi(z1.w);
#pragma unroll
              for (int j = 0; j < 16; ++j) { const float v = (y[j] + ea * yo[j] + dh * xraw[j]) * siluf(zz[j]); ssl += v * v; y[j] = v; }
#pragma unroll
              for (int j = 0; j < 8; ++j) ow[j] = pk2(y[2 * j], y[2 * j + 1]); }
            *(u32x4*)zp = (u32x4){ow[0], ow[1], ow[2], ow[3]}; *(u32x4*)(zp + 8) = (u32x4){ow[4], ow[5], ow[6], ow[7]};
            ssl += __shfl_xor(ssl, 1); ssl += __shfl_xor(ssl, 2);
            if ((tid & 3) == 0) s_ss[lr] += ssl;
        }
        __syncthreads();
        if (tid < CH) ROWSS[(size_t)(r0 + tid) * 2 + g] = s_ss[tid];
    }
}
DEV void ph_mixfinal(const Params& p, int l, int tid) {
    bf16_t* P = (bf16_t*)(p.ws + WS_P); const float* ROWSS = (const float*)(p.ws + WS_ROWSS); const float* ng = p.in[I_SN] + (size_t)l * 1024;
    for (int e = BIDX * NTHREADS + tid; e < M * 512; e += GDIM * NTHREADS) {
        const int row = e >> 9, c = (e & 511) * 2; const float rs = rsqrtf(ROWSS[(size_t)row * 2 + (c >> 9)] * (1.f / 512.f) + EPS);
        unsigned* q = (unsigned*)(P + (size_t)row * PW + PZ + c); const unsigned w = *q; *q = pk2(bflo(w) * rs * ng[c], bfhi(w) * rs * ng[c + 1]);
    }
}

DEV void ph_sb_attn(const Params& p, LAS unsigned char* lds, int gw, int ngw, int wave, int lane) {
    LAS float* qs = (LAS float*)(lds + 65536 + wave * 512);
    bf16_t* P = (bf16_t*)(p.ws + WS_P);
    for (int task = gw; task < NB * 8 * S; task += ngw) {
        const int t = task % S, bh = task / S, h = bh & 7, b = bh >> 3; const size_t rowb = (size_t)b * S;
        bf16_t* qp = P + (rowb + t) * PW + PSQ + h * 64;
        qs[lane] = bf2f(qp[lane]) * 0.125f; LDS_WAIT();
        float o = 0.f, R = 0.f;
        for (int k1 = t - 1; k1 >= 0; k1 -= 64) {
            const int s = k1 - lane; const bool valid = s >= 0; float z = 0.f;
            if (valid) { const bf16_t* kp = P + (rowb + s) * PW + PSK + h * 64;
#pragma unroll
                for (int q = 0; q < 8; ++q) { const u32x4 kv = *(const u32x4*)(kp + q * 8); const LAS float* qq = qs + q * 8;
                    z += qq[0] * bflo(kv.x) + qq[1] * bfhi(kv.x) + qq[2] * bflo(kv.y) + qq[3] * bfhi(kv.y) + qq[4] * bflo(kv.z) + qq[5] * bfhi(kv.z) + qq[6] * bflo(kv.w) + qq[7] * bfhi(kv.w); } }
            const float Lg = valid ? -softplusf(z) : 0.f;
            const float cum = wave_incl_scan(Lg, lane);
            const float w = valid ? __expf(z + R + cum) : 0.f;
            const int nv = (k1 + 1 < 64) ? k1 + 1 : 64;
            for (int i = 0; i < nv; ++i) { const float wi = __shfl(w, i); o += wi * bf2f(P[(rowb + (k1 - i)) * PW + PSV + h * 64 + lane]); }
            R += __shfl(cum, 63);
            if (R < -104.f) break;
        }
        qp[lane] = (bf16_t)f2bf(o);
        LDS_WAIT();
    }
}
DEV void ph_diff_attn(const Params& p, int l, LAS unsigned char* lds, int gw, int ngw, int wave, int lane) {
    LAS float* qs = (LAS float*)(lds + 65536 + 4096 + wave * 512);
    bf16_t* P = (bf16_t*)(p.ws + WS_P); const float* misc = (const float*)(p.ws + WS_MISC);
    const float lam = misc[l]; const float linit = 0.8f - 0.6f * expf(-0.3f * (float)l);
    for (int task = gw; task < NB * 4 * S; task += ngw) {
        const int t = task % S, bh = task / S, h = bh & 3, b = bh >> 2; const size_t rowb = (size_t)b * S;
        bf16_t* qp = P + (rowb + t) * PW + PDQ + h * 128;
        qs[lane] = bf2f(qp[lane]) * 0.125f; qs[64 + lane] = bf2f(qp[64 + lane]) * 0.125f; LDS_WAIT();
        const float* bt = misc + 64 + h * 128;
        float m0 = -INFINITY, m1 = -INFINITY, l0 = 0.f, l1 = 0.f, o0a = 0.f, o0b = 0.f, o1a = 0.f, o1b = 0.f;
        for (int k1 = t; k1 >= 0; k1 -= 64) {
            const int s = k1 - lane; const bool valid = s >= 0; float z0 = 0.f, z1 = 0.f;
            if (valid) { const bf16_t* kp = P + (rowb + s) * PW + PDK + h * 128;
#pragma unroll
                for (int q = 0; q < 8; ++q) { const u32x4 kv = *(const u32x4*)(kp + q * 8); const LAS float* qq = qs + q * 8;
                    z0 += qq[0] * bflo(kv.x) + qq[1] * bfhi(kv.x) + qq[2] * bflo(kv.y) + qq[3] * bfhi(kv.y) + qq[4] * bflo(kv.z) + qq[5] * bfhi(kv.z) + qq[6] * bflo(kv.w) + qq[7] * bfhi(kv.w); }
#pragma unroll
                for (int q = 0; q < 8; ++q) { const u32x4 kv = *(const u32x4*)(kp + 64 + q * 8); const LAS float* qq = qs + 64 + q * 8;
                    z1 += qq[0] * bflo(kv.x) + qq[1] * bfhi(kv.x) + qq[2] * bflo(kv.y) + qq[3] * bfhi(kv.y) + qq[4] * bflo(kv.z) + qq[5] * bfhi(kv.z) + qq[6] * bflo(kv.w) + qq[7] * bfhi(kv.w); } }
            const int dist = t - s; const float bias = bt[dist < 127 ? dist : 127];
            z0 = valid ? z0 + bias : -INFINITY; z1 = valid ? z1 + bias : -INFINITY;
            const float n0 = fmaxf(m0, wave_max(z0)), n1 = fmaxf(m1, wave_max(z1));
            const float sc0 = __expf(m0 - n0), sc1 = __expf(m1 - n1);
            const float p0 = valid ? __expf(z0 - n0) : 0.f, p1 = valid ? __expf(z1 - n1) : 0.f;
            l0 = l0 * sc0 + wave_sum(p0); l1 = l1 * sc1 + wave_sum(p1); o0a *= sc0; o0b *= sc0; o1a *= sc1; o1b *= sc1; m0 = n0; m1 = n1;
            const int nv = (k1 + 1 < 64) ? k1 + 1 : 64;
            for (int i = 0; i < nv; ++i) { const float a = __shfl(p0, i), c = __shfl(p1, i); const unsigned vv = *(const unsigned*)(P + (rowb + (k1 - i)) * PW + PDV + h * 128 + 2 * lane);
                const float va = bflo(vv), vb = bfhi(vv); o0a += a * va; o0b += a * vb; o1a += c * va; o1b += c * vb; }
        }
        const float ya = o0a / l0 - lam * o1a / l1, yb = o0b / l0 - lam * o1b / l1;
        const float rs = rsqrtf(wave_sum(ya * ya + yb * yb) * (1.f / 128.f) + EPS) * (1.f - linit);
        const float* sg = p.in[I_SUB] + (size_t)l * 128 + 2 * lane;
        *(unsigned*)(qp + 2 * lane) = pk2(ya * rs * sg[0], yb * rs * sg[1]);
        LDS_WAIT();
    }
}


#define GAS __attribute__((address_space(1)))
typedef GAS unsigned gu32;
#define RLX_AGENT __ATOMIC_RELAXED, __HIP_MEMORY_SCOPE_AGENT
#define XB_TMO      128
#define XB_XCNT(j)  (256  + 64 * (j))
#define XB_XSUB(j)  (1280 + 64 * (j))
#define XB_XGEN(j)  (2304 + 64 * (j))
#define XB_TOP      3328
#define XB_TOPGEN   3392
#define XCD_BAR_WORDS 3456
#define XB_SPIN_CAP (1u << 18)

__device__ __forceinline__ unsigned xb_ld(unsigned* p)              { return __hip_atomic_load(p, __ATOMIC_RELAXED, __HIP_MEMORY_SCOPE_AGENT); }
__device__ __forceinline__ unsigned xb_add(unsigned* p, unsigned v) { return __hip_atomic_fetch_add(p, v, __ATOMIC_RELAXED, __HIP_MEMORY_SCOPE_AGENT); }
__device__ __forceinline__ unsigned xb_xcc_id() { return (unsigned)__builtin_amdgcn_s_getreg((3 << 11) | 20) & 0xFu; }
#define XB_SPIN(cond, bar) do { unsigned _sp = 0; while (cond) { __builtin_amdgcn_s_sleep(1); \
    if ((++_sp & 255u) == 0u) { if (xb_ld(&(bar)[XB_TMO])) break; if (_sp > XB_SPIN_CAP) { atomicAdd(&(bar)[XB_TMO], 1u); break; } } } } while (0)

struct XcdBarrier {
    unsigned* bar; unsigned x;
    volatile LAS unsigned* st;
};

__device__ __forceinline__ XcdBarrier xcd_barrier_post(unsigned* bar, volatile LAS unsigned* st) {
    XcdBarrier b; b.bar = bar; b.x = xb_xcc_id(); b.st = st;
    if (threadIdx.x == 0) (void)xb_add(&bar[XB_XCNT(b.x)], 1u);
    return b;
}
__device__ __forceinline__ void xcd_barrier_complete(unsigned* bar, unsigned x, unsigned& nloc, unsigned& nx) {
    const unsigned G = gridDim.x * gridDim.y * gridDim.z;
    unsigned sum, cnt, mine, sp = 0u;
    for (;;) {
        sum = 0u; cnt = 0u; mine = 0u;
#pragma unroll
        for (unsigned j = 0; j < 16; ++j) { const unsigned c = xb_ld(&bar[XB_XCNT(j)]); sum += c; cnt += (c > 0u) ? 1u : 0u; mine = (j == x) ? c : mine; }
        if (sum == G) break;
        __builtin_amdgcn_s_sleep(1);
        if ((++sp & 255u) == 0u) { if (xb_ld(&bar[XB_TMO])) break; if (sp > XB_SPIN_CAP) { atomicAdd(&bar[XB_TMO], 1u); break; } }
    }
    nloc = mine > 0u ? mine : 1u; nx = cnt > 0u ? cnt : 1u;
}

__device__ __forceinline__ void xcd_barrier(const XcdBarrier& b) {
    asm volatile("s_waitcnt vmcnt(0)" ::: "memory");
    __syncthreads();
    if (threadIdx.x == 0) {
        unsigned* bar = b.bar;
        __builtin_amdgcn_s_waitcnt(0);
        unsigned nloc = b.st[0], nx = b.st[1];
        if (nloc == 0u) { xcd_barrier_complete(bar, b.x, nloc, nx); b.st[0] = nloc; b.st[1] = nx; }
        const unsigned old = xb_add(&bar[XB_XSUB(b.x)], 1u);
        const unsigned gen = old / nloc;
        if (old + 1u == (gen + 1u) * nloc) {
            __builtin_amdgcn_fence(__ATOMIC_RELEASE, "agent");
            asm volatile("s_waitcnt vmcnt(0)" ::: "memory");
            const unsigned og = xb_add(&bar[XB_TOP], 1u);
            const unsigned tg = og / nx;
            if (og + 1u == (tg + 1u) * nx) xb_add(&bar[XB_TOPGEN], 1u);
            else XB_SPIN(xb_ld(&bar[XB_TOPGEN]) == tg, bar);
            __builtin_amdgcn_fence(__ATOMIC_ACQUIRE, "agent");
            xb_add(&bar[XB_XGEN(b.x)], 1u);
            asm volatile("s_waitcnt vmcnt(0)" ::: "memory");
        } else {
            XB_SPIN(xb_ld(&bar[XB_XGEN(b.x)]) == gen, bar);
            __builtin_amdgcn_fence(__ATOMIC_ACQUIRE, "agent");
            asm volatile("s_waitcnt vmcnt(0)" ::: "memory");
        }
    }
    __syncthreads();
}
#ifndef MK_FUSED
#define MK_FUSED 1
#endif
constexpr int PH_PER_LAYER = 15, N_PHASES = NL * PH_PER_LAYER + 1;
template <int ST>
__global__ void __launch_bounds__(NTHREADS, 2) mk_phase(Params p, int l) {
    extern __shared__ __attribute__((aligned(16))) unsigned char lds_raw[];
    LAS unsigned char* lds = (LAS unsigned char*)lds_raw;
    const int tid = threadIdx.x, lane = tid & 63, wave = __builtin_amdgcn_readfirstlane(tid >> 6);
    const int gw = BIDX * NWAVES + wave, ngw = GDIM * NWAVES;
    bf16_t* wt = (bf16_t*)(p.ws + WS_WT); bf16_t* XN = (bf16_t*)(p.ws + WS_XN); bf16_t* P = (bf16_t*)(p.ws + WS_P); bf16_t* H = (bf16_t*)(p.ws + WS_H);
    float* DT = (float*)(p.ws + WS_DT); bf16_t* HALO = (bf16_t*)(p.ws + WS_HALO); const float* mod = (const float*)(p.ws + WS_MOD);
    if constexpr (ST == 15) { ph_final_norm(p.out, p.in[I_FN], gw, ngw, lane); return; }
    const float* modl = mod + (size_t)l * NB * MODW;
    const float* xcur = (l == 0 && ST <= 3) ? p.in[I_X] : p.out;
    if constexpr (ST == 0) { ph_convert(p, l, lds, gw, ngw, wave, lane); if (l == 0) ph_mod(p, lds, tid, wave, lane); }
    if constexpr (ST == 1) ph_norm(xcur, p.in[I_N1] + (size_t)l * D, modl, 0, 1, XN, gw, ngw, lane);
    if constexpr (ST == 2) { pg8::Gemm g{XN, wt + WT_13A / 2, M, 2 * DFF, D, D}; pg8::StaticOrder So; So.init(M, 2 * DFF, (int)GDIM, (int)BIDX); pg8::EpiSwigluT E{H}; pg8::gemm_phase<pg8::EpiSwigluT, pg8::StaticOrder, true, true>(lds, g, So, E, tid); }
    if constexpr (ST == 3) { pg8::Gemm g{H, wt + WT_2A / 2, M, D, DFF, DFF}; pg8::StaticOrder So; So.init(M, D, (int)GDIM, (int)BIDX); pg8::EpiResidT E{xcur, p.out, modl + 2 * D, 0.5f}; pg8::gemm_phase<pg8::EpiResidT, pg8::StaticOrder, true, true>(lds, g, So, E, tid); }
    if constexpr (ST == 4) ph_norm(p.out, p.in[I_NM] + (size_t)l * D, modl, 3, 4, XN, gw, ngw, lane);
    if constexpr (ST == 5) { pg8::Gemm g{XN, wt + WT_IN / 2, M, NIN, D, D}; pg8::StaticOrder So; So.init(M, NIN, (int)GDIM, (int)BIDX); pg8::EpiInT E{P, DT, HALO}; pg8::gemm_phase<pg8::EpiInT, pg8::StaticOrder, true, true>(lds, g, So, E, tid); }
    if constexpr (ST == 6) ph_conv(p, l, tid);
    if constexpr (ST == 7) ph_ssd_state(p, l, lds, tid, wave, lane);
    if constexpr (ST == 16) ph_sb_attn(p, lds, gw, ngw, wave, lane);
    if constexpr (ST == 17) ph_diff_attn(p, l, lds, gw, ngw, wave, lane);
    if constexpr (ST == 8) ph_ssd_scan(p, tid);
    if constexpr (ST == 9) ph_ssd_out(p, l, lds, tid, wave, lane);
    if constexpr (ST == 10) ph_mixfinal(p, l, tid);
    if constexpr (ST == 11) { pg8::Gemm g{P, wt + WT_OUT / 2, M, D, 2048, PW}; pg8::StaticOrder So; So.init(M, D, (int)GDIM, (int)BIDX); pg8::EpiResidT E{p.out, p.out, modl + 5 * D, 1.0f}; pg8::gemm_phase<pg8::EpiResidT, pg8::StaticOrder, true, true>(lds, g, So, E, tid); }
    if constexpr (ST == 12) ph_norm(p.out, p.in[I_N2] + (size_t)l * D, modl, 6, 7, XN, gw, ngw, lane);
    if constexpr (ST == 13) { pg8::Gemm g{XN, wt + WT_13B / 2, M, 2 * DFF, D, D}; pg8::StaticOrder So; So.init(M, 2 * DFF, (int)GDIM, (int)BIDX); pg8::EpiSwigluT E{H}; pg8::gemm_phase<pg8::EpiSwigluT, pg8::StaticOrder, true, true>(lds, g, So, E, tid); }
    if constexpr (ST == 14) { pg8::Gemm g{H, wt + WT_2B / 2, M, D, DFF, DFF}; pg8::StaticOrder So; So.init(M, D, (int)GDIM, (int)BIDX); pg8::EpiResidT E{p.out, p.out, modl + 8 * D, 0.5f}; pg8::gemm_phase<pg8::EpiResidT, pg8::StaticOrder, true, true>(lds, g, So, E, tid); }
}


constexpr int LDS_MISC_OFF = 147456 - 64;
__global__ void __launch_bounds__(NTHREADS, 2) mk_fwd(Params p) {
    extern __shared__ __attribute__((aligned(16))) unsigned char lds_raw[];
    LAS unsigned char* lds = (LAS unsigned char*)lds_raw;
    volatile LAS unsigned* MISC = (volatile LAS unsigned*)(lds + LDS_MISC_OFF);
    if (threadIdx.x < 16) MISC[threadIdx.x] = 0u;
    __syncthreads();
    XcdBarrier bar = xcd_barrier_post((unsigned*)(p.ws + WS_BAR), MISC + 8);
#define IDS() const int tid = otid(); const int lane = tid & 63, wave = __builtin_amdgcn_readfirstlane(tid >> 6); const int gw = BIDX * NWAVES + wave, ngw = GDIM * NWAVES; (void)lane; (void)gw; (void)ngw; \
    bf16_t* wt = (bf16_t*)(p.ws + WS_WT); bf16_t* XN = (bf16_t*)(p.ws + WS_XN); bf16_t* P = (bf16_t*)(p.ws + WS_P); bf16_t* H = (bf16_t*)(p.ws + WS_H); (void)wt; (void)XN; (void)P; (void)H; \
    const float* modl = (const float*)(p.ws + WS_MOD) + (size_t)l * NB * MODW; const float* xin = (l == 0) ? p.in[I_X] : p.out; (void)modl; (void)xin;
#define GEMM(A_, lda_, W_, N_, K_, EPI, ...) do { pg8::Gemm g{A_, W_, M, N_, K_, lda_}; pg8::StaticOrder So; So.init(M, N_, (int)GDIM, (int)BIDX); pg8::EPI E{__VA_ARGS__}; \
        pg8::gemm_phase<pg8::EPI, pg8::StaticOrder, true, true>(lds, g, So, E, tid); } while (0)
#define SYNC() xcd_barrier(bar)
#pragma unroll 1
    for (int l = 0; l < NL; ++l) {
        { IDS(); ph_convert(p, l, lds, gw, ngw, wave, lane); if (l == 0) ph_mod(p, lds, tid, wave, lane); }
        SYNC();
        { IDS(); ph_norm(xin, p.in[I_N1] + (size_t)l * D, modl, 0, 1, XN, gw, ngw, lane); }
        SYNC();
        { IDS(); GEMM(XN, D, wt + WT_13A / 2, 2 * DFF, D, EpiSwigluT, H); }
        SYNC();
        { IDS(); GEMM(H, DFF, wt + WT_2A / 2, D, DFF, EpiResidT, xin, p.out, modl + 2 * D, 0.5f); }
        SYNC();
        { IDS(); ph_norm(p.out, p.in[I_NM] + (size_t)l * D, modl, 3, 4, XN, gw, ngw, lane); }
        SYNC();
        { IDS(); GEMM(XN, D, wt + WT_IN / 2, NIN, D, EpiInT, P, (float*)(p.ws + WS_DT), (bf16_t*)(p.ws + WS_HALO)); }
        SYNC();
        { IDS(); ph_conv(p, l, tid); }
        SYNC();
        { IDS(); ph_ssd_state(p, l, lds, tid, wave, lane); __syncthreads(); }
        { IDS(); ph_sb_attn(p, lds, gw, ngw, wave, lane); }
        { IDS(); ph_diff_attn(p, l, lds, gw, ngw, wave, lane); }
        SYNC();
        { IDS(); ph_ssd_scan(p, tid); }
        SYNC();
        { IDS(); ph_ssd_out(p, l, lds, tid, wave, lane); }
        SYNC();
        { IDS(); ph_mixfinal(p, l, tid); }
        SYNC();
        { IDS(); GEMM(P, PW, wt + WT_OUT / 2, D, 2048, EpiResidT, p.out, p.out, modl + 5 * D, 1.0f); }
        SYNC();
        { IDS(); ph_norm(p.out, p.in[I_N2] + (size_t)l * D, modl, 6, 7, XN, gw, ngw, lane); }
        SYNC();
        { IDS(); GEMM(XN, D, wt + WT_13B / 2, 2 * DFF, D, EpiSwigluT, H); }
        SYNC();
        { IDS(); GEMM(H, DFF, wt + WT_2B / 2, D, DFF, EpiResidT, p.out, p.out, modl + 8 * D, 0.5f); }
        SYNC();
    }
    { const int l = 0; IDS(); ph_final_norm(p.out, p.in[I_FN], gw, ngw, lane); }
}

constexpr int LDS_BYTES = 147456;
extern "C" void kernel_launch(void* const* d_in, const int* in_sizes, int n_in, void* d_out, int out_size, void* d_ws, size_t ws_size, hipStream_t stream) {
    static int grid = 0;
    if (grid == 0) {
        if (n_in != 26 || out_size != M * D || ws_size < WS_END) { fprintf(stderr, "kernel_launch: unexpected shapes (n_in %d out %d ws %zu)\n", n_in, out_size, ws_size); grid = -1; return; }
        int dev = 0, cus = 0;
        if (hipGetDevice(&dev) != hipSuccess || hipDeviceGetAttribute(&cus, hipDeviceAttributeMultiprocessorCount, dev) != hipSuccess) { grid = -1; return; }
        if (hipFuncSetAttribute((const void*)mk_fwd, hipFuncAttributeMaxDynamicSharedMemorySize, LDS_BYTES) != hipSuccess) { grid = -1; return; }
#define SETATTR(ST) if (hipFuncSetAttribute((const void*)mk_phase<ST>, hipFuncAttributeMaxDynamicSharedMemorySize, LDS_BYTES) != hipSuccess) { grid = -1; return; }
        SETATTR(0) SETATTR(1) SETATTR(2) SETATTR(3) SETATTR(4) SETATTR(5) SETATTR(6) SETATTR(7) SETATTR(8) SETATTR(9) SETATTR(10) SETATTR(11) SETATTR(12) SETATTR(13) SETATTR(14) SETATTR(15) SETATTR(16) SETATTR(17)
        grid = cus;
    }
    if (grid < 0) return;
    Params p{};
    for (int i = 0; i < 26; ++i) p.in[i] = (const float*)d_in[i];
    p.out = (float*)d_out; p.ws = (unsigned char*)d_ws;
#if MK_FUSED
    (void)hipMemsetAsync((char*)d_ws + WS_BAR, 0, 64 * KiB, stream);
    hipLaunchKernelGGL(mk_fwd, dim3(grid), dim3(NTHREADS), LDS_BYTES, stream, p);
#else
#define LAUNCH(ST, l) hipLaunchKernelGGL(mk_phase<ST>, dim3(grid), dim3(NTHREADS), LDS_BYTES, stream, p, l)
    for (int l = 0; l < NL; ++l) {
        LAUNCH(0, l); LAUNCH(1, l); LAUNCH(2, l); LAUNCH(3, l); LAUNCH(4, l); LAUNCH(5, l); LAUNCH(6, l); LAUNCH(7, l); LAUNCH(16, l); LAUNCH(17, l);
        LAUNCH(8, l); LAUNCH(9, l); LAUNCH(10, l); LAUNCH(11, l); LAUNCH(12, l); LAUNCH(13, l); LAUNCH(14, l);
    }
    LAUNCH(15, 0);
#endif
}
```

```cpp
#include <hip/hip_runtime.h>
#include <cstdio>
#include <cstdint>
#include <cmath>

#define DEV __device__ __forceinline__
#define LAS __attribute__((address_space(3)))
typedef unsigned short bf16_t;
typedef unsigned u32x4 __attribute__((ext_vector_type(4)));
typedef unsigned u32x2 __attribute__((ext_vector_type(2)));
typedef float f32x4 __attribute__((ext_vector_type(4)));

constexpr int D = 1024, NB = 4, S = 4096, M = NB * S, NL = 2, DFF = 2816, MODW = 9 * D;
constexpr int PW = 5632, NIN = 5888;
constexpr int PZ = 0, PSQ = 1024, PDQ = 1536, PSK = 2048, PSV = 2560, PDK = 3072, PDV = 3584, PXBC = 4096;
constexpr int PXS = PXBC, PBM = PXBC + 1024, PCM = PXBC + 1280;
constexpr int CH = 128, NCHUNK = S / CH, GCH = NB * NCHUNK;
constexpr float EPS = 1e-6f;
constexpr int NTHREADS = 512, NWAVES = 8;

constexpr size_t KiB = 1024, MiB = 1024 * 1024;
constexpr size_t WS_BAR = 0;
constexpr size_t WS_MOD = 64 * KiB;
constexpr size_t WS_ROWSS = 352 * KiB;
constexpr size_t WS_CD = 480 * KiB;
constexpr size_t WS_MISC = 488 * KiB;
constexpr size_t WS_HALO = 512 * KiB;
constexpr size_t WS_WT = 2 * MiB;
constexpr size_t WT_13A = 0, WT_2A = 11 * MiB, WT_IN = 16 * MiB + 512 * KiB, WT_OUT = 28 * MiB, WT_13B = 32 * MiB, WT_2B = 43 * MiB;
constexpr size_t WS_XN = 51 * MiB;
constexpr size_t WS_ST = 51 * MiB;
constexpr size_t WS_P = 115 * MiB;
constexpr size_t WS_H = WS_P;
constexpr size_t WS_DT = 291 * MiB;
constexpr size_t WS_OD = 292 * MiB;
constexpr size_t WS_END = 324 * MiB;

struct Params { const float* in[26]; float* out; unsigned char* ws; };
enum { I_X = 0, I_C, I_ADAW, I_ADAB, I_N1, I_W13A, I_W2A, I_NM, I_WIN, I_CW, I_CB, I_DTB, I_ALOG, I_SD, I_SN, I_LQ1, I_LK1, I_LQ2, I_LK2, I_SUB, I_RB, I_WOUT, I_N2, I_W13B, I_W2B, I_FN };

DEV float bf2f(bf16_t v) { return __uint_as_float(((unsigned)v) << 16); }
DEV float bflo(unsigned w) { return __uint_as_float(w << 16); }
DEV float bfhi(unsigned w) { return __uint_as_float(w & 0xffff0000u); }
DEV unsigned f2bf(float f) { unsigned u = __float_as_uint(f); return (u + 0x7fffu + ((u >> 16) & 1u)) >> 16; }
DEV unsigned pk2(float lo, float hi) { return f2bf(lo) | (f2bf(hi) << 16); }
DEV float siluf(float x) { return x / (1.f + __expf(-x)); }
DEV float softplusf(float x) { return fmaxf(x, 0.f) + __logf(1.f + __expf(-fabsf(x))); }
DEV float lane_get(float v, int src) { return __int_as_float(__builtin_amdgcn_ds_bpermute(src << 2, __float_as_int(v))); }
DEV float wave_sum(float v, int lane) {
#pragma unroll
    for (int o = 1; o < 64; o <<= 1) v += lane_get(v, lane ^ o);
    return v;
}
DEV float wave_max(float v, int lane) {
#pragma unroll
    for (int o = 1; o < 64; o <<= 1) v = fmaxf(v, lane_get(v, lane ^ o));
    return v;
}
DEV float wave_incl_scan(float v, int lane) {
#pragma unroll
    for (int o = 1; o < 64; o <<= 1) { float t = lane_get(v, lane - o); if (lane >= o) v += t; }
    return v;
}
#define BIDX obid()
#define GDIM ((int)gridDim.x)
#define LDS_WAIT() asm volatile("s_waitcnt lgkmcnt(0)" ::: "memory")
DEV float lambda_init_of(int l) { return l == 0 ? 0.2f : 0.35550906759097f; }
DEV int olane() { int l; asm volatile("v_mbcnt_lo_u32_b32 %0, -1, 0\n\tv_mbcnt_hi_u32_b32 %0, -1, %0" : "=v"(l)); return l; }
DEV int obid() { int b = blockIdx.x; asm volatile("" : "+s"(b)); return b; }

DEV void transpose_item(const float* W, int K, int N, bf16_t* WT, int dst_n0, int src_n0, int nvalid, int k0, LAS float* scr, int lane) {
    const int c = lane & 31;
#pragma unroll 8
    for (int i = 0; i < 32; ++i) { const int kk = 2 * i + (lane >> 5); scr[kk * 33 + c] = (c < nvalid) ? W[(size_t)(k0 + kk) * N + src_n0 + c] : 0.f; }
    LDS_WAIT();
    const int c8 = lane & 7;
#pragma unroll
    for (int j = 0; j < 4; ++j) { const int n = (lane >> 3) + 8 * j; const LAS float* s = scr + (8 * c8) * 33 + n;
        u32x4 o; o.x = pk2(s[0 * 33], s[1 * 33]); o.y = pk2(s[2 * 33], s[3 * 33]); o.z = pk2(s[4 * 33], s[5 * 33]); o.w = pk2(s[6 * 33], s[7 * 33]);
        *(u32x4*)(WT + (size_t)(dst_n0 + n) * K + k0 + 8 * c8) = o; }
    LDS_WAIT();
}
DEV void src_map_swiglu(int n0, int& src, int& nv) { const int pn = n0 >> 8, bj = (n0 >> 7) & 1, i0 = n0 & 127; src = bj * DFF + pn * 128 + i0; nv = 32; }
DEV void src_map_in(int n0, int& src, int& nv) {
    nv = 32;
    if (n0 < 1024) src = n0;
    else if (n0 < 1536) src = 2576 + (n0 - 1024);
    else if (n0 < 2048) src = 4112 + (n0 - 1536);
    else if (n0 < 2560) src = 3088 + (n0 - 2048);
    else if (n0 < 3072) src = 3600 + (n0 - 2560);
    else if (n0 < 3584) src = 4624 + (n0 - 3072);
    else if (n0 < 4096) src = 5136 + (n0 - 3584);
    else if (n0 < 5632) src = 1024 + (n0 - 4096);
    else if (n0 == 5632) { src = 2560; nv = 16; }
    else { src = 0; nv = 0; }
}
DEV void ph_convert(const Params& p, int l, LAS unsigned char* lds, int gw, int ngw, int wave, int lane) {
    LAS float* scr = (LAS float*)(lds + wave * 16384);
    bf16_t* wt = (bf16_t*)(p.ws + WS_WT);
    constexpr int I13 = 16 * 176, I2 = 44 * 32, IIN = 16 * 184, IOUT = 32 * 32;
    constexpr int NITEMS = 2 * I13 + 2 * I2 + IIN + IOUT;
    for (int it = gw; it < NITEMS; it += ngw) {
        int r = it;
        if (r < 2 * I13) { const int which = r / I13; r %= I13; const int kb = r / 176, nb = r % 176; int src, nv; src_map_swiglu(nb * 32, src, nv);
            transpose_item(p.in[which ? I_W13B : I_W13A] + (size_t)l * D * 2 * DFF, D, 2 * DFF, wt + (which ? WT_13B : WT_13A) / 2, nb * 32, src, nv, kb * 64, scr, lane); continue; }
        r -= 2 * I13;
        if (r < 2 * I2) { const int which = r / I2; r %= I2; const int kb = r / 32, nb = r % 32;
            transpose_item(p.in[which ? I_W2B : I_W2A] + (size_t)l * DFF * D, DFF, D, wt + (which ? WT_2B : WT_2A) / 2, nb * 32, nb * 32, 32, kb * 64, scr, lane); continue; }
        r -= 2 * I2;
        if (r < IIN) { const int kb = r / 184, nb = r % 184; int src, nv; src_map_in(nb * 32, src, nv);
            transpose_item(p.in[I_WIN] + (size_t)l * D * 5648, D, 5648, wt + WT_IN / 2, nb * 32, src, nv, kb * 64, scr, lane); continue; }
        r -= IIN;
        { const int kb = r / 32, nb = r % 32;
            transpose_item(p.in[I_WOUT] + (size_t)l * 2048 * D, 2048, D, wt + WT_OUT / 2, nb * 32, nb * 32, 32, kb * 64, scr, lane); }
    }
}

DEV void ph_mod(const Params& p, LAS unsigned char* lds, int tid, int wave, int lane) {
    LAS float* cond = (LAS float*)lds;
    LAS float* part = (LAS float*)(lds + 16384);
    __syncthreads();
    for (int i = tid; i < NB * D; i += NTHREADS) cond[i] = siluf(p.in[I_C][i]);
    __syncthreads();
    float* mod = (float*)(p.ws + WS_MOD);
    for (int unit = BIDX; unit < NL * 144; unit += GDIM) {
        const int l = unit / 144, j = (unit % 144) * 64 + lane;
        const float* w = p.in[I_ADAW] + (size_t)l * D * MODW + j;
        float a0 = 0.f, a1 = 0.f, a2 = 0.f, a3 = 0.f;
        for (int k = wave * 128; k < wave * 128 + 128; ++k) { const float wv = w[(size_t)k * MODW]; a0 += cond[k] * wv; a1 += cond[D + k] * wv; a2 += cond[2 * D + k] * wv; a3 += cond[3 * D + k] * wv; }
        part[(wave * 4 + 0) * 64 + lane] = a0; part[(wave * 4 + 1) * 64 + lane] = a1; part[(wave * 4 + 2) * 64 + lane] = a2; part[(wave * 4 + 3) * 64 + lane] = a3;
        __syncthreads();
        if (wave < 4) { float s = 0.f;
#pragma unroll
            for (int w8 = 0; w8 < 8; ++w8) s += part[(w8 * 4 + wave) * 64 + lane];
            mod[((size_t)l * NB + wave) * MODW + j] = s + p.in[I_ADAB][(size_t)l * MODW + j]; }
        __syncthreads();
    }
    if (BIDX == 0) {
        float* misc = (float*)(p.ws + WS_MISC);
        if (wave < NL) { int l = wave; asm volatile("" : "+s"(l));
            const float s1 = wave_sum(p.in[I_LQ1][l * 64 + lane] * p.in[I_LK1][l * 64 + lane], lane);
            const float s2 = wave_sum(p.in[I_LQ2][l * 64 + lane] * p.in[I_LK2][l * 64 + lane], lane);
            const float linit = lambda_init_of(l);
            if (lane == 0) misc[l] = expf(s1) - expf(s2) + linit; }
        if (tid < 512) { const int h = tid >> 7, d = tid & 127; int bk;
            if (d < 16) bk = d; else { bk = 16 + (int)(logf((float)d / 16.f) / logf(8.f) * 16.f); if (bk > 31) bk = 31; }
            misc[64 + h * 128 + d] = p.in[I_RB][bk * 4 + h]; }
    }
}

DEV void ph_norm(const float* xsrc, const float* g, const float* modl, int ishift, int iscale, bf16_t* XN, int gw, int ngw, int lane) {
    for (int m = gw; m < M; m += ngw) {
        const int b = m / S; const float* xr = xsrc + (size_t)m * D;
        f32x4 v[4]; float ss = 0.f;
#pragma unroll
        for (int j = 0; j < 4; ++j) { v[j] = *(const f32x4*)(xr + 4 * lane + 256 * j); ss += (v[j].x * v[j].x + v[j].y * v[j].y) + (v[j].z * v[j].z + v[j].w * v[j].w); }
        const float rstd = rsqrtf(wave_sum(ss, lane) * (1.f / D) + EPS);
        const float* sh = modl + (size_t)b * MODW + ishift * D; const float* sc = modl + (size_t)b * MODW + iscale * D;
#pragma unroll
        for (int j = 0; j < 4; ++j) { const int c = 4 * lane + 256 * j; const f32x4 gg = *(const f32x4*)(g + c), s1 = *(const f32x4*)(sc + c), s0 = *(const f32x4*)(sh + c);
            const f32x4 o = v[j] * rstd * gg * (s1 + 1.f) + s0; u32x2 w; w.x = pk2(o.x, o.y); w.y = pk2(o.z, o.w); *(u32x2*)(XN + (size_t)m * D + c) = w; }
    }
}
DEV void ph_final_norm(float* x, const float* g, int gw, int ngw, int lane) {
    for (int m = gw; m < M; m += ngw) {
        float* xr = x + (size_t)m * D; f32x4 v[4]; float ss = 0.f;
#pragma unroll
        for (int j = 0; j < 4; ++j) { v[j] = *(const f32x4*)(xr + 4 * lane + 256 * j); ss += (v[j].x * v[j].x + v[j].y * v[j].y) + (v[j].z * v[j].z + v[j].w * v[j].w); }
        const float rstd = rsqrtf(wave_sum(ss, lane) * (1.f / D) + EPS);
#pragma unroll
        for (int j = 0; j < 4; ++j) { const int c = 4 * lane + 256 * j; const f32x4 gg = *(const f32x4*)(g + c); *(f32x4*)(xr + c) = v[j] * rstd * gg; }
    }
}

struct EpiSwiglu { bf16_t* H;
    DEV void elem2(int row, int j, float a, float u) const { H[(size_t)row * DFF + j] = (bf16_t)f2bf(siluf(a) * u); } };
struct EpiResid { const float* xsrc; float* out; const float* gate; float f;
    DEV void elem(int row, int col, float v) const { const int b = row / S; const size_t o = (size_t)row * D + col; out[o] = xsrc[o] + f * gate[(size_t)b * MODW + col] * v; } };
struct EpiIn { bf16_t* P; float* DT; bf16_t* HALO;
    DEV void elem(int row, int col, float v) const {
        if (col < PW) { const bf16_t h = (bf16_t)f2bf(v); P[(size_t)row * PW + col] = h;
            if (col >= PXBC) { const int r = row & 127; if (r >= 125) HALO[((size_t)((row >> 7) + 1) * 3 + (r - 125)) * 1536 + (col - PXBC)] = h; } }
        else if (col < PW + 16) DT[(size_t)row * 16 + (col - PW)] = v; } };

template <bool SW, class Epi>
DEV void gemm_naive(const bf16_t* A, int lda, const bf16_t* Bt, int Ndest, int K, const Epi& E, LAS unsigned char* lds, int tid) {
    LAS float* As = (LAS float*)lds;
    LAS float* Bs = (LAS float*)(lds + 128 * 33 * 4);
    LAS float* Bs2 = (LAS float*)(lds + 192 * 33 * 4);
    const int ntn = SW ? (Ndest / 256) * 2 : Ndest / 64;
    const int ntiles = (M / 128) * ntn;
    const int ty = tid >> 4, tx = tid & 15;
    for (int tile = BIDX; tile < ntiles; tile += GDIM) {
        const int tm = tile / ntn, tn = tile % ntn;
        const int m0 = tm * 128;
        const int n0 = SW ? (tn >> 1) * 256 + (tn & 1) * 64 : tn * 64;
        float acc[4][4], acc2[4][4];
#pragma unroll
        for (int i = 0; i < 4; ++i)
#pragma unroll
            for (int j = 0; j < 4; ++j) { acc[i][j] = 0.f; acc2[i][j] = 0.f; }
        for (int k0 = 0; k0 < K; k0 += 32) {
            { const int row = tid >> 2, kc = (tid & 3) * 8; const u32x4 v = *(const u32x4*)(A + (size_t)(m0 + row) * lda + k0 + kc); LAS float* d = As + row * 33 + kc;
              d[0] = bflo(v.x); d[1] = bfhi(v.x); d[2] = bflo(v.y); d[3] = bfhi(v.y); d[4] = bflo(v.z); d[5] = bfhi(v.z); d[6] = bflo(v.w); d[7] = bfhi(v.w); }
            if (tid < 256) { const int row = tid >> 2, kc = (tid & 3) * 8; const u32x4 v = *(const u32x4*)(Bt + (size_t)(n0 + row) * K + k0 + kc); LAS float* d = Bs + row * 33 + kc;
              d[0] = bflo(v.x); d[1] = bfhi(v.x); d[2] = bflo(v.y); d[3] = bfhi(v.y); d[4] = bflo(v.z); d[5] = bfhi(v.z); d[6] = bflo(v.w); d[7] = bfhi(v.w); }
            else if (SW) { const int t2 = tid - 256; const int row = t2 >> 2, kc = (t2 & 3) * 8; const u32x4 v = *(const u32x4*)(Bt + (size_t)(n0 + 128 + row) * K + k0 + kc); LAS float* d = Bs2 + row * 33 + kc;
              d[0] = bflo(v.x); d[1] = bfhi(v.x); d[2] = bflo(v.y); d[3] = bfhi(v.y); d[4] = bflo(v.z); d[5] = bfhi(v.z); d[6] = bflo(v.w); d[7] = bfhi(v.w); }
            __syncthreads();
#pragma unroll 8
            for (int kk = 0; kk < 32; ++kk) {
                float a[4], b[4], b2[4];
#pragma unroll
                for (int i = 0; i < 4; ++i) a[i] = As[(ty * 4 + i) * 33 + kk];
#pragma unroll
                for (int j = 0; j < 4; ++j) { b[j] = Bs[(tx * 4 + j) * 33 + kk]; if (SW) b2[j] = Bs2[(tx * 4 + j) * 33 + kk]; }
#pragma unroll
                for (int i = 0; i < 4; ++i)
#pragma unroll
                    for (int j = 0; j < 4; ++j) { acc[i][j] += a[i] * b[j]; if (SW) acc2[i][j] += a[i] * b2[j]; }
            }
            __syncthreads();
        }
#pragma unroll
        for (int i = 0; i < 4; ++i)
#pragma unroll
            for (int j = 0; j < 4; ++j) {
                if constexpr (SW) E.elem2(m0 + ty * 4 + i, (tn >> 1) * 128 + (tn & 1) * 64 + tx * 4 + j, acc[i][j], acc2[i][j]);
                else E.elem(m0 + ty * 4 + i, n0 + tx * 4 + j, acc[i][j]);
            }
    }
}

namespace pg8 {
#define PG8_LAS __attribute__((address_space(3)))
typedef unsigned short bf16_t;
typedef short bf16x8 __attribute__((ext_vector_type(8)));
typedef float f32x4 __attribute__((ext_vector_type(4)));
typedef unsigned u32x4 __attribute__((ext_vector_type(4)));
constexpr int BM = 256, BK = 64, HALF = 128, HTB = HALF * BK * 2  , STAGE_BYTES = 8 * HTB, NXCD = 8, WGM = 8;

__host__ __device__ __forceinline__ int lds_byte(int r, int c) { const int st = (r >> 4) * 2 + (c >> 5), rr = r & 15, cc = c & 31, ob = rr * 64 + cc * 2; return st * 1024 + (ob ^ (((ob >> 9) & 1) << 5)); }
__host__ __device__ __forceinline__ void stage_rc(int b, int& R, int& C) { const int st = b / 1024, sb = b % 1024, swz = sb ^ (((sb >> 9) & 1) << 5); R = (st >> 1) * 16 + swz / 64; C = (st & 1) * 32 + (swz % 64) / 2; }
__host__ __device__ __forceinline__ int perm32(int rho) { const int n = rho >> 4, i = rho & 15; return 8 * (i >> 2) + 4 * n + (i & 3); }

struct Unit { int pm, pn; };
struct Gemm { const bf16_t* A; const bf16_t* Bt; int M, N, K, lda; };

struct StaticOrder {
    int nM, nN, nwg, G, c;
    __host__ __device__ void init(int M, int N, int G_, int c_) { nM = M / BM; nN = N / BM; nwg = nM * nN; G = G_; c = c_; }
    __host__ __device__ bool next(int i, Unit& u) const {
        const long L = (long)i * G + c; if (L >= nwg) return false;
        int wgid = (int)L; { const int q = nwg / NXCD, r = nwg % NXCD, xcd = wgid % NXCD, off = wgid / NXCD; wgid = (xcd < r ? xcd * (q + 1) : r * (q + 1) + (xcd - r) * q) + off; }
        const int nig = WGM * nN, gid = wgid / nig, fm = gid * WGM, gsz = (nM - fm) < WGM ? (nM - fm) : WGM;
        u.pm = fm + ((wgid % nig) % gsz); u.pn = (wgid % nig) / gsz; return true;
    }
    __device__ __forceinline__ void a_ready(const Unit&) const {}
    __device__ __forceinline__ void done(const Unit&) const {}
};
__device__ __forceinline__ unsigned cvt_pk_bf16(float lo, float hi) { unsigned r; asm volatile("v_cvt_pk_bf16_f32 %0, %1, %2" : "=v"(r) : "v"(lo), "v"(hi)); return r; }

__device__ __forceinline__ float silu1(float x) { return x * __builtin_amdgcn_rcpf(1.f + __expf(-x)); }
struct EpiSwigluT { static constexpr bool PERM = true, AFTER_DRAIN = false; bf16_t* H;
    __device__ __forceinline__ void operator()(const f32x4 (&acc)[2][2][4][2], const Unit& u, int wr, int wc, int fr, int fq) const {
        const int row0 = u.pm * BM + wr * 64 + fr, col0 = u.pn * HALF + wc * 32 + 8 * fq;
#pragma unroll
        for (int ai = 0; ai < 2; ++ai)
#pragma unroll
            for (int m = 0; m < 4; ++m) { bf16_t* rowp = H + (size_t)(row0 + ai * HALF + m * 16) * 2816 + col0;
                const f32x4 a0 = acc[ai][0][m][0], a1 = acc[ai][0][m][1], u0 = acc[ai][1][m][0], u1 = acc[ai][1][m][1]; u32x4 w;
                w.x = cvt_pk_bf16(silu1(a0[0]) * u0[0], silu1(a0[1]) * u0[1]); w.y = cvt_pk_bf16(silu1(a0[2]) * u0[2], silu1(a0[3]) * u0[3]);
                w.z = cvt_pk_bf16(silu1(a1[0]) * u1[0], silu1(a1[1]) * u1[1]); w.w = cvt_pk_bf16(silu1(a1[2]) * u1[2], silu1(a1[3]) * u1[3]);
                *(u32x4*)rowp = w; }
    }
};
struct EpiResidT { static constexpr bool PERM = false, AFTER_DRAIN = false; const float* xsrc; float* out; const float* gate; float f;
    __device__ __forceinline__ void operator()(const f32x4 (&acc)[2][2][4][2], const Unit& u, int wr, int wc, int fr, int fq) const {
        const int row0 = u.pm * BM + wr * 64 + fr, col0 = u.pn * BM + wc * 32 + 4 * fq; const int b = (u.pm * BM) / 4096;
#pragma unroll
        for (int bj = 0; bj < 2; ++bj)
#pragma unroll
            for (int n = 0; n < 2; ++n) { const int c = col0 + bj * HALF + n * 16; const f32x4 gv = *(const f32x4*)(gate + (size_t)b * 9216 + c) * f;
#pragma unroll
                for (int ai = 0; ai < 2; ++ai)
#pragma unroll
                    for (int m = 0; m < 4; ++m) { const size_t off = (size_t)(row0 + ai * HALF + m * 16) * 1024 + c; *(f32x4*)(out + off) = *(const f32x4*)(xsrc + off) + gv * acc[ai][bj][m][n]; } }
    }
};
struct EpiInT { static constexpr bool PERM = true, AFTER_DRAIN = false; bf16_t* P; float* DT; bf16_t* HALO;
    __device__ __forceinline__ void operator()(const f32x4 (&acc)[2][2][4][2], const Unit& u, int wr, int wc, int fr, int fq) const {
        const int row0 = u.pm * BM + wr * 64 + fr;
        if (u.pn < 22) { const int col0 = u.pn * BM + wc * 32 + 8 * fq; const float qs = (u.pn == 6 || u.pn == 7) ? 0.125f * 1.4426950408889634f : 1.f;
#pragma unroll
            for (int ai = 0; ai < 2; ++ai)
#pragma unroll
                for (int m = 0; m < 4; ++m) { const int row = row0 + ai * HALF + m * 16;
#pragma unroll
                    for (int bj = 0; bj < 2; ++bj) { const f32x4 v0 = acc[ai][bj][m][0] * qs, v1 = acc[ai][bj][m][1] * qs; u32x4 w;
                        w.x = cvt_pk_bf16(v0[0], v0[1]); w.y = cvt_pk_bf16(v0[2], v0[3]); w.z = cvt_pk_bf16(v1[0], v1[1]); w.w = cvt_pk_bf16(v1[2], v1[3]);
                        *(u32x4*)(P + (size_t)row * 5632 + col0 + bj * HALF) = w;
                        if (m == 3 && u.pn >= 16 && wr == 1 && fr >= 13) *(u32x4*)(HALO + ((size_t)((row >> 7) + 1) * 3 + (fr - 13)) * 1536 + (col0 + bj * HALF - 4096)) = w; } }
        } else if (wc == 0 && fq < 2) {
#pragma unroll
            for (int ai = 0; ai < 2; ++ai)
#pragma unroll
                for (int m = 0; m < 4; ++m) { const int row = row0 + ai * HALF + m * 16;
#pragma unroll
                    for (int n = 0; n < 2; ++n) *(f32x4*)(DT + (size_t)row * 16 + 8 * fq + 4 * n) = acc[ai][0][m][n]; }
        }
    }
};

template <class Epi, class Sched, bool ALIGN_EPI = false, bool SP2 = false>
__device__ __forceinline__ void gemm_phase(PG8_LAS unsigned char* lds, const Gemm g, const Sched& S, const Epi& E, const int tid) {
    const int wid = __builtin_amdgcn_readfirstlane(tid >> 6), lane = tid & 63, wr = wid >> 2, wc = wid & 3, fr = lane & 15, fq = lane >> 4;
    const int K = g.K, nt = K / BK;
    unsigned voffA[2], voffB[2];
#pragma unroll
    for (int i = 0; i < 2; ++i) { int R, C; stage_rc(tid * 16 + i * 8192, R, C); const int Rb = Epi::PERM ? ((R & ~31) + perm32(R & 31)) : R;
        voffA[i] = (unsigned)(R * g.lda + C) * 2u; voffB[i] = (unsigned)(Rb * K + C) * 2u; }
    const size_t kstep = (size_t)(BK * 2);
    const size_t hstep = (size_t)HALF * K * 2, hstepA = (size_t)HALF * g.lda * 2;
    const size_t tstep = 2 * hstep, tstepA = 2 * hstepA;
    const unsigned ldsw = (unsigned)wid * 1024u;
    const int aoff = lds_byte(wr * 64 + fr, fq * 8), boff = lds_byte(wc * 32 + fr, fq * 8);
#define PG8_SA(b, h) (((b) * 2 + (h)) * HTB)
#define PG8_SB(b, h) ((4 + (b) * 2 + (h)) * HTB)
#define PG8_STAGE(bufoff, gbase, voff) do { _Pragma("unroll") for (int _i = 0; _i < 2; ++_i) \
        __builtin_amdgcn_global_load_lds((const unsigned*)((const char*)(gbase) + (voff)[_i]), (PG8_LAS unsigned*)(lds + (bufoff) + ldsw + _i * 8192), 16, 0, 0); } while (0)
#define PG8_LDA(dst, b, h) do { _Pragma("unroll") for (int m = 0; m < 4; ++m) _Pragma("unroll") for (int k = 0; k < 2; ++k) dst[m][k] = *(const PG8_LAS bf16x8*)(lds + PG8_SA(b, h) + aoff + m * 2048 + k * 1024); } while (0)
#define PG8_LDB(dst, b, h) do { _Pragma("unroll") for (int n = 0; n < 2; ++n) _Pragma("unroll") for (int k = 0; k < 2; ++k) dst[n][k] = *(const PG8_LAS bf16x8*)(lds + PG8_SB(b, h) + boff + n * 2048 + k * 1024); } while (0)
#define PG8_MMA(ai, bj, At, Bt) do { __builtin_amdgcn_s_setprio(1); _Pragma("unroll") for (int m = 0; m < 4; ++m) _Pragma("unroll") for (int n = 0; n < 2; ++n) _Pragma("unroll") for (int k = 0; k < 2; ++k) \
        acc[ai][bj][m][n] = __builtin_amdgcn_mfma_f32_16x16x32_bf16(Bt[n][k], At[m][k], acc[ai][bj][m][n], 0, 0, 0); __builtin_amdgcn_s_setprio(0); } while (0)
#define PG8_WAIT_V(n) asm volatile("s_waitcnt vmcnt(" #n ")" ::: "memory")
#define PG8_WAIT_L(n) asm volatile("s_waitcnt lgkmcnt(" #n ")" ::: "memory")
#define PG8_BAR __builtin_amdgcn_s_barrier()
#define PG8_SCHED __builtin_amdgcn_sched_barrier(0)
    Unit cur, nxt; int ui = 0;
    if (!S.next(0, cur)) return;
    f32x4 acc[2][2][4][2];
#pragma unroll
    for (int a = 0; a < 2; ++a)
#pragma unroll
        for (int b = 0; b < 2; ++b)
#pragma unroll
            for (int m = 0; m < 4; ++m)
#pragma unroll
                for (int n = 0; n < 2; ++n) acc[a][b][m][n] = (f32x4){0.f, 0.f, 0.f, 0.f};
    bf16x8 At[4][2], B0[2][2], B1[2][2];
    const char* cA = (const char*)g.A + (size_t)cur.pm * tstepA; const char* cB = (const char*)g.Bt + (size_t)cur.pn * tstep;
    S.a_ready(cur);
    if constexpr (SP2) {
        PG8_STAGE(PG8_SB(0, 0), cB, voffB); PG8_STAGE(PG8_SB(0, 1), cB + hstep, voffB); PG8_STAGE(PG8_SA(0, 0), cA, voffA); PG8_STAGE(PG8_SA(0, 1), cA + hstepA, voffA);
        if (wr == 1) PG8_BAR;
        PG8_WAIT_V(2); PG8_BAR;
        PG8_STAGE(PG8_SB(1, 0), cB + kstep, voffB); PG8_STAGE(PG8_SA(1, 0), cA + kstep, voffA); PG8_STAGE(PG8_SB(1, 1), cB + hstep + kstep, voffB);
        PG8_WAIT_V(6); PG8_BAR;
    } else {
        PG8_STAGE(PG8_SB(0, 0), cB, voffB); PG8_STAGE(PG8_SA(0, 0), cA, voffA); PG8_STAGE(PG8_SB(0, 1), cB + hstep, voffB); PG8_STAGE(PG8_SA(0, 1), cA + hstepA, voffA);
        if (wr == 1) PG8_BAR;
        PG8_WAIT_V(4); PG8_BAR;
        PG8_STAGE(PG8_SB(1, 0), cB + kstep, voffB); PG8_STAGE(PG8_SA(1, 0), cA + kstep, voffA); PG8_STAGE(PG8_SB(1, 1), cB + hstep + kstep, voffB);
        PG8_WAIT_V(6); PG8_BAR;
    }
    for (;;) {
        const bool has_next = S.next(ui + 1, nxt);
        const char* nA = has_next ? (const char*)g.A + (size_t)nxt.pm * tstepA : cA; const char* nB = has_next ? (const char*)g.Bt + (size_t)nxt.pn * tstep : cB;
        for (int t = 0; t < nt; t += 2) {
            const bool last = (t == nt - 2);
            const char* a1 = cA + (size_t)(t + 1) * kstep;
            const char* a2 = last ? nA : cA + (size_t)(t + 2) * kstep; const char* b2 = last ? nB : cB + (size_t)(t + 2) * kstep;
            const char* a3 = a2 + kstep; const char* b3 = b2 + kstep;
            if (last && has_next) S.a_ready(nxt);
            if constexpr (SP2) {
            PG8_LDB(B0, 0, 0); PG8_LDB(B1, 0, 1); PG8_SCHED; PG8_LDA(At, 0, 0); PG8_STAGE(PG8_SA(1, 1), a1 + hstepA, voffA);
            PG8_WAIT_V(8); PG8_WAIT_L(0); PG8_BAR; PG8_MMA(0, 0, At, B0); PG8_MMA(0, 1, At, B1); PG8_BAR; PG8_SCHED;
            PG8_LDA(At, 0, 1); PG8_STAGE(PG8_SB(0, 0), b2, voffB); PG8_STAGE(PG8_SB(0, 1), b2 + hstep, voffB); PG8_STAGE(PG8_SA(0, 0), a2, voffA);
            PG8_WAIT_V(8); PG8_WAIT_L(0); PG8_BAR; PG8_MMA(1, 0, At, B0); PG8_MMA(1, 1, At, B1); PG8_BAR; PG8_SCHED;
            PG8_LDB(B0, 1, 0); PG8_LDB(B1, 1, 1); PG8_SCHED; PG8_LDA(At, 1, 0); PG8_STAGE(PG8_SA(0, 1), a2 + hstepA, voffA);
            PG8_WAIT_V(8); PG8_WAIT_L(0); PG8_BAR; PG8_MMA(0, 0, At, B0); PG8_MMA(0, 1, At, B1); PG8_BAR; PG8_SCHED;
            PG8_LDA(At, 1, 1); PG8_STAGE(PG8_SB(1, 0), b3, voffB); PG8_STAGE(PG8_SB(1, 1), b3 + hstep, voffB); PG8_STAGE(PG8_SA(1, 0), a3, voffA);
            PG8_WAIT_V(8); PG8_WAIT_L(0); PG8_BAR; PG8_MMA(1, 0, At, B0); PG8_MMA(1, 1, At, B1); PG8_BAR; PG8_SCHED;
            } else {
            PG8_LDB(B0, 0, 0); PG8_SCHED; PG8_LDA(At, 0, 0); PG8_STAGE(PG8_SA(1, 1), a1 + hstepA, voffA);
            PG8_WAIT_L(8); PG8_BAR; PG8_WAIT_L(0); PG8_MMA(0, 0, At, B0); PG8_BAR; PG8_SCHED;
            PG8_LDB(B1, 0, 1); PG8_STAGE(PG8_SB(0, 0), b2, voffB);
            PG8_BAR; PG8_WAIT_L(0); PG8_MMA(0, 1, At, B1); PG8_BAR;
            PG8_LDA(At, 0, 1); PG8_STAGE(PG8_SA(0, 0), a2, voffA);
            PG8_BAR; PG8_WAIT_L(0); PG8_MMA(1, 0, At, B0); PG8_BAR; PG8_SCHED;
            PG8_STAGE(PG8_SB(0, 1), b2 + hstep, voffB);
            PG8_WAIT_V(6); PG8_BAR; PG8_MMA(1, 1, At, B1); PG8_BAR;
            PG8_LDB(B0, 1, 0); PG8_SCHED; PG8_LDA(At, 1, 0); PG8_STAGE(PG8_SA(0, 1), a2 + hstepA, voffA);
            PG8_WAIT_L(8); PG8_BAR; PG8_WAIT_L(0); PG8_MMA(0, 0, At, B0); PG8_BAR; PG8_SCHED;
            PG8_LDB(B1, 1, 1); PG8_STAGE(PG8_SB(1, 0), b3, voffB);
            PG8_BAR; PG8_WAIT_L(0); PG8_MMA(0, 1, At, B1); PG8_BAR;
            PG8_LDA(At, 1, 1); PG8_STAGE(PG8_SA(1, 0), a3, voffA);
            PG8_BAR; PG8_WAIT_L(0); PG8_MMA(1, 0, At, B0); PG8_BAR; PG8_SCHED;
            PG8_STAGE(PG8_SB(1, 1), b3 + hstep, voffB);
            PG8_WAIT_V(6); PG8_BAR; PG8_MMA(1, 1, At, B1); PG8_BAR;
            }
        }
        if constexpr (ALIGN_EPI) { if (wr == 0) PG8_BAR; }
        if constexpr (!Epi::AFTER_DRAIN) { E(acc, cur, wr, wc, fr, fq); S.done(cur); }
        if (!has_next) break;
#pragma unroll
        for (int a = 0; a < 2; ++a)
#pragma unroll
            for (int b = 0; b < 2; ++b)
#pragma unroll
                for (int m = 0; m < 4; ++m)
#pragma unroll
                    for (int n = 0; n < 2; ++n) acc[a][b][m][n] = (f32x4){0.f, 0.f, 0.f, 0.f};
        cur = nxt; cA = nA; cB = nB; ++ui;
        if constexpr (ALIGN_EPI) { if (wr == 1) PG8_BAR; }
    }
    PG8_WAIT_V(0);
    if constexpr (!ALIGN_EPI) { if (wr == 0) PG8_BAR; }
    PG8_BAR;
    if constexpr (Epi::AFTER_DRAIN) { E.fused(acc, cur, wr, wc, fr, fq, lds, wid, lane); S.done(cur); }
#undef PG8_SA
#undef PG8_SB
#undef PG8_STAGE
#undef PG8_LDA
#undef PG8_LDB
#undef PG8_MMA
#undef PG8_WAIT_V
#undef PG8_WAIT_L
#undef PG8_BAR
#undef PG8_SCHED
}
}
DEV void ph_conv(const Params& p, int l, int tid) {
    bf16_t* P = (bf16_t*)(p.ws + WS_P); const bf16_t* HALO = (const bf16_t*)(p.ws + WS_HALO);
    const float* cw = p.in[I_CW] + (size_t)l * 1536 * 4; const float* cb = p.in[I_CB] + (size_t)l * 1536;
    for (int task = BIDX * NTHREADS + tid; task < GCH * 768; task += GDIM * NTHREADS) {
        const int gc = task / 768, ch = (task % 768) * 2; const int r0 = gc * CH;
        const f32x4 w0 = *(const f32x4*)(cw + ch * 4), w1 = *(const f32x4*)(cw + ch * 4 + 4); const float b0 = cb[ch], b1 = cb[ch + 1];
        float a3 = 0.f, a2 = 0.f, a1 = 0.f, c3 = 0.f, c2 = 0.f, c1 = 0.f;
        if (gc % NCHUNK != 0) { const bf16_t* hp = HALO + (size_t)gc * 3 * 1536 + ch;
            const unsigned h0 = *(const unsigned*)(hp), h1 = *(const unsigned*)(hp + 1536), h2 = *(const unsigned*)(hp + 2 * 1536);
            a3 = bflo(h0); c3 = bfhi(h0); a2 = bflo(h1); c2 = bfhi(h1); a1 = bflo(h2); c1 = bfhi(h2); }
        unsigned* col = (unsigned*)(P + (size_t)r0 * PW + PXBC + ch);
        for (int i = 0; i < CH; ++i) {
            const unsigned raw = col[(size_t)i * (PW / 2)]; const float a0 = bflo(raw), c0 = bfhi(raw);
            const float ya = b0 + w0.x * a3 + w0.y * a2 + w0.z * a1 + w0.w * a0, yc = b1 + w1.x * c3 + w1.y * c2 + w1.z * c1 + w1.w * c0;
            col[(size_t)i * (PW / 2)] = pk2(siluf(ya), siluf(yc));
            a3 = a2; a2 = a1; a1 = a0; c3 = c2; c2 = c1; c1 = c0;
        }
    }
}

DEV void ssd_head_scalars(const Params& p, int l, int r0, int h, LAS float* s_dt, LAS float* s_ac, int tid, int wave, int lane) {
    const float* DT = (const float*)(p.ws + WS_DT);
    if (tid < CH) { const float dtv = softplusf(DT[(size_t)(r0 + tid) * 16 + h] + p.in[I_DTB][l * 16 + h]); s_dt[tid] = dtv; s_ac[tid] = dtv * (-__expf(p.in[I_ALOG][l * 16 + h])); }
    __syncthreads();
    if (wave == 0) { const float v0 = s_ac[2 * lane], v1 = s_ac[2 * lane + 1]; const float s = v0 + v1; const float inc = wave_incl_scan(s, lane); s_ac[2 * lane] = inc - s + v0; s_ac[2 * lane + 1] = inc; }
    __syncthreads();
}
DEV void ph_ssd_state(const Params& p, int l, LAS unsigned char* lds, int tid, int wave, int lane) {
    LAS bf16_t* Bs = (LAS bf16_t*)lds;
    LAS float* xdd = (LAS float*)(lds + 34816);
    LAS float* s_dt = (LAS float*)(lds + 34816 + 32768);
    LAS float* s_ac = s_dt + 128;
    const bf16_t* P = (const bf16_t*)(p.ws + WS_P); float* ST = (float*)(p.ws + WS_ST); float* CD = (float*)(p.ws + WS_CD);
    for (int unit = BIDX; unit < GCH * 16; unit += GDIM) {
        const int gc = unit >> 4, h = unit & 15, g = h >> 3, r0 = gc * CH;
        __syncthreads();
        ssd_head_scalars(p, l, r0, h, s_dt, s_ac, tid, wave, lane);
        { const int row = tid >> 2, c0 = (tid & 3) * 32; const bf16_t* src = P + (size_t)(r0 + row) * PW + PBM + g * 128 + c0;
#pragma unroll
          for (int q = 0; q < 4; ++q) *(LAS u32x4*)(Bs + row * 136 + c0 + q * 8) = *(const u32x4*)(src + q * 8); }
        { const int row = tid >> 2, p0 = (tid & 3) * 16; const bf16_t* src = P + (size_t)(r0 + row) * PW + PXS + h * 64 + p0; const float f = s_dt[row] * __expf(s_ac[127] - s_ac[row]);
#pragma unroll
          for (int q = 0; q < 2; ++q) { const u32x4 v = *(const u32x4*)(src + q * 8); LAS float* d = xdd + row * 64 + p0 + q * 8;
              d[0] = bflo(v.x) * f; d[1] = bfhi(v.x) * f; d[2] = bflo(v.y) * f; d[3] = bfhi(v.y) * f; d[4] = bflo(v.z) * f; d[5] = bfhi(v.z) * f; d[6] = bflo(v.w) * f; d[7] = bfhi(v.w) * f; } }
        __syncthreads();
        const int pp = tid >> 3, ng = tid & 7; float acc[16];
#pragma unroll
        for (int j = 0; j < 16; ++j) acc[j] = 0.f;
        for (int ll = 0; ll < CH; ++ll) { const float xv = xdd[ll * 64 + pp]; const u32x4 b0 = *(const LAS u32x4*)(Bs + ll * 136 + ng * 16), b1 = *(const LAS u32x4*)(Bs + ll * 136 + ng * 16 + 8);
            acc[0] += xv * bflo(b0.x); acc[1] += xv * bfhi(b0.x); acc[2] += xv * bflo(b0.y); acc[3] += xv * bfhi(b0.y); acc[4] += xv * bflo(b0.z); acc[5] += xv * bfhi(b0.z); acc[6] += xv * bflo(b0.w); acc[7] += xv * bfhi(b0.w);
            acc[8] += xv * bflo(b1.x); acc[9] += xv * bfhi(b1.x); acc[10] += xv * bflo(b1.y); acc[11] += xv * bfhi(b1.y); acc[12] += xv * bflo(b1.z); acc[13] += xv * bfhi(b1.z); acc[14] += xv * bflo(b1.w); acc[15] += xv * bfhi(b1.w); }
        float* dst = ST + (((size_t)gc * 16 + h) * 64 + pp) * 128 + ng * 16;
#pragma unroll
        for (int q = 0; q < 4; ++q) *(f32x4*)(dst + q * 4) = (f32x4){acc[q * 4], acc[q * 4 + 1], acc[q * 4 + 2], acc[q * 4 + 3]};
        if (tid == 0) CD[gc * 16 + h] = __expf(s_ac[127]);
    }
}
DEV void ph_ssd_scan(const Params& p, int tid) {
    float* ST = (float*)(p.ws + WS_ST); const float* CD = (const float*)(p.ws + WS_CD);
    for (int e = BIDX * NTHREADS + tid; e < NB * 16 * 64 * 128; e += GDIM * NTHREADS) {
        const int b = e >> 17, h = (e >> 13) & 15, pn = e & 8191; float hc = 0.f;
        for (int c = 0; c < NCHUNK; ++c) { const int gc = b * NCHUNK + c; const size_t idx = ((size_t)gc * 16 + h) * 8192 + pn; const float t = ST[idx]; ST[idx] = hc; hc = hc * CD[gc * 16 + h] + t; }
    }
}
DEV void ph_ssd_out(const Params& p, int l, LAS unsigned char* lds, int tid, int wave, int lane) {
    LAS bf16_t* Cs = (LAS bf16_t*)lds;
    LAS bf16_t* Bs = (LAS bf16_t*)(lds + 34816);
    LAS float* prev = (LAS float*)(lds + 34816);
    LAS bf16_t* CBs = (LAS bf16_t*)(lds + 2 * 34816);
    LAS float* xd = (LAS float*)(lds + 3 * 34816);
    LAS float* s_dt = (LAS float*)(lds + 4 * 34816); LAS float* s_ac = s_dt + 128; LAS float* s_ss = s_dt + 256;
    bf16_t* P = (bf16_t*)(p.ws + WS_P); const float* ST = (const float*)(p.ws + WS_ST); float* ROWSS = (float*)(p.ws + WS_ROWSS);
    for (int unit = BIDX; unit < GCH * 2; unit += GDIM) {
        const int gc = unit >> 1, g = unit & 1, r0 = gc * CH;
        __syncthreads();
        { const int row = tid >> 2, c0 = (tid & 3) * 32; const bf16_t* sc = P + (size_t)(r0 + row) * PW + PCM + g * 128 + c0; const bf16_t* sb = P + (size_t)(r0 + row) * PW + PBM + g * 128 + c0;
#pragma unroll
          for (int q = 0; q < 4; ++q) { *(LAS u32x4*)(Cs + row * 136 + c0 + q * 8) = *(const u32x4*)(sc + q * 8); *(LAS u32x4*)(Bs + row * 136 + c0 + q * 8) = *(const u32x4*)(sb + q * 8); } }
        if (tid < CH) s_ss[tid] = 0.f;
        __syncthreads();
        { const int lr = tid >> 2, s0 = (tid & 3) * 32; float acc[32];
#pragma unroll
          for (int j = 0; j < 32; ++j) acc[j] = 0.f;
          for (int n = 0; n < 128; n += 8) { const u32x4 cv = *(const LAS u32x4*)(Cs + lr * 136 + n);
              const float c0 = bflo(cv.x), c1 = bfhi(cv.x), c2 = bflo(cv.y), c3 = bfhi(cv.y), c4 = bflo(cv.z), c5 = bfhi(cv.z), c6 = bflo(cv.w), c7 = bfhi(cv.w);
#pragma unroll
              for (int j = 0; j < 32; ++j) { const u32x4 bv = *(const LAS u32x4*)(Bs + (s0 + j) * 136 + n);
                  acc[j] += c0 * bflo(bv.x) + c1 * bfhi(bv.x) + c2 * bflo(bv.y) + c3 * bfhi(bv.y) + c4 * bflo(bv.z) + c5 * bfhi(bv.z) + c6 * bflo(bv.w) + c7 * bfhi(bv.w); } }
#pragma unroll
          for (int j = 0; j < 32; j += 2) *(LAS unsigned*)(CBs + lr * 136 + s0 + j) = pk2(acc[j], acc[j + 1]); }
        for (int e = 0; e < 8; ++e) {
            const int h = g * 8 + e;
            __syncthreads();
            ssd_head_scalars(p, l, r0, h, s_dt, s_ac, tid, wave, lane);
            { const int pp = tid >> 3, n0 = (tid & 7) * 16; const float* src = ST + (((size_t)gc * 16 + h) * 64 + pp) * 128 + n0;
#pragma unroll
              for (int q = 0; q < 4; ++q) { const f32x4 v = *(const f32x4*)(src + q * 4); LAS float* d = prev + pp * 129 + n0 + q * 4; d[0] = v.x; d[1] = v.y; d[2] = v.z; d[3] = v.w; } }
            const int lr = tid >> 2, p0 = (tid & 3) * 16; float xraw[16];
            { const bf16_t* src = P + (size_t)(r0 + lr) * PW + PXS + h * 64 + p0; const float f = s_dt[lr];
#pragma unroll
              for (int q = 0; q < 2; ++q) { const u32x4 v = *(const u32x4*)(src + q * 8);
                  xraw[q * 8 + 0] = bflo(v.x); xraw[q * 8 + 1] = bfhi(v.x); xraw[q * 8 + 2] = bflo(v.y); xraw[q * 8 + 3] = bfhi(v.y); xraw[q * 8 + 4] = bflo(v.z); xraw[q * 8 + 5] = bfhi(v.z); xraw[q * 8 + 6] = bflo(v.w); xraw[q * 8 + 7] = bfhi(v.w); }
#pragma unroll
              for (int j = 0; j < 16; ++j) xd[lr * 68 + p0 + j] = xraw[j] * f; }
            __syncthreads();
            float y[16], yo[16];
#pragma unroll
            for (int j = 0; j < 16; ++j) { y[j] = 0.f; yo[j] = 0.f; }
            const float al = s_ac[lr];
            for (int s = 0; s <= lr; ++s) { const float cb = bf2f(CBs[lr * 136 + s]) * __expf(al - s_ac[s]);
#pragma unroll
                for (int q = 0; q < 4; ++q) { const f32x4 xv = *(const LAS f32x4*)(xd + s * 68 + p0 + q * 4); y[q * 4] += cb * xv.x; y[q * 4 + 1] += cb * xv.y; y[q * 4 + 2] += cb * xv.z; y[q * 4 + 3] += cb * xv.w; } }
            for (int n = 0; n < 128; ++n) { const float c = bf2f(Cs[lr * 136 + n]);
#pragma unroll
                for (int j = 0; j < 16; ++j) yo[j] += c * prev[(p0 + j) * 129 + n]; }
            const float ea = __expf(al), dh = p.in[I_SD][l * 16 + h];
            bf16_t* zp = P + (size_t)(r0 + lr) * PW + PZ + h * 64 + p0; float ssl = 0.f; unsigned ow[8];
            { const u32x4 z0 = *(const u32x4*)zp, z1 = *(const u32x4*)(zp + 8); float zz[16];
              zz[0] = bflo(z0.x); zz[1] = bfhi(z0.x); zz[2] = bflo(z0.y); zz[3] = bfhi(z0.y); zz[4] = bflo(z0.z); zz[5] = bfhi(z0.z); zz[6] = bflo(z0.w); zz[7] = bfhi(z0.w);
              zz[8] = bflo(z1.x); zz[9] = bfhi(z1.x); zz[10] = bflo(z1.y); zz[11] = bfhi(z1.y); zz[12] = bflo(z1.z); zz[13] = bfhi(z1.z); zz[14] = bflo(z1.w); zz[15] = bfhi(z1.w);
#pragma unroll
              for (int j = 0; j < 16; ++j) { const float v = (y[j] + ea * yo[j] + dh * xraw[j]) * siluf(zz[j]); ssl += v * v; y[j] = v; }
#pragma unroll
              for (int j = 0; j < 8; ++j) ow[j] = pk2(y[2 * j], y[2 * j + 1]); }
            *(u32x4*)zp = (u32x4){ow[0], ow[1], ow[2], ow[3]}; *(u32x4*)(zp + 8) = (u32x4){ow[4], ow[5], ow[6], ow[7]};
            ssl += lane_get(ssl, lane ^ 1); ssl += lane_get(ssl, lane ^ 2);
            if ((tid & 3) == 0) s_ss[lr] += ssl;
        }
        __syncthreads();
        if (tid < CH) ROWSS[(size_t)(r0 + tid) * 2 + g] = s_ss[tid];
    }
}
DEV void ph_mixfinal(const Params& p, int l, int tid) {
    bf16_t* P = (bf16_t*)(p.ws + WS_P); const float* ROWSS = (const float*)(p.ws + WS_ROWSS); const float* ng = p.in[I_SN] + (size_t)l * 1024;
    for (int e = BIDX * NTHREADS + tid; e < M * 512; e += GDIM * NTHREADS) {
        const int row = e >> 9, c = (e & 511) * 2; const float rs = rsqrtf(ROWSS[(size_t)row * 2 + (c >> 9)] * (1.f / 512.f) + EPS);
        unsigned* q = (unsigned*)(P + (size_t)row * PW + PZ + c); const unsigned w = *q; *q = pk2(bflo(w) * rs * ng[c], bfhi(w) * rs * ng[c + 1]);
    }
}

DEV void ph_sb_attn(const Params& p, LAS unsigned char* lds, int gw, int ngw, int wave, int lane) {
    LAS float* qs = (LAS float*)(lds + 65536 + wave * 512);
    bf16_t* P = (bf16_t*)(p.ws + WS_P);
    for (int task = gw; task < NB * 8 * S; task += ngw) {
        const int t = task % S, bh = task / S, h = bh & 7, b = bh >> 3; const size_t rowb = (size_t)b * S;
        bf16_t* qp = P + (rowb + t) * PW + PSQ + h * 64;
        qs[lane] = bf2f(qp[lane]) * 0.125f; LDS_WAIT();
        float o = 0.f, R = 0.f;
        for (int k1 = t - 1; k1 >= 0; k1 -= 64) {
            const int s = k1 - lane; const bool valid = s >= 0; float z = 0.f;
            if (valid) { const bf16_t* kp = P + (rowb + s) * PW + PSK + h * 64;
#pragma unroll
                for (int q = 0; q < 8; ++q) { const u32x4 kv = *(const u32x4*)(kp + q * 8); const LAS float* qq = qs + q * 8;
                    z += qq[0] * bflo(kv.x) + qq[1] * bfhi(kv.x) + qq[2] * bflo(kv.y) + qq[3] * bfhi(kv.y) + qq[4] * bflo(kv.z) + qq[5] * bfhi(kv.z) + qq[6] * bflo(kv.w) + qq[7] * bfhi(kv.w); } }
            const float Lg = valid ? -softplusf(z) : 0.f;
            const float cum = wave_incl_scan(Lg, lane);
            const float w = valid ? __expf(z + R + cum) : 0.f;
            const int nv = (k1 + 1 < 64) ? k1 + 1 : 64;
            for (int i = 0; i < nv; ++i) { const float wi = lane_get(w, i); o += wi * bf2f(P[(rowb + (k1 - i)) * PW + PSV + h * 64 + lane]); }
            R += lane_get(cum, 63);
            if (R < -104.f) break;
        }
        qp[lane] = (bf16_t)f2bf(o);
        LDS_WAIT();
    }
}
DEV void ph_diff_attn(const Params& p, int l, LAS unsigned char* lds, int gw, int ngw, int wave, int lane) {
    LAS float* qs = (LAS float*)(lds + 65536 + 4096 + wave * 512);
    bf16_t* P = (bf16_t*)(p.ws + WS_P); const float* misc = (const float*)(p.ws + WS_MISC);
    const float lam = misc[l]; const float linit = lambda_init_of(l);
    for (int task = gw; task < NB * 4 * S; task += ngw) {
        const int t = task % S, bh = task / S, h = bh & 3, b = bh >> 2; const size_t rowb = (size_t)b * S;
        bf16_t* qp = P + (rowb + t) * PW + PDQ + h * 128;
        qs[lane] = bf2f(qp[lane]) * 0.125f; qs[64 + lane] = bf2f(qp[64 + lane]) * 0.125f; LDS_WAIT();
        const float* bt = misc + 64 + h * 128;
        float m0 = -INFINITY, m1 = -INFINITY, l0 = 0.f, l1 = 0.f, o0a = 0.f, o0b = 0.f, o1a = 0.f, o1b = 0.f;
        for (int k1 = t; k1 >= 0; k1 -= 64) {
            const int s = k1 - lane; const bool valid = s >= 0; float z0 = 0.f, z1 = 0.f;
            if (valid) { const bf16_t* kp = P + (rowb + s) * PW + PDK + h * 128;
#pragma unroll
                for (int q = 0; q < 8; ++q) { const u32x4 kv = *(const u32x4*)(kp + q * 8); const LAS float* qq = qs + q * 8;
                    z0 += qq[0] * bflo(kv.x) + qq[1] * bfhi(kv.x) + qq[2] * bflo(kv.y) + qq[3] * bfhi(kv.y) + qq[4] * bflo(kv.z) + qq[5] * bfhi(kv.z) + qq[6] * bflo(kv.w) + qq[7] * bfhi(kv.w); }
#pragma unroll
                for (int q = 0; q < 8; ++q) { const u32x4 kv = *(const u32x4*)(kp + 64 + q * 8); const LAS float* qq = qs + 64 + q * 8;
                    z1 += qq[0] * bflo(kv.x) + qq[1] * bfhi(kv.x) + qq[2] * bflo(kv.y) + qq[3] * bfhi(kv.y) + qq[4] * bflo(kv.z) + qq[5] * bfhi(kv.z) + qq[6] * bflo(kv.w) + qq[7] * bfhi(kv.w); } }
            const int dist = t - s; const float bias = bt[dist < 127 ? dist : 127];
            z0 = valid ? z0 + bias : -INFINITY; z1 = valid ? z1 + bias : -INFINITY;
            const float n0 = fmaxf(m0, wave_max(z0, lane)), n1 = fmaxf(m1, wave_max(z1, lane));
            const float sc0 = __expf(m0 - n0), sc1 = __expf(m1 - n1);
            const float p0 = valid ? __expf(z0 - n0) : 0.f, p1 = valid ? __expf(z1 - n1) : 0.f;
            l0 = l0 * sc0 + wave_sum(p0, lane); l1 = l1 * sc1 + wave_sum(p1, lane); o0a *= sc0; o0b *= sc0; o1a *= sc1; o1b *= sc1; m0 = n0; m1 = n1;
            const int nv = (k1 + 1 < 64) ? k1 + 1 : 64;
            for (int i = 0; i < nv; ++i) { const float a = lane_get(p0, i), c = lane_get(p1, i); const unsigned vv = *(const unsigned*)(P + (rowb + (k1 - i)) * PW + PDV + h * 128 + 2 * lane);
                const float va = bflo(vv), vb = bfhi(vv); o0a += a * va; o0b += a * vb; o1a += c * va; o1b += c * vb; }
        }
        const float ya = o0a / l0 - lam * o1a / l1, yb = o0b / l0 - lam * o1b / l1;
        const float rs = rsqrtf(wave_sum(ya * ya + yb * yb, lane) * (1.f / 128.f) + EPS) * (1.f - linit);
        const float* sg = p.in[I_SUB] + (size_t)l * 128 + 2 * lane;
        *(unsigned*)(qp + 2 * lane) = pk2(ya * rs * sg[0], yb * rs * sg[1]);
        LDS_WAIT();
    }
}


#include <hip/hip_bf16.h>
#include <cmath>
namespace attn_body {
using bf16=__hip_bfloat16;
using bf16x8=__attribute__((ext_vector_type(8)))short;
using s16x4=__attribute__((ext_vector_type(4)))short;
using f32x16=__attribute__((ext_vector_type(16)))float;
using u32x4=__attribute__((ext_vector_type(4)))unsigned;
constexpr int BATCH=4,SEQ=4096,D=64,DM=5632,OPITCH=1024;
constexpr int NW=8,QBLK=32,QB=QBLK*NW,KVBLK=64,NQB=SEQ/QB;
constexpr int ATTN_PITCH=DM, ATTN_UNIT_ROWS=QB; constexpr int TAB_PAD=264, TAB_N=720;
__device__ __forceinline__ int crow(int r,int hi){return (r&3)+8*(r>>2)+4*hi;}
#define SBAR() __builtin_amdgcn_sched_barrier(0)
__device__ __forceinline__ void cmask(f32x16&p0,f32x16&p1,int jb,int qrel,int hi){
  const float NEG=-INFINITY; int kb=64*jb+4*hi; asm volatile("":"+v"(kb));
  #pragma unroll
  for(int r=0;r<16;++r){int kv=kb+(r&3)+8*(r>>2); if(kv>qrel)p0[r]=NEG; if(kv+32>qrel)p1[r]=NEG;}
}

constexpr int NSLOT=3, SLOTB=8192;
constexpr int LDS_K=0, LDS_V=NSLOT*SLOTB, LDS_WS=2*NSLOT*SLOTB, LDS_OST=LDS_WS+NW*64*4, LDS_BYTES=LDS_OST+NW*4096;
constexpr float C2=0.125f*1.4426950408889634f;
__device__ __forceinline__ void glds16(const void*gsrc,unsigned lds_dst){unsigned keep;
  asm volatile("s_mov_b32 %0, m0\n\ts_mov_b32 m0, %2\n\ts_nop 0\n\tglobal_load_lds_dwordx4 %1, off\n\ts_mov_b32 m0, %0":"=&s"(keep):"v"(gsrc),"s"(lds_dst):"memory");}
__device__ __forceinline__ float max3f(float a,float b,float c){float r;asm("v_max3_f32 %0, %1, %2, %3":"=v"(r):"v"(a),"v"(b),"v"(c));return r;}
__device__ __forceinline__ float max2f(float a,float b){float r;asm("v_max_f32_e32 %0, %1, %2":"=v"(r):"v"(a),"v"(b));return r;}
__device__ __forceinline__ float fadd_s(float a,float b){float r;asm("v_add_f32_e32 %0, %1, %2":"=v"(r):"v"(a),"v"(b));return r;}
__device__ __forceinline__ float fsub_s(float a,float b){float r;asm("v_sub_f32_e32 %0, %1, %2":"=v"(r):"v"(a),"v"(b));return r;}
typedef float f32x2_t __attribute__((ext_vector_type(2))); typedef __bf16 bf16x2_t __attribute__((ext_vector_type(2)));
__device__ __forceinline__ unsigned cvtpk_s(float lo,float hi){f32x2_t v={lo,hi};bf16x2_t b=__builtin_convertvector(v,bf16x2_t);return __builtin_bit_cast(unsigned,b);}
#define WAIT_BAR(N) asm volatile("s_waitcnt vmcnt(" #N ") lgkmcnt(0)\n\ts_barrier":::"memory")

__device__ __forceinline__ void qkt(f32x16&p0,f32x16&p1,const char*Kslot,const bf16x8*qr,int r32,int hi){ const f32x16 zc_={};
  const char*kb=Kslot+hi*1024+r32*16;
  #pragma unroll
  for(int d0=0;d0<4;++d0){
    const bf16x8 b0=*reinterpret_cast<const bf16x8*>(kb+d0*2048);
    const bf16x8 b1=*reinterpret_cast<const bf16x8*>(kb+d0*2048+512);
    if(d0==0){p0=__builtin_amdgcn_mfma_f32_32x32x16_bf16(b0,qr[0],zc_,0,0,0);p1=__builtin_amdgcn_mfma_f32_32x32x16_bf16(b1,qr[0],zc_,0,0,0);}
    else{p0=__builtin_amdgcn_mfma_f32_32x32x16_bf16(b0,qr[d0],p0,0,0,0);p1=__builtin_amdgcn_mfma_f32_32x32x16_bf16(b1,qr[d0],p1,0,0,0);}}
}
typedef __attribute__((address_space(3))) const char* lds_cptr;
typedef short v4i16_t __attribute__((ext_vector_type(4)));
__device__ __forceinline__ void kload8(bf16x8*kf,lds_cptr kp){
  kf[0]=*(const __attribute__((address_space(3))) bf16x8*)(kp);      kf[1]=*(const __attribute__((address_space(3))) bf16x8*)(kp+512);
  kf[2]=*(const __attribute__((address_space(3))) bf16x8*)(kp+2048); kf[3]=*(const __attribute__((address_space(3))) bf16x8*)(kp+2560);
  kf[4]=*(const __attribute__((address_space(3))) bf16x8*)(kp+4096); kf[5]=*(const __attribute__((address_space(3))) bf16x8*)(kp+4608);
  kf[6]=*(const __attribute__((address_space(3))) bf16x8*)(kp+6144); kf[7]=*(const __attribute__((address_space(3))) bf16x8*)(kp+6656);
}
__device__ __forceinline__ void kload2(bf16x8*kf,lds_cptr kp,int j){ kf[2*j]=*(const __attribute__((address_space(3))) bf16x8*)(kp+j*2048); kf[2*j+1]=*(const __attribute__((address_space(3))) bf16x8*)(kp+j*2048+512); }
__device__ __forceinline__ s16x4 vtr(lds_cptr p){ return __builtin_bit_cast(s16x4,__builtin_amdgcn_ds_read_tr16_b64_v4i16((__attribute__((address_space(3))) v4i16_t*)p)); }
__device__ __forceinline__ float rowmax(const f32x16&p0,const f32x16&p1){
  float a=max3f(p0[0],p0[1],p1[0]),b=max3f(p0[2],p0[3],p1[1]);a=max3f(a,p1[2],p1[3]);
  #pragma unroll
  for(int r=4;r<16;r+=4){a=max3f(a,p0[r],p0[r+1]);b=max3f(b,p0[r+2],p0[r+3]);a=max3f(a,p1[r],p1[r+1]);b=max3f(b,p1[r+2],p1[r+3]);}
  const float m=max2f(a,b);
  auto rr=__builtin_amdgcn_permlane32_swap(__float_as_uint(m),__float_as_uint(m),false,false);
  return max2f(__uint_as_float(rr[0]),__uint_as_float(rr[1]));
}
__device__ __forceinline__ void pv(f32x16*o,int vb,bf16x8 pa0,bf16x8 pa1,bf16x8 pa2,bf16x8 pa3){
  #pragma unroll
  for(int d0=0;d0<2;++d0){s16x4 lo[4],hi[4];
    #pragma unroll
    for(int ks=0;ks<4;++ks){
      asm volatile("ds_read_b64_tr_b16 %0,%1 offset:%c2":"=&v"(lo[ks]):"v"(vb),"i"(d0*4096+ks*1024):"memory");
      asm volatile("ds_read_b64_tr_b16 %0,%1 offset:%c2":"=&v"(hi[ks]):"v"(vb),"i"(d0*4096+ks*1024+512):"memory");}
    asm volatile("s_waitcnt lgkmcnt(0)":::"memory");SBAR();
    #define PK(k) (bf16x8){lo[k][0],lo[k][1],lo[k][2],lo[k][3],hi[k][0],hi[k][1],hi[k][2],hi[k][3]}
    o[d0]=__builtin_amdgcn_mfma_f32_32x32x16_bf16(pa0,PK(0),o[d0],0,0,0);
    o[d0]=__builtin_amdgcn_mfma_f32_32x32x16_bf16(pa1,PK(1),o[d0],0,0,0);
    o[d0]=__builtin_amdgcn_mfma_f32_32x32x16_bf16(pa2,PK(2),o[d0],0,0,0);
    o[d0]=__builtin_amdgcn_mfma_f32_32x32x16_bf16(pa3,PK(3),o[d0],0,0,0);
    #undef PK
  }
}

#ifndef ATTN_STORE16
#define ATTN_STORE16(p,v) (*(u32x4*)(p)=(v))
#endif
template<int THRL> __device__ __forceinline__ void attn_unit(int b,int qb,const bf16*Q,const bf16*__restrict__ K,const bf16*__restrict__ V,bf16*O,char*shm,const __attribute__((address_space(3))) float*tabl,const int tid){
  const int lane=tid&63,r32=lane&31,hi=lane>>5; const int wid=__builtin_amdgcn_readfirstlane(tid>>6);
  const long rowbase=(long)b*SEQ; const int q0=qb*QB;
  const bf16*Qw=Q+(rowbase+q0+wid*QBLK)*DM;
  const bf16*Kh=K+rowbase*DM,*Vh=V+rowbase*DM;
  const unsigned lds0=(unsigned)(uintptr_t)shm;
  float*wsf=(float*)(shm+LDS_WS)+wid*64;
  const bf16*ksrc=Kh+(long)lane*DM+wid*8;
  const bf16*vsrc=Vh+(long)(16*(wid&3)+(lane>>2))*DM+(wid>>2)*32+(lane&3)*8;
  const unsigned kdst=lds0+LDS_K+wid*1024, vdst=lds0+LDS_V+wid*1024;
  #define DMA_K(t,slot) glds16(ksrc+(long)(t)*KVBLK*DM,(unsigned)__builtin_amdgcn_readfirstlane(kdst+(slot)))
  #define DMA_V(t,slot) glds16(vsrc+(long)(t)*KVBLK*DM,(unsigned)__builtin_amdgcn_readfirstlane(vdst+(slot)))
  const int vb0=(int)(lds0+LDS_V)+((lane>>4)&1)*32+(lane&3)*8+(4*hi+((lane&15)>>2))*64;
  const char*Kbase=shm+LDS_K; bf16x8 kf[8];
  const lds_cptr shm3=(lds_cptr)shm; const lds_cptr kp0=shm3+LDS_K+hi*1024+r32*16; const lds_cptr vp0=shm3+LDS_V+((lane>>4)&1)*32+(lane&3)*8+(4*hi+((lane&15)>>2))*64;
  const int NT=(q0+QB)/KVBLK;
  DMA_K(0,0);DMA_V(0,0);DMA_K(1,SLOTB);
  bf16x8 qr[4];
  #pragma unroll
  for(int d0=0;d0<4;++d0)qr[d0]=*reinterpret_cast<const bf16x8*>(&Qw[(long)r32*DM+d0*16+hi*8]);
  float z0_=0.f;asm volatile("":"+v"(z0_));
  float mhat=z0_,l_reg=z0_;f32x16 o[2]; const f32x16 zc_={};
  _Pragma("unroll") for(int r=0;r<16;++r){o[0][r]=z0_;o[1][r]=z0_;}
  const int qrel=wid*QBLK+r32;
  #define CMASK(P0,P1,t) do{int jb_=(t)-(NT-4); if(jb_>=0)cmask(P0,P1,jb_,qrel,hi);}while(0)
  #define BIASADD(P0,P1,t) do{ const __attribute__((address_space(3))) float*tp_=tabl+(q0+qrel-64*(t)-4*hi+(TAB_PAD-63)); \
    _Pragma("unroll") for(int r=0;r<16;++r){ const int c_=(r&3)+8*(r>>2); P0[r]+=tp_[63-c_]; P1[r]+=tp_[31-c_]; if((r&1)==1){SBAR();} } }while(0)
  bool resc=false;
  #define START(P0,P1) do{ const float rm=rowmax(P0,P1); resc=false; \
    { const float dl=rm; mhat=fadd_s(mhat,dl); \
      _Pragma("unroll") for(int r=0;r<16;++r){P0[r]=fsub_s(P0[r],dl);P1[r]=fsub_s(P1[r],dl);} \
      } \
    _Pragma("unroll") for(int r=0;r<16;++r)P0[r]=__builtin_amdgcn_exp2f(P0[r]); }while(0)
  #define RESC() do{ if(resc){ asm volatile("s_waitcnt lgkmcnt(0)":::"memory"); \
      _Pragma("unroll") for(int d_=0;d_<2;++d_) _Pragma("unroll") for(int r=0;r<16;++r)o[d_][r]*=wsf[crow(r,hi)]; } }while(0)
  f32x16 pA0,pA1,pB0,pB1;
  int sl_prev=0,sl_cur=0,sl_next=SLOTB;
  #define ROT() do{sl_prev=sl_cur;sl_cur=sl_next;sl_next=(sl_next==(NSLOT-1)*SLOTB)?0:sl_next+SLOTB;}while(0)
  DMA_K(2,2*SLOTB);
  WAIT_BAR(3);
  qkt(pA0,pA1,Kbase,qr,r32,hi);asm volatile("s_nop 15\n\ts_nop 7":"+v"(pA0),"+v"(pA1)); if(NT<=6){BIASADD(pA0,pA1,0);} CMASK(pA0,pA1,0);
  START(pA0,pA1);
  _Pragma("unroll") for(int r=0;r<16;++r)pA1[r]=__builtin_amdgcn_exp2f(pA1[r]);
  WAIT_BAR(0);
  DMA_K(3,0);DMA_V(1,SLOTB);
  ROT();
  kload8(kf,kp0+sl_cur);
  WAIT_BAR(2);
  s16x4 vlo[8],vhi[8]; u32x4 pw0,pw1,pw2,pw3;
  #define PKW(P,B) cvtpk_s(P[B],P[B+1])
  #define PAF(k) __builtin_bit_cast(bf16x8,pw##k)
  #define VFR(i) (bf16x8){vlo[i][0],vlo[i][1],vlo[i][2],vlo[i][3],vhi[i][0],vhi[i][1],vhi[i][2],vhi[i][3]}
  #define PIN(x) asm volatile("":"+v"(x))
  #define MX3(a,b,c) __builtin_fmaxf(__builtin_fmaxf((a),(b)),(c))
  #define GAPA(MF,A0,A1,A2,A3,W0,W1,PW) do{ MF; sacc+=A0; sacc+=A1; sacc+=A2; sacc+=A3; PIN(sacc); W0; W1; PIN(PW); SBAR(); }while(0)
  #define EX(v) __builtin_amdgcn_exp2f(v)
  #define GAPB(MF,X,B) do{ MF; X[B]=EX(X[B]); X[B+1]=EX(X[B+1]); X[B+2]=EX(X[B+2]); X[B+3]=EX(X[B+3]); PIN(X); SBAR(); }while(0)
  #define VRD(i) do{ vlo[i]=vtr(vp_+(((i)>>2)*4096+((i)&3)*1024)); vhi[i]=vtr(vp_+(((i)>>2)*4096+((i)&3)*1024+512)); }while(0)
  #define KRD(G,j) do{ if(G){ kload2(kf,kp0+sl_next,j); SBAR(); } }while(0)
  #define STEP(C0,C1,P0,P1,t,GK,GV,GL) do{ SBAR(); \
    const lds_cptr vp_=vp0+sl_prev; \
    VRD(0); SBAR(); float sacc=(P0[0]+P0[1]); \
    GAPA(C0=__builtin_amdgcn_mfma_f32_32x32x16_bf16(kf[0],qr[0],zc_,0,0,0), P0[2],P0[3],P0[4],P0[5],     pw0[0]=PKW(P0,0), pw0[1]=PKW(P0,2), pw0); \
    VRD(4); SBAR(); GAPA(C1=__builtin_amdgcn_mfma_f32_32x32x16_bf16(kf[1],qr[0],zc_,0,0,0), P0[6],P0[7],P0[8],P0[9],     pw0[2]=PKW(P0,4), pw0[3]=PKW(P0,6), pw0); \
    VRD(1); SBAR(); GAPA(C0=__builtin_amdgcn_mfma_f32_32x32x16_bf16(kf[2],qr[1],C0,0,0,0),   P0[10],P0[11],P0[12],P0[13], pw1[0]=PKW(P0,8), pw1[1]=PKW(P0,10), pw1); \
    VRD(5); SBAR(); GAPA(C1=__builtin_amdgcn_mfma_f32_32x32x16_bf16(kf[3],qr[1],C1,0,0,0),   P0[14],P0[15],P1[0],P1[1],   pw1[2]=PKW(P0,12),pw1[3]=PKW(P0,14), pw1); \
    VRD(2); SBAR(); GAPA(C0=__builtin_amdgcn_mfma_f32_32x32x16_bf16(kf[4],qr[2],C0,0,0,0),   P1[2],P1[3],P1[4],P1[5],     pw2[0]=PKW(P1,0), pw2[1]=PKW(P1,2), pw2); \
    VRD(6); SBAR(); GAPA(C1=__builtin_amdgcn_mfma_f32_32x32x16_bf16(kf[5],qr[2],C1,0,0,0),   P1[6],P1[7],P1[8],P1[9],     pw2[2]=PKW(P1,4), pw2[3]=PKW(P1,6), pw2); \
    VRD(3); SBAR(); GAPA(C0=__builtin_amdgcn_mfma_f32_32x32x16_bf16(kf[6],qr[3],C0,0,0,0),   P1[10],P1[11],P1[12],P1[13], pw3[0]=PKW(P1,8), pw3[1]=PKW(P1,10), pw3); \
    VRD(7); SBAR(); GAPA(C1=__builtin_amdgcn_mfma_f32_32x32x16_bf16(kf[7],qr[3],C1,0,0,0),   P1[14],P1[15],0.f,0.f,       pw3[2]=PKW(P1,12),pw3[3]=PKW(P1,14), pw3); \
    l_reg+=sacc; \
    if(GK){DMA_K((t)+3,sl_cur);} if(GV){DMA_V((t)+1,sl_next);} \
    BIASQ(C0,C1,t); CMASK(C0,C1,t); \
    { float a=MX3(C0[0],C0[1],C1[0]),b=MX3(C0[2],C0[3],C1[1]); a=MX3(a,C1[2],C1[3]); \
      _Pragma("unroll") for(int r=4;r<16;r+=4){a=MX3(a,C0[r],C0[r+1]);b=MX3(b,C0[r+2],C0[r+3]);a=MX3(a,C1[r],C1[r+1]);b=MX3(b,C1[r+2],C1[r+3]);} \
      float rm=__builtin_fmaxf(a,b); { auto rr=__builtin_amdgcn_permlane32_swap(__float_as_uint(rm),__float_as_uint(rm),false,false); rm=__builtin_fmaxf(__uint_as_float(rr[0]),__uint_as_float(rr[1])); } \
      rm-=mhat; resc=false; \
      if(__builtin_expect(__any(rm>(float)THRL),0)){ const float dl=__builtin_fmaxf(rm,0.f); mhat+=dl; \
        const float f=__builtin_amdgcn_exp2f(-dl); l_reg*=f; if(hi==0)wsf[r32]=f; resc=true; } \
      _Pragma("unroll") for(int r=0;r<16;++r){C0[r]-=mhat;C1[r]-=mhat;} } \
    SBAR(); \
    GAPB(o[0]=__builtin_amdgcn_mfma_f32_32x32x16_bf16(PAF(0),VFR(0),o[0],0,0,0), C0,0); \
    GAPB(o[1]=__builtin_amdgcn_mfma_f32_32x32x16_bf16(PAF(0),VFR(4),o[1],0,0,0), C0,4); \
    KRD(GL,0); GAPB(o[0]=__builtin_amdgcn_mfma_f32_32x32x16_bf16(PAF(1),VFR(1),o[0],0,0,0), C0,8); \
    KRD(GL,1); GAPB(o[1]=__builtin_amdgcn_mfma_f32_32x32x16_bf16(PAF(1),VFR(5),o[1],0,0,0), C0,12); \
    KRD(GL,2); GAPB(o[0]=__builtin_amdgcn_mfma_f32_32x32x16_bf16(PAF(2),VFR(2),o[0],0,0,0), C1,0); \
    KRD(GL,3); GAPB(o[1]=__builtin_amdgcn_mfma_f32_32x32x16_bf16(PAF(2),VFR(6),o[1],0,0,0), C1,4); \
    GAPB(o[0]=__builtin_amdgcn_mfma_f32_32x32x16_bf16(PAF(3),VFR(3),o[0],0,0,0), C1,8); \
    GAPB(o[1]=__builtin_amdgcn_mfma_f32_32x32x16_bf16(PAF(3),VFR(7),o[1],0,0,0), C1,12); \
    }while(0)
  int t=1;
  #undef CMASK
  #define CMASK(P0,P1,t) do{}while(0)
  #define BIASQ(P0,P1,t) do{}while(0)
  for(;t+7<NT;t+=2){
    STEP(pB0,pB1,pA0,pA1,t,true,true,true);     WAIT_BAR(2); RESC(); ROT();
    STEP(pA0,pA1,pB0,pB1,t+1,true,true,true);   WAIT_BAR(2); RESC(); ROT();
  }
  #undef CMASK
  #undef BIASQ
  #define CMASK(P0,P1,t) do{int jb_=(t)-(NT-4); if(jb_>=0)cmask(P0,P1,jb_,qrel,hi);}while(0)
  #define BIASQ(P0,P1,t) BIASADD(P0,P1,t)
  #define ENDW(tt) do{ if((tt)+3<NT){WAIT_BAR(2);} else if((tt)+2<NT){WAIT_BAR(1);} else {WAIT_BAR(0);} }while(0)
  for(;t+1<NT;t+=2){
    STEP(pB0,pB1,pA0,pA1,t,(t+3<NT),(t+1<NT),(t+1<NT));       ENDW(t);   RESC(); ROT();
    STEP(pA0,pA1,pB0,pB1,t+1,(t+4<NT),(t+2<NT),(t+2<NT));     ENDW(t+1); RESC(); ROT();
  }
  STEP(pB0,pB1,pA0,pA1,NT-1,false,false,false); RESC();
  { float sacc=pB0[0]+pB0[1]; _Pragma("unroll") for(int r=2;r<16;++r)sacc+=pB0[r]; _Pragma("unroll") for(int r=0;r<16;++r)sacc+=pB1[r]; l_reg+=sacc;
    pw0=(u32x4){PKW(pB0,0),PKW(pB0,2),PKW(pB0,4),PKW(pB0,6)};pw1=(u32x4){PKW(pB0,8),PKW(pB0,10),PKW(pB0,12),PKW(pB0,14)};pw2=(u32x4){PKW(pB1,0),PKW(pB1,2),PKW(pB1,4),PKW(pB1,6)};pw3=(u32x4){PKW(pB1,8),PKW(pB1,10),PKW(pB1,12),PKW(pB1,14)};
    SBAR(); pv(o,vb0+sl_cur,PAF(0),PAF(1),PAF(2),PAF(3)); }
  #undef PKW
  #undef PAF
  #undef VFR
  #undef PIN
  #undef MX3
  #undef GAPA
  #undef GAPB
  #undef EX
  #undef VRD
  #undef KRD
  #undef STEP
  #undef ENDW
  {auto rr=__builtin_amdgcn_permlane32_swap(__float_as_uint(l_reg),__float_as_uint(l_reg),false,false);l_reg=__uint_as_float(rr[0])+__uint_as_float(rr[1]);}
  int lane_e=lane; asm volatile("":"+v"(lane_e)); const int r32e=lane_e&31,hie=lane_e>>5;
  float*wsfe=(float*)(shm+LDS_WS)+wid*64;
  if(hie==0)wsfe[32+r32e]=l_reg;asm volatile("s_waitcnt lgkmcnt(0)":::"memory");
  float rli[16];
  #pragma unroll
  for(int r=0;r<16;++r)rli[r]=__builtin_amdgcn_rcpf(wsfe[32+crow(r,hie)]);
  bf16*Ow=O+(rowbase+q0+wid*QBLK)*OPITCH;
  { bf16*stg=(bf16*)(shm+LDS_OST)+wid*2048;
    #pragma unroll
    for(int r=0;r<16;++r){const int orow=crow(r,hie);
      #pragma unroll
      for(int d0=0;d0<2;++d0)stg[orow*64+d0*32+r32e]=__float2bfloat16(o[d0][r]*rli[r]);}
    asm volatile("s_waitcnt lgkmcnt(0)":::"memory");
    #pragma unroll
    for(int i=0;i<4;++i){const int row=i*8+(lane_e>>3),ch=lane_e&7; const u32x4 v=*(const u32x4*)(stg+row*64+ch*8); ATTN_STORE16(Ow+(long)row*OPITCH+ch*8,v);} }
  asm volatile("s_waitcnt lgkmcnt(0)\n\ts_barrier":::"memory");
  #undef DMA_K
  #undef DMA_V
  #undef CMASK
  #undef BIASQ
  #undef BIASADD
  #undef START
  #undef RESC
  #undef ROT
}
constexpr int ATTN_LDS_BYTES=LDS_BYTES;
template<int THRL=8> __device__ __forceinline__ void diff_attn_phase(char*lds,const bf16*P,bf16*OD,const __attribute__((address_space(3))) float*tab,int vcu,int G,const int tid){
  for(int st=vcu;st<256;st+=G){
    #pragma unroll 1
    for(int i=0;i<4;++i){ int st_=st; asm volatile("":"+s"(st_)); int tid_=tid; asm volatile("":"+v"(tid_));
      const int bhv=st_>>2,s=st_&3,b=bhv>>4,hv=bhv&15,h=hv>>2,m=(hv>>1)&1,vh=hv&1;
      const bf16*Q=P+1536+h*128+m*64,*K=P+3072+h*128+m*64,*V=P+3584+h*128+vh*64; bf16*O=OD+hv*64;
      const int qb=(i==0)?s:(i==1)?7-s:(i==2)?8+s:15-s; attn_unit<THRL>(b,qb,Q,K,V,O,lds,tab+h*TAB_N,tid_); } }
}
#undef SBAR
#undef WAIT_BAR
}
#define GAS __attribute__((address_space(1)))
typedef GAS unsigned gu32;
#define RLX_AGENT __ATOMIC_RELAXED, __HIP_MEMORY_SCOPE_AGENT
#define XB_TMO      128
#define XB_XCNT(j)  (256  + 64 * (j))
#define XB_XSUB(j)  (1280 + 64 * (j))
#define XB_XGEN(j)  (2304 + 64 * (j))
#define XB_TOP      3328
#define XB_TOPGEN   3392
#define XCD_BAR_WORDS 3456
#define XB_SPIN_CAP (1u << 18)

__device__ __forceinline__ unsigned xb_ld(unsigned* p)              { return __hip_atomic_load(p, __ATOMIC_RELAXED, __HIP_MEMORY_SCOPE_AGENT); }
__device__ __forceinline__ unsigned xb_add(unsigned* p, unsigned v) { return __hip_atomic_fetch_add(p, v, __ATOMIC_RELAXED, __HIP_MEMORY_SCOPE_AGENT); }
__device__ __forceinline__ unsigned xb_xcc_id() { return (unsigned)__builtin_amdgcn_s_getreg((3 << 11) | 20) & 0xFu; }
#define XB_SPIN(cond, bar) do { unsigned _sp = 0; while (cond) { __builtin_amdgcn_s_sleep(1); \
    if ((++_sp & 255u) == 0u) { if (xb_ld(&(bar)[XB_TMO])) break; if (_sp > XB_SPIN_CAP) { atomicAdd(&(bar)[XB_TMO], 1u); break; } } } } while (0)

struct XcdBarrier {
    unsigned* bar; unsigned x; bool lead;
    volatile LAS unsigned* st;
};

__device__ __forceinline__ XcdBarrier xcd_barrier_post(unsigned* bar, volatile LAS unsigned* st) {
    XcdBarrier b; b.bar = bar; b.x = xb_xcc_id(); b.st = st; b.lead = threadIdx.x == 0;
    if (threadIdx.x == 0) (void)xb_add(&bar[XB_XCNT(b.x)], 1u);
    return b;
}
__device__ __forceinline__ void xcd_barrier_complete(unsigned* bar, unsigned x, unsigned& nloc, unsigned& nx) {
    const unsigned G = gridDim.x * gridDim.y * gridDim.z;
    unsigned sum, cnt, mine, sp = 0u;
    for (;;) {
        sum = 0u; cnt = 0u; mine = 0u;
#pragma unroll
        for (unsigned j = 0; j < 16; ++j) { const unsigned c = xb_ld(&bar[XB_XCNT(j)]); sum += c; cnt += (c > 0u) ? 1u : 0u; mine = (j == x) ? c : mine; }
        if (sum == G) break;
        __builtin_amdgcn_s_sleep(1);
        if ((++sp & 255u) == 0u) { if (xb_ld(&bar[XB_TMO])) break; if (sp > XB_SPIN_CAP) { atomicAdd(&bar[XB_TMO], 1u); break; } }
    }
    nloc = mine > 0u ? mine : 1u; nx = cnt > 0u ? cnt : 1u;
}

__device__ __forceinline__ void xcd_barrier(const XcdBarrier& b) {
    asm volatile("s_waitcnt vmcnt(0)" ::: "memory");
    __syncthreads();
    if (b.lead) {
        unsigned* bar = b.bar;
        __builtin_amdgcn_s_waitcnt(0);
        unsigned nloc = b.st[0], nx = b.st[1];
        if (nloc == 0u) { xcd_barrier_complete(bar, b.x, nloc, nx); b.st[0] = nloc; b.st[1] = nx; }
        const unsigned old = xb_add(&bar[XB_XSUB(b.x)], 1u);
        const unsigned gen = old / nloc;
        if (old + 1u == (gen + 1u) * nloc) {
            __builtin_amdgcn_fence(__ATOMIC_RELEASE, "agent");
            asm volatile("s_waitcnt vmcnt(0)" ::: "memory");
            const unsigned og = xb_add(&bar[XB_TOP], 1u);
            const unsigned tg = og / nx;
            if (og + 1u == (tg + 1u) * nx) xb_add(&bar[XB_TOPGEN], 1u);
            else XB_SPIN(xb_ld(&bar[XB_TOPGEN]) == tg, bar);
            __builtin_amdgcn_fence(__ATOMIC_ACQUIRE, "agent");
            xb_add(&bar[XB_XGEN(b.x)], 1u);
            asm volatile("s_waitcnt vmcnt(0)" ::: "memory");
        } else {
            XB_SPIN(xb_ld(&bar[XB_XGEN(b.x)]) == gen, bar);
            __builtin_amdgcn_fence(__ATOMIC_ACQUIRE, "agent");
            asm volatile("s_waitcnt vmcnt(0)" ::: "memory");
        }
    }
    __syncthreads();
}
DEV void ph_diff_combine(const Params& p, int l, int gw, int ngw, int lane) {
    bf16_t* P = (bf16_t*)(p.ws + WS_P); const bf16_t* OD = (const bf16_t*)(p.ws + WS_OD); const float* misc = (const float*)(p.ws + WS_MISC);
    const float lam = misc[l]; const float linit = lambda_init_of(l);
    const float g0 = p.in[I_SUB][(size_t)l * 128 + 2 * lane] * (1.f - linit), g1 = p.in[I_SUB][(size_t)l * 128 + 2 * lane + 1] * (1.f - linit);
    for (int row = gw; row < M; row += ngw) {
#pragma unroll
        for (int h = 0; h < 4; ++h) { const unsigned o0 = *(const unsigned*)(OD + (size_t)row * 1024 + h * 256 + 2 * lane), o1 = *(const unsigned*)(OD + (size_t)row * 1024 + h * 256 + 128 + 2 * lane);
            const float ya = bflo(o0) - lam * bflo(o1), yb = bfhi(o0) - lam * bfhi(o1);
            const float rs = rsqrtf(wave_sum(ya * ya + yb * yb, lane) * (1.f / 128.f) + EPS);
            *(unsigned*)(P + (size_t)row * PW + PDQ + h * 128 + 2 * lane) = pk2(ya * rs * g0, yb * rs * g1); }
    }
}
constexpr int LDS_TAB_OFF = 86016;
DEV void ph_diff_table(const Params& p, LAS unsigned char* lds, int tid) {
    LAS float* tab = (LAS float*)(lds + LDS_TAB_OFF); const float* bt = (const float*)(p.ws + WS_MISC) + 64;
    for (int j = tid; j < 4 * attn_body::TAB_N; j += NTHREADS) { const int h = j / attn_body::TAB_N, d = j % attn_body::TAB_N - attn_body::TAB_PAD;
        tab[j] = (d >= 0 && d < 127) ? (bt[h * 128 + d] - bt[h * 128 + 127]) * 1.4426950408889634f : 0.f; }
}
#ifndef MK_FUSED
#define MK_FUSED 1
#endif
constexpr int PH_PER_LAYER = 15, N_PHASES = NL * PH_PER_LAYER + 1;
template <int ST>
__global__ void __launch_bounds__(NTHREADS, 2) mk_phase(Params p, int l) {
    extern __shared__ __attribute__((aligned(16))) unsigned char lds_raw[];
    LAS unsigned char* lds = (LAS unsigned char*)lds_raw;
    const int tid = threadIdx.x, lane = tid & 63, wave = __builtin_amdgcn_readfirstlane(tid >> 6);
    const int gw = BIDX * NWAVES + wave, ngw = GDIM * NWAVES;
    bf16_t* wt = (bf16_t*)(p.ws + WS_WT); bf16_t* XN = (bf16_t*)(p.ws + WS_XN); bf16_t* P = (bf16_t*)(p.ws + WS_P); bf16_t* H = (bf16_t*)(p.ws + WS_H);
    float* DT = (float*)(p.ws + WS_DT); bf16_t* HALO = (bf16_t*)(p.ws + WS_HALO); const float* mod = (const float*)(p.ws + WS_MOD);
    if constexpr (ST == 15) { ph_final_norm(p.out, p.in[I_FN], gw, ngw, lane); return; }
    const float* modl = mod + (size_t)l * NB * MODW;
    const float* xcur = (l == 0 && ST <= 3) ? p.in[I_X] : p.out;
    if constexpr (ST == 0) { ph_convert(p, l, lds, gw, ngw, wave, lane); if (l == 0) ph_mod(p, lds, tid, wave, lane); }
    if constexpr (ST == 1) ph_norm(xcur, p.in[I_N1] + (size_t)l * D, modl, 0, 1, XN, gw, ngw, lane);
    if constexpr (ST == 2) { pg8::Gemm g{XN, wt + WT_13A / 2, M, 2 * DFF, D, D}; pg8::StaticOrder So; So.init(M, 2 * DFF, (int)GDIM, (int)BIDX); pg8::EpiSwigluT E{H}; pg8::gemm_phase<pg8::EpiSwigluT, pg8::StaticOrder, true, true>(lds, g, So, E, tid); }
    if constexpr (ST == 3) { pg8::Gemm g{H, wt + WT_2A / 2, M, D, DFF, DFF}; pg8::StaticOrder So; So.init(M, D, (int)GDIM, (int)BIDX); pg8::EpiResidT E{xcur, p.out, modl + 2 * D, 0.5f}; pg8::gemm_phase<pg8::EpiResidT, pg8::StaticOrder, true, true>(lds, g, So, E, tid); }
    if constexpr (ST == 4) ph_norm(p.out, p.in[I_NM] + (size_t)l * D, modl, 3, 4, XN, gw, ngw, lane);
    if constexpr (ST == 5) { pg8::Gemm g{XN, wt + WT_IN / 2, M, NIN, D, D}; pg8::StaticOrder So; So.init(M, NIN, (int)GDIM, (int)BIDX); pg8::EpiInT E{P, DT, HALO}; pg8::gemm_phase<pg8::EpiInT, pg8::StaticOrder, true, true>(lds, g, So, E, tid); }
    if constexpr (ST == 6) ph_conv(p, l, tid);
    if constexpr (ST == 7) ph_ssd_state(p, l, lds, tid, wave, lane);
    if constexpr (ST == 16) ph_sb_attn(p, lds, gw, ngw, wave, lane);
    if constexpr (ST == 17) ph_diff_attn(p, l, lds, gw, ngw, wave, lane);
    if constexpr (ST == 8) ph_ssd_scan(p, tid);
    if constexpr (ST == 9) ph_ssd_out(p, l, lds, tid, wave, lane);
    if constexpr (ST == 10) ph_mixfinal(p, l, tid);
    if constexpr (ST == 11) { pg8::Gemm g{P, wt + WT_OUT / 2, M, D, 2048, PW}; pg8::StaticOrder So; So.init(M, D, (int)GDIM, (int)BIDX); pg8::EpiResidT E{p.out, p.out, modl + 5 * D, 1.0f}; pg8::gemm_phase<pg8::EpiResidT, pg8::StaticOrder, true, true>(lds, g, So, E, tid); }
    if constexpr (ST == 12) ph_norm(p.out, p.in[I_N2] + (size_t)l * D, modl, 6, 7, XN, gw, ngw, lane);
    if constexpr (ST == 13) { pg8::Gemm g{XN, wt + WT_13B / 2, M, 2 * DFF, D, D}; pg8::StaticOrder So; So.init(M, 2 * DFF, (int)GDIM, (int)BIDX); pg8::EpiSwigluT E{H}; pg8::gemm_phase<pg8::EpiSwigluT, pg8::StaticOrder, true, true>(lds, g, So, E, tid); }
    if constexpr (ST == 14) { pg8::Gemm g{H, wt + WT_2B / 2, M, D, DFF, DFF}; pg8::StaticOrder So; So.init(M, D, (int)GDIM, (int)BIDX); pg8::EpiResidT E{p.out, p.out, modl + 8 * D, 0.5f}; pg8::gemm_phase<pg8::EpiResidT, pg8::StaticOrder, true, true>(lds, g, So, E, tid); }
}


constexpr int LDS_MISC_OFF = 147456 - 64;
DEV Params load_params(const __attribute__((address_space(4))) Params* pp) { Params q;
#pragma unroll
    for (int i = 0; i < 26; ++i) q.in[i] = pp->in[i];
    q.out = pp->out; q.ws = pp->ws; return q; }
#define KARGS() const __attribute__((address_space(4))) Params* pp_ = (const __attribute__((address_space(4))) Params*)__builtin_amdgcn_kernarg_segment_ptr(); asm volatile("" : "+s"(pp_)); const Params p = load_params(pp_)
__global__ void __launch_bounds__(NTHREADS, 2) mk_fwd(Params p_arg) {
    extern __shared__ __attribute__((aligned(16))) unsigned char lds_raw[];
    LAS unsigned char* lds = (LAS unsigned char*)lds_raw;
    volatile LAS unsigned* MISC = (volatile LAS unsigned*)(lds + LDS_MISC_OFF);
    const int wave_s = __builtin_amdgcn_readfirstlane((int)threadIdx.x >> 6);
    if (threadIdx.x < 16) MISC[threadIdx.x] = 0u;
    __syncthreads();
    { KARGS(); (void)xcd_barrier_post((unsigned*)(p.ws + WS_BAR), MISC + 8); }
#define IDS() KARGS(); const int wave = wave_s; const int lane = olane(); const int tid = wave * 64 + lane; const int gw = BIDX * NWAVES + wave, ngw = GDIM * NWAVES; (void)lane; (void)gw; (void)ngw; \
    bf16_t* wt = (bf16_t*)(p.ws + WS_WT); bf16_t* XN = (bf16_t*)(p.ws + WS_XN); bf16_t* P = (bf16_t*)(p.ws + WS_P); bf16_t* H = (bf16_t*)(p.ws + WS_H); (void)wt; (void)XN; (void)P; (void)H; \
    const float* modl = (const float*)(p.ws + WS_MOD) + (size_t)l * NB * MODW; const float* xin = (l == 0) ? p.in[I_X] : p.out; (void)modl; (void)xin;
#define GEMM(A_, lda_, W_, N_, K_, EPI, ...) do { pg8::Gemm g{A_, W_, M, N_, K_, lda_}; pg8::StaticOrder So; So.init(M, N_, (int)GDIM, (int)BIDX); pg8::EPI E{__VA_ARGS__}; \
        pg8::gemm_phase<pg8::EPI, pg8::StaticOrder, true, true>(lds, g, So, E, tid); } while (0)
#define SYNC() do { KARGS(); XcdBarrier bar_; bar_.bar = (unsigned*)(p.ws + WS_BAR); bar_.x = xb_xcc_id(); bar_.st = (volatile LAS unsigned*)(lds + LDS_MISC_OFF) + 8; bar_.lead = (wave_s == 0) && (olane() == 0); xcd_barrier(bar_); } while (0)
#pragma unroll 1
    for (int l = 0; l < NL; ++l) {
        { IDS(); ph_convert(p, l, lds, gw, ngw, wave, lane); if (l == 0) ph_mod(p, lds, tid, wave, lane); }
        SYNC();
        { IDS(); ph_norm(xin, p.in[I_N1] + (size_t)l * D, modl, 0, 1, XN, gw, ngw, lane); }
        SYNC();
        { IDS(); GEMM(XN, D, wt + WT_13A / 2, 2 * DFF, D, EpiSwigluT, H); }
        SYNC();
        { IDS(); GEMM(H, DFF, wt + WT_2A / 2, D, DFF, EpiResidT, xin, p.out, modl + 2 * D, 0.5f); }
        SYNC();
        { IDS(); ph_norm(p.out, p.in[I_NM] + (size_t)l * D, modl, 3, 4, XN, gw, ngw, lane); }
        SYNC();
        { IDS(); GEMM(XN, D, wt + WT_IN / 2, NIN, D, EpiInT, P, (float*)(p.ws + WS_DT), (bf16_t*)(p.ws + WS_HALO)); }
        SYNC();
        { IDS(); ph_conv(p, l, tid); }
        SYNC();
        { IDS(); ph_ssd_state(p, l, lds, tid, wave, lane); __syncthreads(); }
        { IDS(); ph_sb_attn(p, lds, gw, ngw, wave, lane); }
        { IDS(); __syncthreads(); ph_diff_table(p, lds, tid); __syncthreads(); const int G = GDIM, bid = BIDX; const int vcu = (G % 8 == 0) ? (bid % 8) * (G / 8) + bid / 8 : bid;
          attn_body::diff_attn_phase<8>((char*)lds_raw, (const attn_body::bf16*)P, (attn_body::bf16*)(p.ws + WS_OD), (const LAS float*)(lds + LDS_TAB_OFF), vcu, G, tid); }
        SYNC();
        { IDS(); ph_ssd_scan(p, tid); }
        SYNC();
        { IDS(); ph_ssd_out(p, l, lds, tid, wave, lane); }
        SYNC();
        { IDS(); ph_mixfinal(p, l, tid); ph_diff_combine(p, l, gw, ngw, lane); }
        SYNC();
        { IDS(); GEMM(P, PW, wt + WT_OUT / 2, D, 2048, EpiResidT, p.out, p.out, modl + 5 * D, 1.0f); }
        SYNC();
        { IDS(); ph_norm(p.out, p.in[I_N2] + (size_t)l * D, modl, 6, 7, XN, gw, ngw, lane); }
        SYNC();
        { IDS(); GEMM(XN, D, wt + WT_13B / 2, 2 * DFF, D, EpiSwigluT, H); }
        SYNC();
        { IDS(); GEMM(H, DFF, wt + WT_2B / 2, D, DFF, EpiResidT, p.out, p.out, modl + 8 * D, 0.5f); }
        SYNC();
    }
    { const int l = 0; IDS(); ph_final_norm(p.out, p.in[I_FN], gw, ngw, lane); }
}

constexpr int LDS_BYTES = 147456;
extern "C" void kernel_launch(void* const* d_in, const int* in_sizes, int n_in, void* d_out, int out_size, void* d_ws, size_t ws_size, hipStream_t stream) {
    static int grid = 0;
    if (grid == 0) {
        if (n_in != 26 || out_size != M * D || ws_size < WS_END) { fprintf(stderr, "kernel_launch: unexpected shapes (n_in %d out %d ws %zu)\n", n_in, out_size, ws_size); grid = -1; return; }
        int dev = 0, cus = 0;
        if (hipGetDevice(&dev) != hipSuccess || hipDeviceGetAttribute(&cus, hipDeviceAttributeMultiprocessorCount, dev) != hipSuccess) { grid = -1; return; }
        if (hipFuncSetAttribute((const void*)mk_fwd, hipFuncAttributeMaxDynamicSharedMemorySize, LDS_BYTES) != hipSuccess) { grid = -1; return; }
#define SETATTR(ST) if (hipFuncSetAttribute((const void*)mk_phase<ST>, hipFuncAttributeMaxDynamicSharedMemorySize, LDS_BYTES) != hipSuccess) { grid = -1; return; }
        SETATTR(0) SETATTR(1) SETATTR(2) SETATTR(3) SETATTR(4) SETATTR(5) SETATTR(6) SETATTR(7) SETATTR(8) SETATTR(9) SETATTR(10) SETATTR(11) SETATTR(12) SETATTR(13) SETATTR(14) SETATTR(15) SETATTR(16) SETATTR(17)
        grid = cus;
    }
    if (grid < 0) return;
    Params p{};
    for (int i = 0; i < 26; ++i) p.in[i] = (const float*)d_in[i];
    p.out = (float*)d_out; p.ws = (unsigned char*)d_ws;
#if MK_FUSED
    (void)hipMemsetAsync((char*)d_ws + WS_BAR, 0, 64 * KiB, stream);
    hipLaunchKernelGGL(mk_fwd, dim3(grid), dim3(NTHREADS), LDS_BYTES, stream, p);
#else
#define LAUNCH(ST, l) hipLaunchKernelGGL(mk_phase<ST>, dim3(grid), dim3(NTHREADS), LDS_BYTES, stream, p, l)
    for (int l = 0; l < NL; ++l) {
        LAUNCH(0, l); LAUNCH(1, l); LAUNCH(2, l); LAUNCH(3, l); LAUNCH(4, l); LAUNCH(5, l); LAUNCH(6, l); LAUNCH(7, l); LAUNCH(16, l);
        LAUNCH(8, l); LAUNCH(9, l); LAUNCH(10, l); LAUNCH(11, l); LAUNCH(12, l); LAUNCH(13, l); LAUNCH(14, l);
    }
    LAUNCH(15, 0);
#endif
}
```

```cpp
#include <hip/hip_runtime.h>
#include <cstdio>
#include <cstdint>
#include <cmath>

#define DEV __device__ __forceinline__
#define LAS __attribute__((address_space(3)))
typedef unsigned short bf16_t;
typedef unsigned u32x4 __attribute__((ext_vector_type(4)));
typedef unsigned u32x2 __attribute__((ext_vector_type(2)));
typedef float f32x4 __attribute__((ext_vector_type(4)));

constexpr int D = 1024, NB = 4, S = 4096, M = NB * S, NL = 2, DFF = 2816, MODW = 9 * D;
constexpr int PW = 5632, NIN = 5888;
constexpr int PZ = 0, PSQ = 1024, PDQ = 1536, PSK = 2048, PSV = 2560, PDK = 3072, PDV = 3584, PXBC = 4096;
constexpr int PXS = PXBC, PBM = PXBC + 1024, PCM = PXBC + 1280;
constexpr int CH = 128, NCHUNK = S / CH, GCH = NB * NCHUNK;
constexpr float EPS = 1e-6f;
constexpr int NTHREADS = 512, NWAVES = 8;

constexpr size_t KiB = 1024, MiB = 1024 * 1024;
constexpr size_t WS_BAR = 0;
constexpr size_t WS_MOD = 64 * KiB;
constexpr size_t WS_ROWSS = 352 * KiB;
constexpr size_t WS_CD = 480 * KiB;
constexpr size_t WS_MISC = 488 * KiB;
constexpr size_t WS_HALO = 512 * KiB;
constexpr size_t WS_WT = 2 * MiB;
constexpr size_t WT_13A = 0, WT_2A = 11 * MiB, WT_IN = 16 * MiB + 512 * KiB, WT_OUT = 28 * MiB, WT_13B = 32 * MiB, WT_2B = 43 * MiB;
constexpr size_t WS_XN = 51 * MiB;
constexpr size_t WS_ST = 51 * MiB;
constexpr size_t WS_P = 115 * MiB;
constexpr size_t WS_H = WS_P;
constexpr size_t WS_DT = 291 * MiB;
constexpr size_t WS_OD = 292 * MiB;
constexpr size_t WS_END = 324 * MiB;

struct Params { const float* in[26]; float* out; unsigned char* ws; };
enum { I_X = 0, I_C, I_ADAW, I_ADAB, I_N1, I_W13A, I_W2A, I_NM, I_WIN, I_CW, I_CB, I_DTB, I_ALOG, I_SD, I_SN, I_LQ1, I_LK1, I_LQ2, I_LK2, I_SUB, I_RB, I_WOUT, I_N2, I_W13B, I_W2B, I_FN };

DEV float bf2f(bf16_t v) { return __uint_as_float(((unsigned)v) << 16); }
DEV float bflo(unsigned w) { return __uint_as_float(w << 16); }
DEV float bfhi(unsigned w) { return __uint_as_float(w & 0xffff0000u); }
DEV unsigned f2bf(float f) { unsigned u = __float_as_uint(f); return (u + 0x7fffu + ((u >> 16) & 1u)) >> 16; }
DEV unsigned pk2(float lo, float hi) { return f2bf(lo) | (f2bf(hi) << 16); }
DEV float siluf(float x) { return x / (1.f + __expf(-x)); }
DEV float softplusf(float x) { return fmaxf(x, 0.f) + __logf(1.f + __expf(-fabsf(x))); }
DEV float lane_get(float v, int src) { return __int_as_float(__builtin_amdgcn_ds_bpermute(src << 2, __float_as_int(v))); }
DEV float wave_sum(float v, int lane) {
#pragma unroll
    for (int o = 1; o < 64; o <<= 1) v += lane_get(v, lane ^ o);
    return v;
}
DEV float wave_max(float v, int lane) {
#pragma unroll
    for (int o = 1; o < 64; o <<= 1) v = fmaxf(v, lane_get(v, lane ^ o));
    return v;
}
DEV float wave_incl_scan(float v, int lane) {
#pragma unroll
    for (int o = 1; o < 64; o <<= 1) { float t = lane_get(v, lane - o); if (lane >= o) v += t; }
    return v;
}
#define BIDX obid()
#define GDIM ((int)gridDim.x)
#define LDS_WAIT() asm volatile("s_waitcnt lgkmcnt(0)" ::: "memory")
DEV float lambda_init_of(int l) { return l == 0 ? 0.2f : 0.35550906759097f; }
DEV int olane() { int l; asm volatile("v_mbcnt_lo_u32_b32 %0, -1, 0\n\tv_mbcnt_hi_u32_b32 %0, -1, %0" : "=v"(l)); return l; }
DEV int obid() { int b = blockIdx.x; asm volatile("" : "+s"(b)); return b; }

DEV void transpose_item(const float* W, int K, int N, bf16_t* WT, int dst_n0, int src_n0, int nvalid, int k0, LAS float* scr, int lane) {
    const int c = lane & 31;
#pragma unroll 8
    for (int i = 0; i < 32; ++i) { const int kk = 2 * i + (lane >> 5); scr[kk * 33 + c] = (c < nvalid) ? W[(size_t)(k0 + kk) * N + src_n0 + c] : 0.f; }
    LDS_WAIT();
    const int c8 = lane & 7;
#pragma unroll
    for (int j = 0; j < 4; ++j) { const int n = (lane >> 3) + 8 * j; const LAS float* s = scr + (8 * c8) * 33 + n;
        u32x4 o; o.x = pk2(s[0 * 33], s[1 * 33]); o.y = pk2(s[2 * 33], s[3 * 33]); o.z = pk2(s[4 * 33], s[5 * 33]); o.w = pk2(s[6 * 33], s[7 * 33]);
        *(u32x4*)(WT + (size_t)(dst_n0 + n) * K + k0 + 8 * c8) = o; }
    LDS_WAIT();
}
DEV void src_map_swiglu(int n0, int& src, int& nv) { const int pn = n0 >> 8, bj = (n0 >> 7) & 1, i0 = n0 & 127; src = bj * DFF + pn * 128 + i0; nv = 32; }
DEV void src_map_in(int n0, int& src, int& nv) {
    nv = 32;
    if (n0 < 1024) src = n0;
    else if (n0 < 1536) src = 2576 + (n0 - 1024);
    else if (n0 < 2048) src = 4112 + (n0 - 1536);
    else if (n0 < 2560) src = 3088 + (n0 - 2048);
    else if (n0 < 3072) src = 3600 + (n0 - 2560);
    else if (n0 < 3584) src = 4624 + (n0 - 3072);
    else if (n0 < 4096) src = 5136 + (n0 - 3584);
    else if (n0 < 5632) src = 1024 + (n0 - 4096);
    else if (n0 == 5632) { src = 2560; nv = 16; }
    else { src = 0; nv = 0; }
}
DEV void ph_convert(const Params& p, int l, LAS unsigned char* lds, int gw, int ngw, int wave, int lane) {
    LAS float* scr = (LAS float*)(lds + wave * 16384);
    bf16_t* wt = (bf16_t*)(p.ws + WS_WT);
    constexpr int I13 = 16 * 176, I2 = 44 * 32, IIN = 16 * 184, IOUT = 32 * 32;
    constexpr int NITEMS = 2 * I13 + 2 * I2 + IIN + IOUT;
    for (int it = gw; it < NITEMS; it += ngw) {
        int r = it;
        if (r < 2 * I13) { const int which = r / I13; r %= I13; const int kb = r / 176, nb = r % 176; int src, nv; src_map_swiglu(nb * 32, src, nv);
            transpose_item(p.in[which ? I_W13B : I_W13A] + (size_t)l * D * 2 * DFF, D, 2 * DFF, wt + (which ? WT_13B : WT_13A) / 2, nb * 32, src, nv, kb * 64, scr, lane); continue; }
        r -= 2 * I13;
        if (r < 2 * I2) { const int which = r / I2; r %= I2; const int kb = r / 32, nb = r % 32;
            transpose_item(p.in[which ? I_W2B : I_W2A] + (size_t)l * DFF * D, DFF, D, wt + (which ? WT_2B : WT_2A) / 2, nb * 32, nb * 32, 32, kb * 64, scr, lane); continue; }
        r -= 2 * I2;
        if (r < IIN) { const int kb = r / 184, nb = r % 184; int src, nv; src_map_in(nb * 32, src, nv);
            transpose_item(p.in[I_WIN] + (size_t)l * D * 5648, D, 5648, wt + WT_IN / 2, nb * 32, src, nv, kb * 64, scr, lane); continue; }
        r -= IIN;
        { const int kb = r / 32, nb = r % 32;
            transpose_item(p.in[I_WOUT] + (size_t)l * 2048 * D, 2048, D, wt + WT_OUT / 2, nb * 32, nb * 32, 32, kb * 64, scr, lane); }
    }
}

DEV void ph_mod(const Params& p, LAS unsigned char* lds, int tid, int wave, int lane) {
    LAS float* cond = (LAS float*)lds;
    LAS float* part = (LAS float*)(lds + 16384);
    __syncthreads();
    for (int i = tid; i < NB * D; i += NTHREADS) cond[i] = siluf(p.in[I_C][i]);
    __syncthreads();
    float* mod = (float*)(p.ws + WS_MOD);
    for (int unit = BIDX; unit < NL * 144; unit += GDIM) {
        const int l = unit / 144, j = (unit % 144) * 64 + lane;
        const float* w = p.in[I_ADAW] + (size_t)l * D * MODW + j;
        float a0 = 0.f, a1 = 0.f, a2 = 0.f, a3 = 0.f;
        for (int k = wave * 128; k < wave * 128 + 128; ++k) { const float wv = w[(size_t)k * MODW]; a0 += cond[k] * wv; a1 += cond[D + k] * wv; a2 += cond[2 * D + k] * wv; a3 += cond[3 * D + k] * wv; }
        part[(wave * 4 + 0) * 64 + lane] = a0; part[(wave * 4 + 1) * 64 + lane] = a1; part[(wave * 4 + 2) * 64 + lane] = a2; part[(wave * 4 + 3) * 64 + lane] = a3;
        __syncthreads();
        if (wave < 4) { float s = 0.f;
#pragma unroll
            for (int w8 = 0; w8 < 8; ++w8) s += part[(w8 * 4 + wave) * 64 + lane];
            mod[((size_t)l * NB + wave) * MODW + j] = s + p.in[I_ADAB][(size_t)l * MODW + j]; }
        __syncthreads();
    }
    if (BIDX == 0) {
        float* misc = (float*)(p.ws + WS_MISC);
        if (wave < NL) { int l = wave; asm volatile("" : "+s"(l));
            const float s1 = wave_sum(p.in[I_LQ1][l * 64 + lane] * p.in[I_LK1][l * 64 + lane], lane);
            const float s2 = wave_sum(p.in[I_LQ2][l * 64 + lane] * p.in[I_LK2][l * 64 + lane], lane);
            const float linit = lambda_init_of(l);
            if (lane == 0) misc[l] = expf(s1) - expf(s2) + linit; }
        if (tid < 512) { const int h = tid >> 7, d = tid & 127; int bk;
            if (d < 16) bk = d; else { bk = 16 + (int)(logf((float)d / 16.f) / logf(8.f) * 16.f); if (bk > 31) bk = 31; }
            misc[64 + h * 128 + d] = p.in[I_RB][bk * 4 + h]; }
    }
}

DEV void ph_norm(const float* xsrc, const float* g, const float* modl, int ishift, int iscale, bf16_t* XN, int gw, int ngw, int lane) {
    for (int m = gw; m < M; m += ngw) {
        const int b = m / S; const float* xr = xsrc + (size_t)m * D;
        f32x4 v[4]; float ss = 0.f;
#pragma unroll
        for (int j = 0; j < 4; ++j) { v[j] = *(const f32x4*)(xr + 4 * lane + 256 * j); ss += (v[j].x * v[j].x + v[j].y * v[j].y) + (v[j].z * v[j].z + v[j].w * v[j].w); }
        const float rstd = rsqrtf(wave_sum(ss, lane) * (1.f / D) + EPS);
        const float* sh = modl + (size_t)b * MODW + ishift * D; const float* sc = modl + (size_t)b * MODW + iscale * D;
#pragma unroll
        for (int j = 0; j < 4; ++j) { const int c = 4 * lane + 256 * j; const f32x4 gg = *(const f32x4*)(g + c), s1 = *(const f32x4*)(sc + c), s0 = *(const f32x4*)(sh + c);
            const f32x4 o = v[j] * rstd * gg * (s1 + 1.f) + s0; u32x2 w; w.x = pk2(o.x, o.y); w.y = pk2(o.z, o.w); *(u32x2*)(XN + (size_t)m * D + c) = w; }
    }
}
DEV void ph_final_norm(float* x, const float* g, int gw, int ngw, int lane) {
    for (int m = gw; m < M; m += ngw) {
        float* xr = x + (size_t)m * D; f32x4 v[4]; float ss = 0.f;
#pragma unroll
        for (int j = 0; j < 4; ++j) { v[j] = *(const f32x4*)(xr + 4 * lane + 256 * j); ss += (v[j].x * v[j].x + v[j].y * v[j].y) + (v[j].z * v[j].z + v[j].w * v[j].w); }
        const float rstd = rsqrtf(wave_sum(ss, lane) * (1.f / D) + EPS);
#pragma unroll
        for (int j = 0; j < 4; ++j) { const int c = 4 * lane + 256 * j; const f32x4 gg = *(const f32x4*)(g + c); *(f32x4*)(xr + c) = v[j] * rstd * gg; }
    }
}

struct EpiSwiglu { bf16_t* H;
    DEV void elem2(int row, int j, float a, float u) const { H[(size_t)row * DFF + j] = (bf16_t)f2bf(siluf(a) * u); } };
struct EpiResid { const float* xsrc; float* out; const float* gate; float f;
    DEV void elem(int row, int col, float v) const { const int b = row / S; const size_t o = (size_t)row * D + col; out[o] = xsrc[o] + f * gate[(size_t)b * MODW + col] * v; } };
struct EpiIn { bf16_t* P; float* DT; bf16_t* HALO;
    DEV void elem(int row, int col, float v) const {
        if (col < PW) { const bf16_t h = (bf16_t)f2bf(v); P[(size_t)row * PW + col] = h;
            if (col >= PXBC) { const int r = row & 127; if (r >= 125) HALO[((size_t)((row >> 7) + 1) * 3 + (r - 125)) * 1536 + (col - PXBC)] = h; } }
        else if (col < PW + 16) DT[(size_t)row * 16 + (col - PW)] = v; } };

template <bool SW, class Epi>
DEV void gemm_naive(const bf16_t* A, int lda, const bf16_t* Bt, int Ndest, int K, const Epi& E, LAS unsigned char* lds, int tid) {
    LAS float* As = (LAS float*)lds;
    LAS float* Bs = (LAS float*)(lds + 128 * 33 * 4);
    LAS float* Bs2 = (LAS float*)(lds + 192 * 33 * 4);
    const int ntn = SW ? (Ndest / 256) * 2 : Ndest / 64;
    const int ntiles = (M / 128) * ntn;
    const int ty = tid >> 4, tx = tid & 15;
    for (int tile = BIDX; tile < ntiles; tile += GDIM) {
        const int tm = tile / ntn, tn = tile % ntn;
        const int m0 = tm * 128;
        const int n0 = SW ? (tn >> 1) * 256 + (tn & 1) * 64 : tn * 64;
        float acc[4][4], acc2[4][4];
#pragma unroll
        for (int i = 0; i < 4; ++i)
#pragma unroll
            for (int j = 0; j < 4; ++j) { acc[i][j] = 0.f; acc2[i][j] = 0.f; }
        for (int k0 = 0; k0 < K; k0 += 32) {
            { const int row = tid >> 2, kc = (tid & 3) * 8; const u32x4 v = *(const u32x4*)(A + (size_t)(m0 + row) * lda + k0 + kc); LAS float* d = As + row * 33 + kc;
              d[0] = bflo(v.x); d[1] = bfhi(v.x); d[2] = bflo(v.y); d[3] = bfhi(v.y); d[4] = bflo(v.z); d[5] = bfhi(v.z); d[6] = bflo(v.w); d[7] = bfhi(v.w); }
            if (tid < 256) { const int row = tid >> 2, kc = (tid & 3) * 8; const u32x4 v = *(const u32x4*)(Bt + (size_t)(n0 + row) * K + k0 + kc); LAS float* d = Bs + row * 33 + kc;
              d[0] = bflo(v.x); d[1] = bfhi(v.x); d[2] = bflo(v.y); d[3] = bfhi(v.y); d[4] = bflo(v.z); d[5] = bfhi(v.z); d[6] = bflo(v.w); d[7] = bfhi(v.w); }
            else if (SW) { const int t2 = tid - 256; const int row = t2 >> 2, kc = (t2 & 3) * 8; const u32x4 v = *(const u32x4*)(Bt + (size_t)(n0 + 128 + row) * K + k0 + kc); LAS float* d = Bs2 + row * 33 + kc;
              d[0] = bflo(v.x); d[1] = bfhi(v.x); d[2] = bflo(v.y); d[3] = bfhi(v.y); d[4] = bflo(v.z); d[5] = bfhi(v.z); d[6] = bflo(v.w); d[7] = bfhi(v.w); }
            __syncthreads();
#pragma unroll 8
            for (int kk = 0; kk < 32; ++kk) {
                float a[4], b[4], b2[4];
#pragma unroll
                for (int i = 0; i < 4; ++i) a[i] = As[(ty * 4 + i) * 33 + kk];
#pragma unroll
                for (int j = 0; j < 4; ++j) { b[j] = Bs[(tx * 4 + j) * 33 + kk]; if (SW) b2[j] = Bs2[(tx * 4 + j) * 33 + kk]; }
#pragma unroll
                for (int i = 0; i < 4; ++i)
#pragma unroll
                    for (int j = 0; j < 4; ++j) { acc[i][j] += a[i] * b[j]; if (SW) acc2[i][j] += a[i] * b2[j]; }
            }
            __syncthreads();
        }
#pragma unroll
        for (int i = 0; i < 4; ++i)
#pragma unroll
            for (int j = 0; j < 4; ++j) {
                if constexpr (SW) E.elem2(m0 + ty * 4 + i, (tn >> 1) * 128 + (tn & 1) * 64 + tx * 4 + j, acc[i][j], acc2[i][j]);
                else E.elem(m0 + ty * 4 + i, n0 + tx * 4 + j, acc[i][j]);
            }
    }
}

namespace pg8 {
#define PG8_LAS __attribute__((address_space(3)))
typedef unsigned short bf16_t;
typedef short bf16x8 __attribute__((ext_vector_type(8)));
typedef float f32x4 __attribute__((ext_vector_type(4)));
typedef unsigned u32x4 __attribute__((ext_vector_type(4)));
constexpr int BM = 256, BK = 64, HALF = 128, HTB = HALF * BK * 2  , STAGE_BYTES = 8 * HTB, NXCD = 8, WGM = 8;

__host__ __device__ __forceinline__ int lds_byte(int r, int c) { const int st = (r >> 4) * 2 + (c >> 5), rr = r & 15, cc = c & 31, ob = rr * 64 + cc * 2; return st * 1024 + (ob ^ (((ob >> 9) & 1) << 5)); }
__host__ __device__ __forceinline__ void stage_rc(int b, int& R, int& C) { const int st = b / 1024, sb = b % 1024, swz = sb ^ (((sb >> 9) & 1) << 5); R = (st >> 1) * 16 + swz / 64; C = (st & 1) * 32 + (swz % 64) / 2; }
__host__ __device__ __forceinline__ int perm32(int rho) { const int n = rho >> 4, i = rho & 15; return 8 * (i >> 2) + 4 * n + (i & 3); }

struct Unit { int pm, pn; };
struct Gemm { const bf16_t* A; const bf16_t* Bt; int M, N, K, lda; };

struct StaticOrder {
    int nM, nN, nwg, G, c;
    __host__ __device__ void init(int M, int N, int G_, int c_) { nM = M / BM; nN = N / BM; nwg = nM * nN; G = G_; c = c_; }
    __host__ __device__ bool next(int i, Unit& u) const {
        const long L = (long)i * G + c; if (L >= nwg) return false;
        int wgid = (int)L; { const int q = nwg / NXCD, r = nwg % NXCD, xcd = wgid % NXCD, off = wgid / NXCD; wgid = (xcd < r ? xcd * (q + 1) : r * (q + 1) + (xcd - r) * q) + off; }
        const int nig = WGM * nN, gid = wgid / nig, fm = gid * WGM, gsz = (nM - fm) < WGM ? (nM - fm) : WGM;
        u.pm = fm + ((wgid % nig) % gsz); u.pn = (wgid % nig) / gsz; return true;
    }
    __device__ __forceinline__ void a_ready(const Unit&) const {}
    __device__ __forceinline__ void done(const Unit&) const {}
};
__device__ __forceinline__ unsigned cvt_pk_bf16(float lo, float hi) { unsigned r; asm volatile("v_cvt_pk_bf16_f32 %0, %1, %2" : "=v"(r) : "v"(lo), "v"(hi)); return r; }

__device__ __forceinline__ float silu1(float x) { return x * __builtin_amdgcn_rcpf(1.f + __expf(-x)); }
struct EpiSwigluT { static constexpr bool PERM = true, AFTER_DRAIN = false; bf16_t* H;
    __device__ __forceinline__ void operator()(const f32x4 (&acc)[2][2][4][2], const Unit& u, int wr, int wc, int fr, int fq) const {
        const int row0 = u.pm * BM + wr * 64 + fr, col0 = u.pn * HALF + wc * 32 + 8 * fq;
#pragma unroll
        for (int ai = 0; ai < 2; ++ai)
#pragma unroll
            for (int m = 0; m < 4; ++m) { bf16_t* rowp = H + (size_t)(row0 + ai * HALF + m * 16) * 2816 + col0;
                const f32x4 a0 = acc[ai][0][m][0], a1 = acc[ai][0][m][1], u0 = acc[ai][1][m][0], u1 = acc[ai][1][m][1]; u32x4 w;
                w.x = cvt_pk_bf16(silu1(a0[0]) * u0[0], silu1(a0[1]) * u0[1]); w.y = cvt_pk_bf16(silu1(a0[2]) * u0[2], silu1(a0[3]) * u0[3]);
                w.z = cvt_pk_bf16(silu1(a1[0]) * u1[0], silu1(a1[1]) * u1[1]); w.w = cvt_pk_bf16(silu1(a1[2]) * u1[2], silu1(a1[3]) * u1[3]);
                *(u32x4*)rowp = w; }
    }
};
struct EpiResidT { static constexpr bool PERM = false, AFTER_DRAIN = false; const float* xsrc; float* out; const float* gate; float f;
    __device__ __forceinline__ void operator()(const f32x4 (&acc)[2][2][4][2], const Unit& u, int wr, int wc, int fr, int fq) const {
        const int row0 = u.pm * BM + wr * 64 + fr, col0 = u.pn * BM + wc * 32 + 4 * fq; const int b = (u.pm * BM) / 4096;
#pragma unroll
        for (int bj = 0; bj < 2; ++bj)
#pragma unroll
            for (int n = 0; n < 2; ++n) { const int c = col0 + bj * HALF + n * 16; const f32x4 gv = *(const f32x4*)(gate + (size_t)b * 9216 + c) * f;
#pragma unroll
                for (int ai = 0; ai < 2; ++ai)
#pragma unroll
                    for (int m = 0; m < 4; ++m) { const size_t off = (size_t)(row0 + ai * HALF + m * 16) * 1024 + c; *(f32x4*)(out + off) = *(const f32x4*)(xsrc + off) + gv * acc[ai][bj][m][n]; } }
    }
};
struct EpiInT { static constexpr bool PERM = true, AFTER_DRAIN = false; bf16_t* P; float* DT; bf16_t* HALO;
    __device__ __forceinline__ void operator()(const f32x4 (&acc)[2][2][4][2], const Unit& u, int wr, int wc, int fr, int fq) const {
        const int row0 = u.pm * BM + wr * 64 + fr;
        if (u.pn < 22) { const int col0 = u.pn * BM + wc * 32 + 8 * fq; const float qs = (u.pn >= 4 && u.pn <= 7) ? 0.125f * 1.4426950408889634f : 1.f;
#pragma unroll
            for (int ai = 0; ai < 2; ++ai)
#pragma unroll
                for (int m = 0; m < 4; ++m) { const int row = row0 + ai * HALF + m * 16;
#pragma unroll
                    for (int bj = 0; bj < 2; ++bj) { const f32x4 v0 = acc[ai][bj][m][0] * qs, v1 = acc[ai][bj][m][1] * qs; u32x4 w;
                        w.x = cvt_pk_bf16(v0[0], v0[1]); w.y = cvt_pk_bf16(v0[2], v0[3]); w.z = cvt_pk_bf16(v1[0], v1[1]); w.w = cvt_pk_bf16(v1[2], v1[3]);
                        *(u32x4*)(P + (size_t)row * 5632 + col0 + bj * HALF) = w;
                        if (m == 3 && u.pn >= 16 && wr == 1 && fr >= 13) *(u32x4*)(HALO + ((size_t)((row >> 7) + 1) * 3 + (fr - 13)) * 1536 + (col0 + bj * HALF - 4096)) = w; } }
        } else if (wc == 0 && fq < 2) {
#pragma unroll
            for (int ai = 0; ai < 2; ++ai)
#pragma unroll
                for (int m = 0; m < 4; ++m) { const int row = row0 + ai * HALF + m * 16;
#pragma unroll
                    for (int n = 0; n < 2; ++n) *(f32x4*)(DT + (size_t)row * 16 + 8 * fq + 4 * n) = acc[ai][0][m][n]; }
        }
    }
};

template <class Epi, class Sched, bool ALIGN_EPI = false, bool SP2 = false>
__device__ __forceinline__ void gemm_phase(PG8_LAS unsigned char* lds, const Gemm g, const Sched& S, const Epi& E, const int tid) {
    const int wid = __builtin_amdgcn_readfirstlane(tid >> 6), lane = tid & 63, wr = wid >> 2, wc = wid & 3, fr = lane & 15, fq = lane >> 4;
    const int K = g.K, nt = K / BK;
    unsigned voffA[2], voffB[2];
#pragma unroll
    for (int i = 0; i < 2; ++i) { int R, C; stage_rc(tid * 16 + i * 8192, R, C); const int Rb = Epi::PERM ? ((R & ~31) + perm32(R & 31)) : R;
        voffA[i] = (unsigned)(R * g.lda + C) * 2u; voffB[i] = (unsigned)(Rb * K + C) * 2u; }
    const size_t kstep = (size_t)(BK * 2);
    const size_t hstep = (size_t)HALF * K * 2, hstepA = (size_t)HALF * g.lda * 2;
    const size_t tstep = 2 * hstep, tstepA = 2 * hstepA;
    const unsigned ldsw = (unsigned)wid * 1024u;
    const int aoff = lds_byte(wr * 64 + fr, fq * 8), boff = lds_byte(wc * 32 + fr, fq * 8);
#define PG8_SA(b, h) (((b) * 2 + (h)) * HTB)
#define PG8_SB(b, h) ((4 + (b) * 2 + (h)) * HTB)
#define PG8_STAGE(bufoff, gbase, voff) do { _Pragma("unroll") for (int _i = 0; _i < 2; ++_i) \
        __builtin_amdgcn_global_load_lds((const unsigned*)((const char*)(gbase) + (voff)[_i]), (PG8_LAS unsigned*)(lds + (bufoff) + ldsw + _i * 8192), 16, 0, 0); } while (0)
#define PG8_LDA(dst, b, h) do { _Pragma("unroll") for (int m = 0; m < 4; ++m) _Pragma("unroll") for (int k = 0; k < 2; ++k) dst[m][k] = *(const PG8_LAS bf16x8*)(lds + PG8_SA(b, h) + aoff + m * 2048 + k * 1024); } while (0)
#define PG8_LDB(dst, b, h) do { _Pragma("unroll") for (int n = 0; n < 2; ++n) _Pragma("unroll") for (int k = 0; k < 2; ++k) dst[n][k] = *(const PG8_LAS bf16x8*)(lds + PG8_SB(b, h) + boff + n * 2048 + k * 1024); } while (0)
#define PG8_MMA(ai, bj, At, Bt) do { __builtin_amdgcn_s_setprio(1); _Pragma("unroll") for (int m = 0; m < 4; ++m) _Pragma("unroll") for (int n = 0; n < 2; ++n) _Pragma("unroll") for (int k = 0; k < 2; ++k) \
        acc[ai][bj][m][n] = __builtin_amdgcn_mfma_f32_16x16x32_bf16(Bt[n][k], At[m][k], acc[ai][bj][m][n], 0, 0, 0); __builtin_amdgcn_s_setprio(0); } while (0)
#define PG8_WAIT_V(n) asm volatile("s_waitcnt vmcnt(" #n ")" ::: "memory")
#define PG8_WAIT_L(n) asm volatile("s_waitcnt lgkmcnt(" #n ")" ::: "memory")
#define PG8_BAR __builtin_amdgcn_s_barrier()
#define PG8_SCHED __builtin_amdgcn_sched_barrier(0)
    Unit cur, nxt; int ui = 0;
    if (!S.next(0, cur)) return;
    f32x4 acc[2][2][4][2];
#pragma unroll
    for (int a = 0; a < 2; ++a)
#pragma unroll
        for (int b = 0; b < 2; ++b)
#pragma unroll
            for (int m = 0; m < 4; ++m)
#pragma unroll
                for (int n = 0; n < 2; ++n) acc[a][b][m][n] = (f32x4){0.f, 0.f, 0.f, 0.f};
    bf16x8 At[4][2], B0[2][2], B1[2][2];
    const char* cA = (const char*)g.A + (size_t)cur.pm * tstepA; const char* cB = (const char*)g.Bt + (size_t)cur.pn * tstep;
    S.a_ready(cur);
    if constexpr (SP2) {
        PG8_STAGE(PG8_SB(0, 0), cB, voffB); PG8_STAGE(PG8_SB(0, 1), cB + hstep, voffB); PG8_STAGE(PG8_SA(0, 0), cA, voffA); PG8_STAGE(PG8_SA(0, 1), cA + hstepA, voffA);
        if (wr == 1) PG8_BAR;
        PG8_WAIT_V(2); PG8_BAR;
        PG8_STAGE(PG8_SB(1, 0), cB + kstep, voffB); PG8_STAGE(PG8_SA(1, 0), cA + kstep, voffA); PG8_STAGE(PG8_SB(1, 1), cB + hstep + kstep, voffB);
        PG8_WAIT_V(6); PG8_BAR;
    } else {
        PG8_STAGE(PG8_SB(0, 0), cB, voffB); PG8_STAGE(PG8_SA(0, 0), cA, voffA); PG8_STAGE(PG8_SB(0, 1), cB + hstep, voffB); PG8_STAGE(PG8_SA(0, 1), cA + hstepA, voffA);
        if (wr == 1) PG8_BAR;
        PG8_WAIT_V(4); PG8_BAR;
        PG8_STAGE(PG8_SB(1, 0), cB + kstep, voffB); PG8_STAGE(PG8_SA(1, 0), cA + kstep, voffA); PG8_STAGE(PG8_SB(1, 1), cB + hstep + kstep, voffB);
        PG8_WAIT_V(6); PG8_BAR;
    }
    for (;;) {
        const bool has_next = S.next(ui + 1, nxt);
        const char* nA = has_next ? (const char*)g.A + (size_t)nxt.pm * tstepA : cA; const char* nB = has_next ? (const char*)g.Bt + (size_t)nxt.pn * tstep : cB;
        for (int t = 0; t < nt; t += 2) {
            const bool last = (t == nt - 2);
            const char* a1 = cA + (size_t)(t + 1) * kstep;
            const char* a2 = last ? nA : cA + (size_t)(t + 2) * kstep; const char* b2 = last ? nB : cB + (size_t)(t + 2) * kstep;
            const char* a3 = a2 + kstep; const char* b3 = b2 + kstep;
            if (last && has_next) S.a_ready(nxt);
            if constexpr (SP2) {
            PG8_LDB(B0, 0, 0); PG8_LDB(B1, 0, 1); PG8_SCHED; PG8_LDA(At, 0, 0); PG8_STAGE(PG8_SA(1, 1), a1 + hstepA, voffA);
            PG8_WAIT_V(8); PG8_WAIT_L(0); PG8_BAR; PG8_MMA(0, 0, At, B0); PG8_MMA(0, 1, At, B1); PG8_BAR; PG8_SCHED;
            PG8_LDA(At, 0, 1); PG8_STAGE(PG8_SB(0, 0), b2, voffB); PG8_STAGE(PG8_SB(0, 1), b2 + hstep, voffB); PG8_STAGE(PG8_SA(0, 0), a2, voffA);
            PG8_WAIT_V(8); PG8_WAIT_L(0); PG8_BAR; PG8_MMA(1, 0, At, B0); PG8_MMA(1, 1, At, B1); PG8_BAR; PG8_SCHED;
            PG8_LDB(B0, 1, 0); PG8_LDB(B1, 1, 1); PG8_SCHED; PG8_LDA(At, 1, 0); PG8_STAGE(PG8_SA(0, 1), a2 + hstepA, voffA);
            PG8_WAIT_V(8); PG8_WAIT_L(0); PG8_BAR; PG8_MMA(0, 0, At, B0); PG8_MMA(0, 1, At, B1); PG8_BAR; PG8_SCHED;
            PG8_LDA(At, 1, 1); PG8_STAGE(PG8_SB(1, 0), b3, voffB); PG8_STAGE(PG8_SB(1, 1), b3 + hstep, voffB); PG8_STAGE(PG8_SA(1, 0), a3, voffA);
            PG8_WAIT_V(8); PG8_WAIT_L(0); PG8_BAR; PG8_MMA(1, 0, At, B0); PG8_MMA(1, 1, At, B1); PG8_BAR; PG8_SCHED;
            } else {
            PG8_LDB(B0, 0, 0); PG8_SCHED; PG8_LDA(At, 0, 0); PG8_STAGE(PG8_SA(1, 1), a1 + hstepA, voffA);
            PG8_WAIT_L(8); PG8_BAR; PG8_WAIT_L(0); PG8_MMA(0, 0, At, B0); PG8_BAR; PG8_SCHED;
            PG8_LDB(B1, 0, 1); PG8_STAGE(PG8_SB(0, 0), b2, voffB);
            PG8_BAR; PG8_WAIT_L(0); PG8_MMA(0, 1, At, B1); PG8_BAR;
            PG8_LDA(At, 0, 1); PG8_STAGE(PG8_SA(0, 0), a2, voffA);
            PG8_BAR; PG8_WAIT_L(0); PG8_MMA(1, 0, At, B0); PG8_BAR; PG8_SCHED;
            PG8_STAGE(PG8_SB(0, 1), b2 + hstep, voffB);
            PG8_WAIT_V(6); PG8_BAR; PG8_MMA(1, 1, At, B1); PG8_BAR;
            PG8_LDB(B0, 1, 0); PG8_SCHED; PG8_LDA(At, 1, 0); PG8_STAGE(PG8_SA(0, 1), a2 + hstepA, voffA);
            PG8_WAIT_L(8); PG8_BAR; PG8_WAIT_L(0); PG8_MMA(0, 0, At, B0); PG8_BAR; PG8_SCHED;
            PG8_LDB(B1, 1, 1); PG8_STAGE(PG8_SB(1, 0), b3, voffB);
            PG8_BAR; PG8_WAIT_L(0); PG8_MMA(0, 1, At, B1); PG8_BAR;
            PG8_LDA(At, 1, 1); PG8_STAGE(PG8_SA(1, 0), a3, voffA);
            PG8_BAR; PG8_WAIT_L(0); PG8_MMA(1, 0, At, B0); PG8_BAR; PG8_SCHED;
            PG8_STAGE(PG8_SB(1, 1), b3 + hstep, voffB);
            PG8_WAIT_V(6); PG8_BAR; PG8_MMA(1, 1, At, B1); PG8_BAR;
            }
        }
        if constexpr (ALIGN_EPI) { if (wr == 0) PG8_BAR; }
        if constexpr (!Epi::AFTER_DRAIN) { E(acc, cur, wr, wc, fr, fq); S.done(cur); }
        if (!has_next) break;
#pragma unroll
        for (int a = 0; a < 2; ++a)
#pragma unroll
            for (int b = 0; b < 2; ++b)
#pragma unroll
                for (int m = 0; m < 4; ++m)
#pragma unroll
                    for (int n = 0; n < 2; ++n) acc[a][b][m][n] = (f32x4){0.f, 0.f, 0.f, 0.f};
        cur = nxt; cA = nA; cB = nB; ++ui;
        if constexpr (ALIGN_EPI) { if (wr == 1) PG8_BAR; }
    }
    PG8_WAIT_V(0);
    if constexpr (!ALIGN_EPI) { if (wr == 0) PG8_BAR; }
    PG8_BAR;
    if constexpr (Epi::AFTER_DRAIN) { E.fused(acc, cur, wr, wc, fr, fq, lds, wid, lane); S.done(cur); }
#undef PG8_SA
#undef PG8_SB
#undef PG8_STAGE
#undef PG8_LDA
#undef PG8_LDB
#undef PG8_MMA
#undef PG8_WAIT_V
#undef PG8_WAIT_L
#undef PG8_BAR
#undef PG8_SCHED
}
}
DEV void ph_conv(const Params& p, int l, int tid) {
    bf16_t* P = (bf16_t*)(p.ws + WS_P); const bf16_t* HALO = (const bf16_t*)(p.ws + WS_HALO);
    const float* cw = p.in[I_CW] + (size_t)l * 1536 * 4; const float* cb = p.in[I_CB] + (size_t)l * 1536;
    for (int task = BIDX * NTHREADS + tid; task < GCH * 768; task += GDIM * NTHREADS) {
        const int gc = task / 768, ch = (task % 768) * 2; const int r0 = gc * CH;
        const f32x4 w0 = *(const f32x4*)(cw + ch * 4), w1 = *(const f32x4*)(cw + ch * 4 + 4); const float b0 = cb[ch], b1 = cb[ch + 1];
        float a3 = 0.f, a2 = 0.f, a1 = 0.f, c3 = 0.f, c2 = 0.f, c1 = 0.f;
        if (gc % NCHUNK != 0) { const bf16_t* hp = HALO + (size_t)gc * 3 * 1536 + ch;
            const unsigned h0 = *(const unsigned*)(hp), h1 = *(const unsigned*)(hp + 1536), h2 = *(const unsigned*)(hp + 2 * 1536);
            a3 = bflo(h0); c3 = bfhi(h0); a2 = bflo(h1); c2 = bfhi(h1); a1 = bflo(h2); c1 = bfhi(h2); }
        unsigned* col = (unsigned*)(P + (size_t)r0 * PW + PXBC + ch);
        for (int i = 0; i < CH; ++i) {
            const unsigned raw = col[(size_t)i * (PW / 2)]; const float a0 = bflo(raw), c0 = bfhi(raw);
            const float ya = b0 + w0.x * a3 + w0.y * a2 + w0.z * a1 + w0.w * a0, yc = b1 + w1.x * c3 + w1.y * c2 + w1.z * c1 + w1.w * c0;
            col[(size_t)i * (PW / 2)] = pk2(siluf(ya), siluf(yc));
            a3 = a2; a2 = a1; a1 = a0; c3 = c2; c2 = c1; c1 = c0;
        }
    }
}

DEV void ssd_head_scalars(const Params& p, int l, int r0, int h, LAS float* s_dt, LAS float* s_ac, int tid, int wave, int lane) {
    const float* DT = (const float*)(p.ws + WS_DT);
    if (tid < CH) { const float dtv = softplusf(DT[(size_t)(r0 + tid) * 16 + h] + p.in[I_DTB][l * 16 + h]); s_dt[tid] = dtv; s_ac[tid] = dtv * (-__expf(p.in[I_ALOG][l * 16 + h])); }
    __syncthreads();
    if (wave == 0) { const float v0 = s_ac[2 * lane], v1 = s_ac[2 * lane + 1]; const float s = v0 + v1; const float inc = wave_incl_scan(s, lane); s_ac[2 * lane] = inc - s + v0; s_ac[2 * lane + 1] = inc; }
    __syncthreads();
}
DEV void ph_ssd_state(const Params& p, int l, LAS unsigned char* lds, int tid, int wave, int lane) {
    LAS bf16_t* Bs = (LAS bf16_t*)lds;
    LAS float* xdd = (LAS float*)(lds + 34816);
    LAS float* s_dt = (LAS float*)(lds + 34816 + 32768);
    LAS float* s_ac = s_dt + 128;
    const bf16_t* P = (const bf16_t*)(p.ws + WS_P); float* ST = (float*)(p.ws + WS_ST); float* CD = (float*)(p.ws + WS_CD);
    for (int unit = BIDX; unit < GCH * 16; unit += GDIM) {
        const int gc = unit >> 4, h = unit & 15, g = h >> 3, r0 = gc * CH;
        __syncthreads();
        ssd_head_scalars(p, l, r0, h, s_dt, s_ac, tid, wave, lane);
        { const int row = tid >> 2, c0 = (tid & 3) * 32; const bf16_t* src = P + (size_t)(r0 + row) * PW + PBM + g * 128 + c0;
#pragma unroll
          for (int q = 0; q < 4; ++q) *(LAS u32x4*)(Bs + row * 136 + c0 + q * 8) = *(const u32x4*)(src + q * 8); }
        { const int row = tid >> 2, p0 = (tid & 3) * 16; const bf16_t* src = P + (size_t)(r0 + row) * PW + PXS + h * 64 + p0; const float f = s_dt[row] * __expf(s_ac[127] - s_ac[row]);
#pragma unroll
          for (int q = 0; q < 2; ++q) { const u32x4 v = *(const u32x4*)(src + q * 8); LAS float* d = xdd + row * 64 + p0 + q * 8;
              d[0] = bflo(v.x) * f; d[1] = bfhi(v.x) * f; d[2] = bflo(v.y) * f; d[3] = bfhi(v.y) * f; d[4] = bflo(v.z) * f; d[5] = bfhi(v.z) * f; d[6] = bflo(v.w) * f; d[7] = bfhi(v.w) * f; } }
        __syncthreads();
        const int pp = tid >> 3, ng = tid & 7; float acc[16];
#pragma unroll
        for (int j = 0; j < 16; ++j) acc[j] = 0.f;
        for (int ll = 0; ll < CH; ++ll) { const float xv = xdd[ll * 64 + pp]; const u32x4 b0 = *(const LAS u32x4*)(Bs + ll * 136 + ng * 16), b1 = *(const LAS u32x4*)(Bs + ll * 136 + ng * 16 + 8);
            acc[0] += xv * bflo(b0.x); acc[1] += xv * bfhi(b0.x); acc[2] += xv * bflo(b0.y); acc[3] += xv * bfhi(b0.y); acc[4] += xv * bflo(b0.z); acc[5] += xv * bfhi(b0.z); acc[6] += xv * bflo(b0.w); acc[7] += xv * bfhi(b0.w);
            acc[8] += xv * bflo(b1.x); acc[9] += xv * bfhi(b1.x); acc[10] += xv * bflo(b1.y); acc[11] += xv * bfhi(b1.y); acc[12] += xv * bflo(b1.z); acc[13] += xv * bfhi(b1.z); acc[14] += xv * bflo(b1.w); acc[15] += xv * bfhi(b1.w); }
        float* dst = ST + (((size_t)gc * 16 + h) * 64 + pp) * 128 + ng * 16;
#pragma unroll
        for (int q = 0; q < 4; ++q) *(f32x4*)(dst + q * 4) = (f32x4){acc[q * 4], acc[q * 4 + 1], acc[q * 4 + 2], acc[q * 4 + 3]};
        if (tid == 0) CD[gc * 16 + h] = __expf(s_ac[127]);
    }
}
DEV void ph_ssd_scan(const Params& p, int tid) {
    float* ST = (float*)(p.ws + WS_ST); const float* CD = (const float*)(p.ws + WS_CD);
    for (int e = BIDX * NTHREADS + tid; e < NB * 16 * 64 * 128; e += GDIM * NTHREADS) {
        const int b = e >> 17, h = (e >> 13) & 15, pn = e & 8191; float hc = 0.f;
        for (int c = 0; c < NCHUNK; ++c) { const int gc = b * NCHUNK + c; const size_t idx = ((size_t)gc * 16 + h) * 8192 + pn; const float t = ST[idx]; ST[idx] = hc; hc = hc * CD[gc * 16 + h] + t; }
    }
}
DEV void ph_ssd_out(const Params& p, int l, LAS unsigned char* lds, int tid, int wave, int lane) {
    LAS bf16_t* Cs = (LAS bf16_t*)lds;
    LAS bf16_t* Bs = (LAS bf16_t*)(lds + 34816);
    LAS float* prev = (LAS float*)(lds + 34816);
    LAS bf16_t* CBs = (LAS bf16_t*)(lds + 2 * 34816);
    LAS float* xd = (LAS float*)(lds + 3 * 34816);
    LAS float* s_dt = (LAS float*)(lds + 4 * 34816); LAS float* s_ac = s_dt + 128; LAS float* s_ss = s_dt + 256;
    bf16_t* P = (bf16_t*)(p.ws + WS_P); const float* ST = (const float*)(p.ws + WS_ST); float* ROWSS = (float*)(p.ws + WS_ROWSS);
    for (int unit = BIDX; unit < GCH * 2; unit += GDIM) {
        const int gc = unit >> 1, g = unit & 1, r0 = gc * CH;
        __syncthreads();
        { const int row = tid >> 2, c0 = (tid & 3) * 32; const bf16_t* sc = P + (size_t)(r0 + row) * PW + PCM + g * 128 + c0; const bf16_t* sb = P + (size_t)(r0 + row) * PW + PBM + g * 128 + c0;
#pragma unroll
          for (int q = 0; q < 4; ++q) { *(LAS u32x4*)(Cs + row * 136 + c0 + q * 8) = *(const u32x4*)(sc + q * 8); *(LAS u32x4*)(Bs + row * 136 + c0 + q * 8) = *(const u32x4*)(sb + q * 8); } }
        if (tid < CH) s_ss[tid] = 0.f;
        __syncthreads();
        { const int lr = tid >> 2, s0 = (tid & 3) * 32; float acc[32];
#pragma unroll
          for (int j = 0; j < 32; ++j) acc[j] = 0.f;
          for (int n = 0; n < 128; n += 8) { const u32x4 cv = *(const LAS u32x4*)(Cs + lr * 136 + n);
              const float c0 = bflo(cv.x), c1 = bfhi(cv.x), c2 = bflo(cv.y), c3 = bfhi(cv.y), c4 = bflo(cv.z), c5 = bfhi(cv.z), c6 = bflo(cv.w), c7 = bfhi(cv.w);
#pragma unroll
              for (int j = 0; j < 32; ++j) { const u32x4 bv = *(const LAS u32x4*)(Bs + (s0 + j) * 136 + n);
                  acc[j] += c0 * bflo(bv.x) + c1 * bfhi(bv.x) + c2 * bflo(bv.y) + c3 * bfhi(bv.y) + c4 * bflo(bv.z) + c5 * bfhi(bv.z) + c6 * bflo(bv.w) + c7 * bfhi(bv.w); } }
#pragma unroll
          for (int j = 0; j < 32; j += 2) *(LAS unsigned*)(CBs + lr * 136 + s0 + j) = pk2(acc[j], acc[j + 1]); }
        for (int e = 0; e < 8; ++e) {
            const int h = g * 8 + e;
            __syncthreads();
            ssd_head_scalars(p, l, r0, h, s_dt, s_ac, tid, wave, lane);
            { const int pp = tid >> 3, n0 = (tid & 7) * 16; const float* src = ST + (((size_t)gc * 16 + h) * 64 + pp) * 128 + n0;
#pragma unroll
              for (int q = 0; q < 4; ++q) { const f32x4 v = *(const f32x4*)(src + q * 4); LAS float* d = prev + pp * 129 + n0 + q * 4; d[0] = v.x; d[1] = v.y; d[2] = v.z; d[3] = v.w; } }
            const int lr = tid >> 2, p0 = (tid & 3) * 16; float xraw[16];
            { const bf16_t* src = P + (size_t)(r0 + lr) * PW + PXS + h * 64 + p0; const float f = s_dt[lr];
#pragma unroll
              for (int q = 0; q < 2; ++q) { const u32x4 v = *(const u32x4*)(src + q * 8);
                  xraw[q * 8 + 0] = bflo(v.x); xraw[q * 8 + 1] = bfhi(v.x); xraw[q * 8 + 2] = bflo(v.y); xraw[q * 8 + 3] = bfhi(v.y); xraw[q * 8 + 4] = bflo(v.z); xraw[q * 8 + 5] = bfhi(v.z); xraw[q * 8 + 6] = bflo(v.w); xraw[q * 8 + 7] = bfhi(v.w); }
#pragma unroll
              for (int j = 0; j < 16; ++j) xd[lr * 68 + p0 + j] = xraw[j] * f; }
            __syncthreads();
            float y[16], yo[16];
#pragma unroll
            for (int j = 0; j < 16; ++j) { y[j] = 0.f; yo[j] = 0.f; }
            const float al = s_ac[lr];
            for (int s = 0; s <= lr; ++s) { const float cb = bf2f(CBs[lr * 136 + s]) * __expf(al - s_ac[s]);
#pragma unroll
                for (int q = 0; q < 4; ++q) { const f32x4 xv = *(const LAS f32x4*)(xd + s * 68 + p0 + q * 4); y[q * 4] += cb * xv.x; y[q * 4 + 1] += cb * xv.y; y[q * 4 + 2] += cb * xv.z; y[q * 4 + 3] += cb * xv.w; } }
            for (int n = 0; n < 128; ++n) { const float c = bf2f(Cs[lr * 136 + n]);
#pragma unroll
                for (int j = 0; j < 16; ++j) yo[j] += c * prev[(p0 + j) * 129 + n]; }
            const float ea = __expf(al), dh = p.in[I_SD][l * 16 + h];
            bf16_t* zp = P + (size_t)(r0 + lr) * PW + PZ + h * 64 + p0; float ssl = 0.f; unsigned ow[8];
            { const u32x4 z0 = *(const u32x4*)zp, z1 = *(const u32x4*)(zp + 8); float zz[16];
              zz[0] = bflo(z0.x); zz[1] = bfhi(z0.x); zz[2] = bflo(z0.y); zz[3] = bfhi(z0.y); zz[4] = bflo(z0.z); zz[5] = bfhi(z0.z); zz[6] = bflo(z0.w); zz[7] = bfhi(z0.w);
              zz[8] = bflo(z1.x); zz[9] = bfhi(z1.x); zz[10] = bflo(z1.y); zz[11] = bfhi(z1.y); zz[12] = bflo(z1.z); zz[13] = bfhi(z1.z); zz[14] = bflo(z1.w); zz[15] = bfhi(z1.w);
#pragma unroll
              for (int j = 0; j < 16; ++j) { const float v = (y[j] + ea * yo[j] + dh * xraw[j]) * siluf(zz[j]); ssl += v * v; y[j] = v; }
#pragma unroll
              for (int j = 0; j < 8; ++j) ow[j] = pk2(y[2 * j], y[2 * j + 1]); }
            *(u32x4*)zp = (u32x4){ow[0], ow[1], ow[2], ow[3]}; *(u32x4*)(zp + 8) = (u32x4){ow[4], ow[5], ow[6], ow[7]};
            ssl += lane_get(ssl, lane ^ 1); ssl += lane_get(ssl, lane ^ 2);
            if ((tid & 3) == 0) s_ss[lr] += ssl;
        }
        __syncthreads();
        if (tid < CH) ROWSS[(size_t)(r0 + tid) * 2 + g] = s_ss[tid];
    }
}
DEV void ph_mixfinal(const Params& p, int l, int tid) {
    bf16_t* P = (bf16_t*)(p.ws + WS_P); const float* ROWSS = (const float*)(p.ws + WS_ROWSS); const float* ng = p.in[I_SN] + (size_t)l * 1024;
    for (int e = BIDX * NTHREADS + tid; e < M * 512; e += GDIM * NTHREADS) {
        const int row = e >> 9, c = (e & 511) * 2; const float rs = rsqrtf(ROWSS[(size_t)row * 2 + (c >> 9)] * (1.f / 512.f) + EPS);
        unsigned* q = (unsigned*)(P + (size_t)row * PW + PZ + c); const unsigned w = *q; *q = pk2(bflo(w) * rs * ng[c], bfhi(w) * rs * ng[c + 1]);
    }
}

DEV void ph_sb_attn(const Params& p, LAS unsigned char* lds, int gw, int ngw, int wave, int lane) {
    LAS float* qs = (LAS float*)(lds + 65536 + wave * 512);
    bf16_t* P = (bf16_t*)(p.ws + WS_P);
    for (int task = gw; task < NB * 8 * S; task += ngw) {
        const int t = task % S, bh = task / S, h = bh & 7, b = bh >> 3; const size_t rowb = (size_t)b * S;
        bf16_t* qp = P + (rowb + t) * PW + PSQ + h * 64;
        qs[lane] = bf2f(qp[lane]) * 0.125f; LDS_WAIT();
        float o = 0.f, R = 0.f;
        for (int k1 = t - 1; k1 >= 0; k1 -= 64) {
            const int s = k1 - lane; const bool valid = s >= 0; float z = 0.f;
            if (valid) { const bf16_t* kp = P + (rowb + s) * PW + PSK + h * 64;
#pragma unroll
                for (int q = 0; q < 8; ++q) { const u32x4 kv = *(const u32x4*)(kp + q * 8); const LAS float* qq = qs + q * 8;
                    z += qq[0] * bflo(kv.x) + qq[1] * bfhi(kv.x) + qq[2] * bflo(kv.y) + qq[3] * bfhi(kv.y) + qq[4] * bflo(kv.z) + qq[5] * bfhi(kv.z) + qq[6] * bflo(kv.w) + qq[7] * bfhi(kv.w); } }
            const float Lg = valid ? -softplusf(z) : 0.f;
            const float cum = wave_incl_scan(Lg, lane);
            const float w = valid ? __expf(z + R + cum) : 0.f;
            const int nv = (k1 + 1 < 64) ? k1 + 1 : 64;
            for (int i = 0; i < nv; ++i) { const float wi = lane_get(w, i); o += wi * bf2f(P[(rowb + (k1 - i)) * PW + PSV + h * 64 + lane]); }
            R += lane_get(cum, 63);
            if (R < -104.f) break;
        }
        qp[lane] = (bf16_t)f2bf(o);
        LDS_WAIT();
    }
}
DEV void ph_diff_attn(const Params& p, int l, LAS unsigned char* lds, int gw, int ngw, int wave, int lane) {
    LAS float* qs = (LAS float*)(lds + 65536 + 4096 + wave * 512);
    bf16_t* P = (bf16_t*)(p.ws + WS_P); const float* misc = (const float*)(p.ws + WS_MISC);
    const float lam = misc[l]; const float linit = lambda_init_of(l);
    for (int task = gw; task < NB * 4 * S; task += ngw) {
        const int t = task % S, bh = task / S, h = bh & 3, b = bh >> 2; const size_t rowb = (size_t)b * S;
        bf16_t* qp = P + (rowb + t) * PW + PDQ + h * 128;
        qs[lane] = bf2f(qp[lane]) * 0.125f; qs[64 + lane] = bf2f(qp[64 + lane]) * 0.125f; LDS_WAIT();
        const float* bt = misc + 64 + h * 128;
        float m0 = -INFINITY, m1 = -INFINITY, l0 = 0.f, l1 = 0.f, o0a = 0.f, o0b = 0.f, o1a = 0.f, o1b = 0.f;
        for (int k1 = t; k1 >= 0; k1 -= 64) {
            const int s = k1 - lane; const bool valid = s >= 0; float z0 = 0.f, z1 = 0.f;
            if (valid) { const bf16_t* kp = P + (rowb + s) * PW + PDK + h * 128;
#pragma unroll
                for (int q = 0; q < 8; ++q) { const u32x4 kv = *(const u32x4*)(kp + q * 8); const LAS float* qq = qs + q * 8;
                    z0 += qq[0] * bflo(kv.x) + qq[1] * bfhi(kv.x) + qq[2] * bflo(kv.y) + qq[3] * bfhi(kv.y) + qq[4] * bflo(kv.z) + qq[5] * bfhi(kv.z) + qq[6] * bflo(kv.w) + qq[7] * bfhi(kv.w); }
#pragma unroll
                for (int q = 0; q < 8; ++q) { const u32x4 kv = *(const u32x4*)(kp + 64 + q * 8); const LAS float* qq = qs + 64 + q * 8;
                    z1 += qq[0] * bflo(kv.x) + qq[1] * bfhi(kv.x) + qq[2] * bflo(kv.y) + qq[3] * bfhi(kv.y) + qq[4] * bflo(kv.z) + qq[5] * bfhi(kv.z) + qq[6] * bflo(kv.w) + qq[7] * bfhi(kv.w); } }
            const int dist = t - s; const float bias = bt[dist < 127 ? dist : 127];
            z0 = valid ? z0 + bias : -INFINITY; z1 = valid ? z1 + bias : -INFINITY;
            const float n0 = fmaxf(m0, wave_max(z0, lane)), n1 = fmaxf(m1, wave_max(z1, lane));
            const float sc0 = __expf(m0 - n0), sc1 = __expf(m1 - n1);
            const float p0 = valid ? __expf(z0 - n0) : 0.f, p1 = valid ? __expf(z1 - n1) : 0.f;
            l0 = l0 * sc0 + wave_sum(p0, lane); l1 = l1 * sc1 + wave_sum(p1, lane); o0a *= sc0; o0b *= sc0; o1a *= sc1; o1b *= sc1; m0 = n0; m1 = n1;
            const int nv = (k1 + 1 < 64) ? k1 + 1 : 64;
            for (int i = 0; i < nv; ++i) { const float a = lane_get(p0, i), c = lane_get(p1, i); const unsigned vv = *(const unsigned*)(P + (rowb + (k1 - i)) * PW + PDV + h * 128 + 2 * lane);
                const float va = bflo(vv), vb = bfhi(vv); o0a += a * va; o0b += a * vb; o1a += c * va; o1b += c * vb; }
        }
        const float ya = o0a / l0 - lam * o1a / l1, yb = o0b / l0 - lam * o1b / l1;
        const float rs = rsqrtf(wave_sum(ya * ya + yb * yb, lane) * (1.f / 128.f) + EPS) * (1.f - linit);
        const float* sg = p.in[I_SUB] + (size_t)l * 128 + 2 * lane;
        *(unsigned*)(qp + 2 * lane) = pk2(ya * rs * sg[0], yb * rs * sg[1]);
        LDS_WAIT();
    }
}


#include <hip/hip_bf16.h>
#include <cmath>
namespace attn_body {
using bf16=__hip_bfloat16;
using bf16x8=__attribute__((ext_vector_type(8)))short;
using s16x4=__attribute__((ext_vector_type(4)))short;
using f32x16=__attribute__((ext_vector_type(16)))float;
using u32x4=__attribute__((ext_vector_type(4)))unsigned;
constexpr int BATCH=4,SEQ=4096,D=64,DM=5632,OPITCH=1024;
constexpr int NW=8,QBLK=32,QB=QBLK*NW,KVBLK=64,NQB=SEQ/QB;
constexpr int ATTN_PITCH=DM, ATTN_UNIT_ROWS=QB; constexpr int TAB_PAD=264, TAB_N=720;
__device__ __forceinline__ int crow(int r,int hi){return (r&3)+8*(r>>2)+4*hi;}
#define SBAR() __builtin_amdgcn_sched_barrier(0)
__device__ __forceinline__ void cmask(f32x16&p0,f32x16&p1,int jb,int qrel,int hi){
  const float NEG=-INFINITY; int kb=64*jb+4*hi; asm volatile("":"+v"(kb));
  #pragma unroll
  for(int r=0;r<16;++r){int kv=kb+(r&3)+8*(r>>2); if(kv>qrel)p0[r]=NEG; if(kv+32>qrel)p1[r]=NEG;}
}

constexpr int NSLOT=3, SLOTB=8192;
constexpr int LDS_K=0, LDS_V=NSLOT*SLOTB, LDS_WS=2*NSLOT*SLOTB, LDS_OST=LDS_WS+NW*64*4, LDS_BYTES=LDS_OST+NW*4096;
constexpr float C2=0.125f*1.4426950408889634f;
__device__ __forceinline__ void glds16(const void*gsrc,unsigned lds_dst){unsigned keep;
  asm volatile("s_mov_b32 %0, m0\n\ts_mov_b32 m0, %2\n\ts_nop 0\n\tglobal_load_lds_dwordx4 %1, off\n\ts_mov_b32 m0, %0":"=&s"(keep):"v"(gsrc),"s"(lds_dst):"memory");}
__device__ __forceinline__ float max3f(float a,float b,float c){float r;asm("v_max3_f32 %0, %1, %2, %3":"=v"(r):"v"(a),"v"(b),"v"(c));return r;}
__device__ __forceinline__ float max2f(float a,float b){float r;asm("v_max_f32_e32 %0, %1, %2":"=v"(r):"v"(a),"v"(b));return r;}
__device__ __forceinline__ float fadd_s(float a,float b){float r;asm("v_add_f32_e32 %0, %1, %2":"=v"(r):"v"(a),"v"(b));return r;}
__device__ __forceinline__ float fsub_s(float a,float b){float r;asm("v_sub_f32_e32 %0, %1, %2":"=v"(r):"v"(a),"v"(b));return r;}
typedef float f32x2_t __attribute__((ext_vector_type(2))); typedef __bf16 bf16x2_t __attribute__((ext_vector_type(2)));
__device__ __forceinline__ unsigned cvtpk_s(float lo,float hi){f32x2_t v={lo,hi};bf16x2_t b=__builtin_convertvector(v,bf16x2_t);return __builtin_bit_cast(unsigned,b);}
#define WAIT_BAR(N) asm volatile("s_waitcnt vmcnt(" #N ") lgkmcnt(0)\n\ts_barrier":::"memory")

__device__ __forceinline__ void qkt(f32x16&p0,f32x16&p1,const char*Kslot,const bf16x8*qr,int r32,int hi){ const f32x16 zc_={};
  const char*kb=Kslot+hi*1024+r32*16;
  #pragma unroll
  for(int d0=0;d0<4;++d0){
    const bf16x8 b0=*reinterpret_cast<const bf16x8*>(kb+d0*2048);
    const bf16x8 b1=*reinterpret_cast<const bf16x8*>(kb+d0*2048+512);
    if(d0==0){p0=__builtin_amdgcn_mfma_f32_32x32x16_bf16(b0,qr[0],zc_,0,0,0);p1=__builtin_amdgcn_mfma_f32_32x32x16_bf16(b1,qr[0],zc_,0,0,0);}
    else{p0=__builtin_amdgcn_mfma_f32_32x32x16_bf16(b0,qr[d0],p0,0,0,0);p1=__builtin_amdgcn_mfma_f32_32x32x16_bf16(b1,qr[d0],p1,0,0,0);}}
}
typedef __attribute__((address_space(3))) const char* lds_cptr;
typedef short v4i16_t __attribute__((ext_vector_type(4)));
__device__ __forceinline__ void kload8(bf16x8*kf,lds_cptr kp){
  kf[0]=*(const __attribute__((address_space(3))) bf16x8*)(kp);      kf[1]=*(const __attribute__((address_space(3))) bf16x8*)(kp+512);
  kf[2]=*(const __attribute__((address_space(3))) bf16x8*)(kp+2048); kf[3]=*(const __attribute__((address_space(3))) bf16x8*)(kp+2560);
  kf[4]=*(const __attribute__((address_space(3))) bf16x8*)(kp+4096); kf[5]=*(const __attribute__((address_space(3))) bf16x8*)(kp+4608);
  kf[6]=*(const __attribute__((address_space(3))) bf16x8*)(kp+6144); kf[7]=*(const __attribute__((address_space(3))) bf16x8*)(kp+6656);
}
__device__ __forceinline__ void kload2(bf16x8*kf,lds_cptr kp,int j){ kf[2*j]=*(const __attribute__((address_space(3))) bf16x8*)(kp+j*2048); kf[2*j+1]=*(const __attribute__((address_space(3))) bf16x8*)(kp+j*2048+512); }
__device__ __forceinline__ s16x4 vtr(lds_cptr p){ return __builtin_bit_cast(s16x4,__builtin_amdgcn_ds_read_tr16_b64_v4i16((__attribute__((address_space(3))) v4i16_t*)p)); }
__device__ __forceinline__ float rowmax(const f32x16&p0,const f32x16&p1){
  float a=max3f(p0[0],p0[1],p1[0]),b=max3f(p0[2],p0[3],p1[1]);a=max3f(a,p1[2],p1[3]);
  #pragma unroll
  for(int r=4;r<16;r+=4){a=max3f(a,p0[r],p0[r+1]);b=max3f(b,p0[r+2],p0[r+3]);a=max3f(a,p1[r],p1[r+1]);b=max3f(b,p1[r+2],p1[r+3]);}
  const float m=max2f(a,b);
  auto rr=__builtin_amdgcn_permlane32_swap(__float_as_uint(m),__float_as_uint(m),false,false);
  return max2f(__uint_as_float(rr[0]),__uint_as_float(rr[1]));
}
__device__ __forceinline__ void pv(f32x16*o,int vb,bf16x8 pa0,bf16x8 pa1,bf16x8 pa2,bf16x8 pa3){
  #pragma unroll
  for(int d0=0;d0<2;++d0){s16x4 lo[4],hi[4];
    #pragma unroll
    for(int ks=0;ks<4;++ks){
      asm volatile("ds_read_b64_tr_b16 %0,%1 offset:%c2":"=&v"(lo[ks]):"v"(vb),"i"(d0*4096+ks*1024):"memory");
      asm volatile("ds_read_b64_tr_b16 %0,%1 offset:%c2":"=&v"(hi[ks]):"v"(vb),"i"(d0*4096+ks*1024+512):"memory");}
    asm volatile("s_waitcnt lgkmcnt(0)":::"memory");SBAR();
    #define PK(k) (bf16x8){lo[k][0],lo[k][1],lo[k][2],lo[k][3],hi[k][0],hi[k][1],hi[k][2],hi[k][3]}
    o[d0]=__builtin_amdgcn_mfma_f32_32x32x16_bf16(pa0,PK(0),o[d0],0,0,0);
    o[d0]=__builtin_amdgcn_mfma_f32_32x32x16_bf16(pa1,PK(1),o[d0],0,0,0);
    o[d0]=__builtin_amdgcn_mfma_f32_32x32x16_bf16(pa2,PK(2),o[d0],0,0,0);
    o[d0]=__builtin_amdgcn_mfma_f32_32x32x16_bf16(pa3,PK(3),o[d0],0,0,0);
    #undef PK
  }
}

#ifndef ATTN_STORE16
#define ATTN_STORE16(p,v) (*(u32x4*)(p)=(v))
#endif
template<int THRL> __device__ __forceinline__ void attn_unit(int b,int qb,const bf16*Q,const bf16*__restrict__ K,const bf16*__restrict__ V,bf16*O,char*shm,const __attribute__((address_space(3))) float*tabl,const int tid){
  const int lane=tid&63,r32=lane&31,hi=lane>>5; const int wid=__builtin_amdgcn_readfirstlane(tid>>6);
  const long rowbase=(long)b*SEQ; const int q0=qb*QB;
  const bf16*Qw=Q+(rowbase+q0+wid*QBLK)*DM;
  const bf16*Kh=K+rowbase*DM,*Vh=V+rowbase*DM;
  const unsigned lds0=(unsigned)(uintptr_t)shm;
  float*wsf=(float*)(shm+LDS_WS)+wid*64;
  const bf16*ksrc=Kh+(long)lane*DM+wid*8;
  const bf16*vsrc=Vh+(long)(16*(wid&3)+(lane>>2))*DM+(wid>>2)*32+(lane&3)*8;
  const unsigned kdst=lds0+LDS_K+wid*1024, vdst=lds0+LDS_V+wid*1024;
  #define DMA_K(t,slot) glds16(ksrc+(long)(t)*KVBLK*DM,(unsigned)__builtin_amdgcn_readfirstlane(kdst+(slot)))
  #define DMA_V(t,slot) glds16(vsrc+(long)(t)*KVBLK*DM,(unsigned)__builtin_amdgcn_readfirstlane(vdst+(slot)))
  const int vb0=(int)(lds0+LDS_V)+((lane>>4)&1)*32+(lane&3)*8+(4*hi+((lane&15)>>2))*64;
  const char*Kbase=shm+LDS_K; bf16x8 kf[8];
  const lds_cptr shm3=(lds_cptr)shm; const lds_cptr kp0=shm3+LDS_K+hi*1024+r32*16; const lds_cptr vp0=shm3+LDS_V+((lane>>4)&1)*32+(lane&3)*8+(4*hi+((lane&15)>>2))*64;
  const int NT=(q0+QB)/KVBLK;
  DMA_K(0,0);DMA_V(0,0);DMA_K(1,SLOTB);
  bf16x8 qr[4];
  #pragma unroll
  for(int d0=0;d0<4;++d0)qr[d0]=*reinterpret_cast<const bf16x8*>(&Qw[(long)r32*DM+d0*16+hi*8]);
  float z0_=0.f;asm volatile("":"+v"(z0_));
  float mhat=z0_,l_reg=z0_;f32x16 o[2]; const f32x16 zc_={};
  _Pragma("unroll") for(int r=0;r<16;++r){o[0][r]=z0_;o[1][r]=z0_;}
  const int qrel=wid*QBLK+r32;
  #define CMASK(P0,P1,t) do{int jb_=(t)-(NT-4); if(jb_>=0)cmask(P0,P1,jb_,qrel,hi);}while(0)
  #define BIASADD(P0,P1,t) do{ const __attribute__((address_space(3))) float*tp_=tabl+(q0+qrel-64*(t)-4*hi+(TAB_PAD-63)); \
    _Pragma("unroll") for(int r=0;r<16;++r){ const int c_=(r&3)+8*(r>>2); P0[r]+=tp_[63-c_]; P1[r]+=tp_[31-c_]; if((r&1)==1){SBAR();} } }while(0)
  bool resc=false;
  #define START(P0,P1) do{ const float rm=rowmax(P0,P1); resc=false; \
    { const float dl=rm; mhat=fadd_s(mhat,dl); \
      _Pragma("unroll") for(int r=0;r<16;++r){P0[r]=fsub_s(P0[r],dl);P1[r]=fsub_s(P1[r],dl);} \
      } \
    _Pragma("unroll") for(int r=0;r<16;++r)P0[r]=__builtin_amdgcn_exp2f(P0[r]); }while(0)
  #define RESC() do{ if(resc){ asm volatile("s_waitcnt lgkmcnt(0)":::"memory"); \
      _Pragma("unroll") for(int d_=0;d_<2;++d_) _Pragma("unroll") for(int r=0;r<16;++r)o[d_][r]*=wsf[crow(r,hi)]; } }while(0)
  f32x16 pA0,pA1,pB0,pB1;
  int sl_prev=0,sl_cur=0,sl_next=SLOTB;
  #define ROT() do{sl_prev=sl_cur;sl_cur=sl_next;sl_next=(sl_next==(NSLOT-1)*SLOTB)?0:sl_next+SLOTB;}while(0)
  DMA_K(2,2*SLOTB);
  WAIT_BAR(3);
  qkt(pA0,pA1,Kbase,qr,r32,hi);asm volatile("s_nop 15\n\ts_nop 7":"+v"(pA0),"+v"(pA1)); if(NT<=6){BIASADD(pA0,pA1,0);} CMASK(pA0,pA1,0);
  START(pA0,pA1);
  _Pragma("unroll") for(int r=0;r<16;++r)pA1[r]=__builtin_amdgcn_exp2f(pA1[r]);
  WAIT_BAR(0);
  DMA_K(3,0);DMA_V(1,SLOTB);
  ROT();
  kload8(kf,kp0+sl_cur);
  WAIT_BAR(2);
  s16x4 vlo[8],vhi[8]; u32x4 pw0,pw1,pw2,pw3;
  #define PKW(P,B) cvtpk_s(P[B],P[B+1])
  #define PAF(k) __builtin_bit_cast(bf16x8,pw##k)
  #define VFR(i) (bf16x8){vlo[i][0],vlo[i][1],vlo[i][2],vlo[i][3],vhi[i][0],vhi[i][1],vhi[i][2],vhi[i][3]}
  #define PIN(x) asm volatile("":"+v"(x))
  #define MX3(a,b,c) __builtin_fmaxf(__builtin_fmaxf((a),(b)),(c))
  #define GAPA(MF,A0,A1,A2,A3,W0,W1,PW) do{ MF; sacc+=A0; sacc+=A1; sacc+=A2; sacc+=A3; PIN(sacc); W0; W1; PIN(PW); SBAR(); }while(0)
  #define EX(v) __builtin_amdgcn_exp2f(v)
  #define GAPB(MF,X,B) do{ MF; X[B]=EX(X[B]); X[B+1]=EX(X[B+1]); X[B+2]=EX(X[B+2]); X[B+3]=EX(X[B+3]); PIN(X); SBAR(); }while(0)
  #define VRD(i) do{ vlo[i]=vtr(vp_+(((i)>>2)*4096+((i)&3)*1024)); vhi[i]=vtr(vp_+(((i)>>2)*4096+((i)&3)*1024+512)); }while(0)
  #define KRD(G,j) do{ if(G){ kload2(kf,kp0+sl_next,j); SBAR(); } }while(0)
  #define STEP(C0,C1,P0,P1,t,GK,GV,GL) do{ SBAR(); \
    const lds_cptr vp_=vp0+sl_prev; \
    VRD(0); SBAR(); float sacc=(P0[0]+P0[1]); \
    GAPA(C0=__builtin_amdgcn_mfma_f32_32x32x16_bf16(kf[0],qr[0],zc_,0,0,0), P0[2],P0[3],P0[4],P0[5],     pw0[0]=PKW(P0,0), pw0[1]=PKW(P0,2), pw0); \
    VRD(4); SBAR(); GAPA(C1=__builtin_amdgcn_mfma_f32_32x32x16_bf16(kf[1],qr[0],zc_,0,0,0), P0[6],P0[7],P0[8],P0[9],     pw0[2]=PKW(P0,4), pw0[3]=PKW(P0,6), pw0); \
    VRD(1); SBAR(); GAPA(C0=__builtin_amdgcn_mfma_f32_32x32x16_bf16(kf[2],qr[1],C0,0,0,0),   P0[10],P0[11],P0[12],P0[13], pw1[0]=PKW(P0,8), pw1[1]=PKW(P0,10), pw1); \
    VRD(5); SBAR(); GAPA(C1=__builtin_amdgcn_mfma_f32_32x32x16_bf16(kf[3],qr[1],C1,0,0,0),   P0[14],P0[15],P1[0],P1[1],   pw1[2]=PKW(P0,12),pw1[3]=PKW(P0,14), pw1); \
    VRD(2); SBAR(); GAPA(C0=__builtin_amdgcn_mfma_f32_32x32x16_bf16(kf[4],qr[2],C0,0,0,0),   P1[2],P1[3],P1[4],P1[5],     pw2[0]=PKW(P1,0), pw2[1]=PKW(P1,2), pw2); \
    VRD(6); SBAR(); GAPA(C1=__builtin_amdgcn_mfma_f32_32x32x16_bf16(kf[5],qr[2],C1,0,0,0),   P1[6],P1[7],P1[8],P1[9],     pw2[2]=PKW(P1,4), pw2[3]=PKW(P1,6), pw2); \
    VRD(3); SBAR(); GAPA(C0=__builtin_amdgcn_mfma_f32_32x32x16_bf16(kf[6],qr[3],C0,0,0,0),   P1[10],P1[11],P1[12],P1[13], pw3[0]=PKW(P1,8), pw3[1]=PKW(P1,10), pw3); \
    VRD(7); SBAR(); GAPA(C1=__builtin_amdgcn_mfma_f32_32x32x16_bf16(kf[7],qr[3],C1,0,0,0),   P1[14],P1[15],0.f,0.f,       pw3[2]=PKW(P1,12),pw3[3]=PKW(P1,14), pw3); \
    l_reg+=sacc; \
    if(GK){DMA_K((t)+3,sl_cur);} if(GV){DMA_V((t)+1,sl_next);} \
    BIASQ(C0,C1,t); CMASK(C0,C1,t); \
    { float a=MX3(C0[0],C0[1],C1[0]),b=MX3(C0[2],C0[3],C1[1]); a=MX3(a,C1[2],C1[3]); \
      _Pragma("unroll") for(int r=4;r<16;r+=4){a=MX3(a,C0[r],C0[r+1]);b=MX3(b,C0[r+2],C0[r+3]);a=MX3(a,C1[r],C1[r+1]);b=MX3(b,C1[r+2],C1[r+3]);} \
      float rm=__builtin_fmaxf(a,b); { auto rr=__builtin_amdgcn_permlane32_swap(__float_as_uint(rm),__float_as_uint(rm),false,false); rm=__builtin_fmaxf(__uint_as_float(rr[0]),__uint_as_float(rr[1])); } \
      rm-=mhat; resc=false; \
      if(__builtin_expect(__any(rm>(float)THRL),0)){ const float dl=__builtin_fmaxf(rm,0.f); mhat+=dl; \
        const float f=__builtin_amdgcn_exp2f(-dl); l_reg*=f; if(hi==0)wsf[r32]=f; resc=true; } \
      _Pragma("unroll") for(int r=0;r<16;++r){C0[r]-=mhat;C1[r]-=mhat;} } \
    SBAR(); \
    GAPB(o[0]=__builtin_amdgcn_mfma_f32_32x32x16_bf16(PAF(0),VFR(0),o[0],0,0,0), C0,0); \
    GAPB(o[1]=__builtin_amdgcn_mfma_f32_32x32x16_bf16(PAF(0),VFR(4),o[1],0,0,0), C0,4); \
    KRD(GL,0); GAPB(o[0]=__builtin_amdgcn_mfma_f32_32x32x16_bf16(PAF(1),VFR(1),o[0],0,0,0), C0,8); \
    KRD(GL,1); GAPB(o[1]=__builtin_amdgcn_mfma_f32_32x32x16_bf16(PAF(1),VFR(5),o[1],0,0,0), C0,12); \
    KRD(GL,2); GAPB(o[0]=__builtin_amdgcn_mfma_f32_32x32x16_bf16(PAF(2),VFR(2),o[0],0,0,0), C1,0); \
    KRD(GL,3); GAPB(o[1]=__builtin_amdgcn_mfma_f32_32x32x16_bf16(PAF(2),VFR(6),o[1],0,0,0), C1,4); \
    GAPB(o[0]=__builtin_amdgcn_mfma_f32_32x32x16_bf16(PAF(3),VFR(3),o[0],0,0,0), C1,8); \
    GAPB(o[1]=__builtin_amdgcn_mfma_f32_32x32x16_bf16(PAF(3),VFR(7),o[1],0,0,0), C1,12); \
    }while(0)
  int t=1;
  #undef CMASK
  #define CMASK(P0,P1,t) do{}while(0)
  #define BIASQ(P0,P1,t) do{}while(0)
  for(;t+7<NT;t+=2){
    STEP(pB0,pB1,pA0,pA1,t,true,true,true);     WAIT_BAR(2); RESC(); ROT();
    STEP(pA0,pA1,pB0,pB1,t+1,true,true,true);   WAIT_BAR(2); RESC(); ROT();
  }
  #undef CMASK
  #undef BIASQ
  #define CMASK(P0,P1,t) do{int jb_=(t)-(NT-4); if(jb_>=0)cmask(P0,P1,jb_,qrel,hi);}while(0)
  #define BIASQ(P0,P1,t) BIASADD(P0,P1,t)
  #define ENDW(tt) do{ if((tt)+3<NT){WAIT_BAR(2);} else if((tt)+2<NT){WAIT_BAR(1);} else {WAIT_BAR(0);} }while(0)
  for(;t+1<NT;t+=2){
    STEP(pB0,pB1,pA0,pA1,t,(t+3<NT),(t+1<NT),(t+1<NT));       ENDW(t);   RESC(); ROT();
    STEP(pA0,pA1,pB0,pB1,t+1,(t+4<NT),(t+2<NT),(t+2<NT));     ENDW(t+1); RESC(); ROT();
  }
  STEP(pB0,pB1,pA0,pA1,NT-1,false,false,false); RESC();
  { float sacc=pB0[0]+pB0[1]; _Pragma("unroll") for(int r=2;r<16;++r)sacc+=pB0[r]; _Pragma("unroll") for(int r=0;r<16;++r)sacc+=pB1[r]; l_reg+=sacc;
    pw0=(u32x4){PKW(pB0,0),PKW(pB0,2),PKW(pB0,4),PKW(pB0,6)};pw1=(u32x4){PKW(pB0,8),PKW(pB0,10),PKW(pB0,12),PKW(pB0,14)};pw2=(u32x4){PKW(pB1,0),PKW(pB1,2),PKW(pB1,4),PKW(pB1,6)};pw3=(u32x4){PKW(pB1,8),PKW(pB1,10),PKW(pB1,12),PKW(pB1,14)};
    SBAR(); pv(o,vb0+sl_cur,PAF(0),PAF(1),PAF(2),PAF(3)); }
  #undef PKW
  #undef PAF
  #undef VFR
  #undef PIN
  #undef MX3
  #undef GAPA
  #undef GAPB
  #undef EX
  #undef VRD
  #undef KRD
  #undef STEP
  #undef ENDW
  {auto rr=__builtin_amdgcn_permlane32_swap(__float_as_uint(l_reg),__float_as_uint(l_reg),false,false);l_reg=__uint_as_float(rr[0])+__uint_as_float(rr[1]);}
  int lane_e=lane; asm volatile("":"+v"(lane_e)); const int r32e=lane_e&31,hie=lane_e>>5;
  float*wsfe=(float*)(shm+LDS_WS)+wid*64;
  if(hie==0)wsfe[32+r32e]=l_reg;asm volatile("s_waitcnt lgkmcnt(0)":::"memory");
  float rli[16];
  #pragma unroll
  for(int r=0;r<16;++r)rli[r]=__builtin_amdgcn_rcpf(wsfe[32+crow(r,hie)]);
  bf16*Ow=O+(rowbase+q0+wid*QBLK)*OPITCH;
  { bf16*stg=(bf16*)(shm+LDS_OST)+wid*2048;
    #pragma unroll
    for(int r=0;r<16;++r){const int orow=crow(r,hie);
      #pragma unroll
      for(int d0=0;d0<2;++d0)stg[orow*64+d0*32+r32e]=__float2bfloat16(o[d0][r]*rli[r]);}
    asm volatile("s_waitcnt lgkmcnt(0)":::"memory");
    #pragma unroll
    for(int i=0;i<4;++i){const int row=i*8+(lane_e>>3),ch=lane_e&7; const u32x4 v=*(const u32x4*)(stg+row*64+ch*8); ATTN_STORE16(Ow+(long)row*OPITCH+ch*8,v);} }
  asm volatile("s_waitcnt lgkmcnt(0)\n\ts_barrier":::"memory");
  #undef DMA_K
  #undef DMA_V
  #undef CMASK
  #undef BIASQ
  #undef BIASADD
  #undef START
  #undef RESC
  #undef ROT
}
constexpr int ATTN_LDS_BYTES=LDS_BYTES;
constexpr int SB_KB=0, SB_VB=16384, SB_FLG=32768, SB_OST=33024, SB_LDS=SB_OST+NW*4096;
__device__ __forceinline__ void sb_unit(int b,int qb,bf16*Qp,const bf16*__restrict__ Kp,const bf16*__restrict__ Vp,char*shm,const int tid){
  const int lane=tid&63,r32=lane&31,hi=lane>>5; const int wid=__builtin_amdgcn_readfirstlane(tid>>6);
  const long rowbase=(long)b*SEQ; const int q0=qb*QB;
  bf16*Qw=Qp+(rowbase+q0+wid*QBLK)*DM;
  bf16x8 qr[4];
  #pragma unroll
  for(int d0=0;d0<4;++d0)qr[d0]=*reinterpret_cast<const bf16x8*>(&Qw[(long)r32*DM+d0*16+hi*8]);
  bf16x8 UA,UB,ONES;
  #pragma unroll
  for(int j=0;j<8;++j){ const int kvp=8*(j>>2)+4*hi+(j&3); UA[j]=(kvp>r32)?(short)0x3F80:(short)0; UB[j]=(kvp+16>r32)?(short)0x3F80:(short)0; ONES[j]=(short)0x3F80; }
  float z0_=0.f;asm volatile("":"+v"(z0_));
  f32x16 o[2]; float R=z0_;
  #pragma unroll
  for(int r=0;r<16;++r){o[0][r]=z0_;o[1][r]=z0_;}
  const int qw0=q0+wid*QBLK, qabs=qw0+r32;
  const int NT=(q0+QB)/KVBLK;
  const bf16*ksrc=Kp+(rowbase+lane)*DM+wid*8;
  const bf16*vsrc=Vp+(rowbase+16*(wid&3)+(lane>>2))*DM+(wid>>2)*32+(lane&3)*8;
  typedef __attribute__((address_space(3))) u32x4* lds_u4p;
  const lds_cptr shm3=(lds_cptr)shm;
  const unsigned lds0=(unsigned)(uintptr_t)shm;
  volatile __attribute__((address_space(3))) int*flg=(volatile __attribute__((address_space(3))) int*)(shm3+SB_FLG);
  u32x4 kreg,vreg; int kt=NT-1,cur=0;
  kreg=*(const u32x4*)(ksrc+(long)kt*KVBLK*DM); vreg=*(const u32x4*)(vsrc+(long)kt*KVBLK*DM);
  bool done_w=false;
  for(;;){
    *(lds_u4p)(shm3+SB_KB+cur*8192+wid*1024+lane*16)=kreg; *(lds_u4p)(shm3+SB_VB+cur*8192+wid*1024+lane*16)=vreg;
    __syncthreads();
    if(kt>0){ kreg=*(const u32x4*)(ksrc+(long)(kt-1)*KVBLK*DM); vreg=*(const u32x4*)(vsrc+(long)(kt-1)*KVBLK*DM); }
    if(64*kt<qw0+31 && !done_w){
      f32x16 p0,p1; qkt(p0,p1,shm+SB_KB+cur*8192,qr,r32,hi);
      const int kv0=64*kt+4*hi;
      f32x16 L0,L1;
      #pragma unroll
      for(int r=0;r<16;++r){ const int kv=kv0+(r&3)+8*(r>>2);
        { const float z=p0[r]; const float sp=__builtin_fmaxf(z,0.f)+__builtin_amdgcn_logf(1.f+__builtin_amdgcn_exp2f(-__builtin_fabsf(z))); L0[r]=(kv<qabs)?-sp:0.f; }
        { const float z=p1[r]; const float sp=__builtin_fmaxf(z,0.f)+__builtin_amdgcn_logf(1.f+__builtin_amdgcn_exp2f(-__builtin_fabsf(z))); L1[r]=(kv+32<qabs)?-sp:0.f; } }
      u32x4 lh[4],ll[4];
      #pragma unroll
      for(int s=0;s<4;++s)
        #pragma unroll
        for(int e=0;e<4;++e){ const float a=(s<2)?L0[8*s+2*e]:L1[8*(s-2)+2*e], c=(s<2)?L0[8*s+2*e+1]:L1[8*(s-2)+2*e+1];
          const unsigned h2=cvtpk_s(a,c); lh[s][e]=h2; ll[s][e]=cvtpk_s(a-__uint_as_float(h2<<16),c-__uint_as_float(h2&0xffff0000u)); }
      #define BF8(x) __builtin_bit_cast(bf16x8,x)
      const f32x16 zc_={};
      f32x16 T0=__builtin_amdgcn_mfma_f32_32x32x16_bf16(UA,BF8(lh[0]),zc_,0,0,0);
      T0=__builtin_amdgcn_mfma_f32_32x32x16_bf16(UA,BF8(ll[0]),T0,0,0,0);
      T0=__builtin_amdgcn_mfma_f32_32x32x16_bf16(UB,BF8(lh[1]),T0,0,0,0); T0=__builtin_amdgcn_mfma_f32_32x32x16_bf16(UB,BF8(ll[1]),T0,0,0,0);
      T0=__builtin_amdgcn_mfma_f32_32x32x16_bf16(ONES,BF8(lh[2]),T0,0,0,0); T0=__builtin_amdgcn_mfma_f32_32x32x16_bf16(ONES,BF8(ll[2]),T0,0,0,0);
      T0=__builtin_amdgcn_mfma_f32_32x32x16_bf16(ONES,BF8(lh[3]),T0,0,0,0); T0=__builtin_amdgcn_mfma_f32_32x32x16_bf16(ONES,BF8(ll[3]),T0,0,0,0);
      f32x16 T1=__builtin_amdgcn_mfma_f32_32x32x16_bf16(UA,BF8(lh[2]),zc_,0,0,0);
      T1=__builtin_amdgcn_mfma_f32_32x32x16_bf16(UA,BF8(ll[2]),T1,0,0,0);
      T1=__builtin_amdgcn_mfma_f32_32x32x16_bf16(UB,BF8(lh[3]),T1,0,0,0); T1=__builtin_amdgcn_mfma_f32_32x32x16_bf16(UB,BF8(ll[3]),T1,0,0,0);
      float tot=T0[0]+L0[0]; { auto rr=__builtin_amdgcn_permlane32_swap(__float_as_uint(tot),__float_as_uint(tot),false,false); tot=__uint_as_float(rr[0]); }
      #pragma unroll
      for(int r=0;r<16;++r){ const int kv=kv0+(r&3)+8*(r>>2);
        p0[r]=(kv<qabs)?__builtin_amdgcn_exp2f(p0[r]+L0[r]+T0[r]+R):0.f; p1[r]=(kv+32<qabs)?__builtin_amdgcn_exp2f(p1[r]+L1[r]+T1[r]+R):0.f; }
      R+=tot;
      u32x4 pw0,pw1,pw2,pw3;
      pw0=(u32x4){cvtpk_s(p0[0],p0[1]),cvtpk_s(p0[2],p0[3]),cvtpk_s(p0[4],p0[5]),cvtpk_s(p0[6],p0[7])}; pw1=(u32x4){cvtpk_s(p0[8],p0[9]),cvtpk_s(p0[10],p0[11]),cvtpk_s(p0[12],p0[13]),cvtpk_s(p0[14],p0[15])};
      pw2=(u32x4){cvtpk_s(p1[0],p1[1]),cvtpk_s(p1[2],p1[3]),cvtpk_s(p1[4],p1[5]),cvtpk_s(p1[6],p1[7])}; pw3=(u32x4){cvtpk_s(p1[8],p1[9]),cvtpk_s(p1[10],p1[11]),cvtpk_s(p1[12],p1[13]),cvtpk_s(p1[14],p1[15])};
      SBAR();
      const int vb=(int)(lds0+SB_VB+cur*8192)+((lane>>4)&1)*32+(lane&3)*8+(4*hi+((lane&15)>>2))*64;
      pv(o,vb,BF8(pw0),BF8(pw1),BF8(pw2),BF8(pw3));
      #undef BF8
      done_w=__all(R<-150.f);
    }
    if(lane==0)flg[wid]=done_w?1:0;
    __syncthreads();
    int alld=1;
    #pragma unroll
    for(int w=0;w<NW;++w)alld&=flg[w];
    if(alld||kt==0)break;
    --kt;cur^=1;
  }
  { int lane_e=lane; asm volatile("":"+v"(lane_e)); const int r32e=lane_e&31,hie=lane_e>>5;
    bf16*stg=(bf16*)(shm+SB_OST)+wid*2048;
    #pragma unroll
    for(int r=0;r<16;++r){const int orow=crow(r,hie);
      #pragma unroll
      for(int d0=0;d0<2;++d0)stg[orow*64+d0*32+r32e]=__float2bfloat16(o[d0][r]);}
    asm volatile("s_waitcnt lgkmcnt(0)":::"memory");
    #pragma unroll
    for(int i=0;i<4;++i){const int row=i*8+(lane_e>>3),ch=lane_e&7; const u32x4 v=*(const u32x4*)(stg+row*64+ch*8); *(u32x4*)(Qw+(long)row*DM+ch*8)=v;} }
  __syncthreads();
}
__device__ __forceinline__ void sb_attn_phase(char*lds,bf16*P,int vcu,int G,const int tid){
  #pragma unroll 1
  for(int u=vcu;u<512;u+=G){ int u_=u; asm volatile("":"+s"(u_)); int tid_=tid; asm volatile("":"+v"(tid_));
    const int qb=u_&15,bh=u_>>4,h=bh&7,b=bh>>3;
    sb_unit(b,qb,P+1024+h*64,P+2048+h*64,P+2560+h*64,lds,tid_); }
}
template<int THRL=8> __device__ __forceinline__ void diff_attn_phase(char*lds,const bf16*P,bf16*OD,const __attribute__((address_space(3))) float*tab,int vcu,int G,const int tid){
  for(int st=vcu;st<256;st+=G){
    #pragma unroll 1
    for(int i=0;i<4;++i){ int st_=st; asm volatile("":"+s"(st_)); int tid_=tid; asm volatile("":"+v"(tid_));
      const int bhv=st_>>2,s=st_&3,b=bhv>>4,hv=bhv&15,h=hv>>2,m=(hv>>1)&1,vh=hv&1;
      const bf16*Q=P+1536+h*128+m*64,*K=P+3072+h*128+m*64,*V=P+3584+h*128+vh*64; bf16*O=OD+hv*64;
      const int qb=(i==0)?s:(i==1)?7-s:(i==2)?8+s:15-s; attn_unit<THRL>(b,qb,Q,K,V,O,lds,tab+h*TAB_N,tid_); } }
}
#undef SBAR
#undef WAIT_BAR
}
#define GAS __attribute__((address_space(1)))
typedef GAS unsigned gu32;
#define RLX_AGENT __ATOMIC_RELAXED, __HIP_MEMORY_SCOPE_AGENT
#define XB_TMO      128
#define XB_XCNT(j)  (256  + 64 * (j))
#define XB_XSUB(j)  (1280 + 64 * (j))
#define XB_XGEN(j)  (2304 + 64 * (j))
#define XB_TOP      3328
#define XB_TOPGEN   3392
#define XCD_BAR_WORDS 3456
#define XB_SPIN_CAP (1u << 18)

__device__ __forceinline__ unsigned xb_ld(unsigned* p)              { return __hip_atomic_load(p, __ATOMIC_RELAXED, __HIP_MEMORY_SCOPE_AGENT); }
__device__ __forceinline__ unsigned xb_add(unsigned* p, unsigned v) { return __hip_atomic_fetch_add(p, v, __ATOMIC_RELAXED, __HIP_MEMORY_SCOPE_AGENT); }
__device__ __forceinline__ unsigned xb_xcc_id() { return (unsigned)__builtin_amdgcn_s_getreg((3 << 11) | 20) & 0xFu; }
#define XB_SPIN(cond, bar) do { unsigned _sp = 0; while (cond) { __builtin_amdgcn_s_sleep(1); \
    if ((++_sp & 255u) == 0u) { if (xb_ld(&(bar)[XB_TMO])) break; if (_sp > XB_SPIN_CAP) { atomicAdd(&(bar)[XB_TMO], 1u); break; } } } } while (0)

struct XcdBarrier {
    unsigned* bar; unsigned x; bool lead;
    volatile LAS unsigned* st;
};

__device__ __forceinline__ XcdBarrier xcd_barrier_post(unsigned* bar, volatile LAS unsigned* st) {
    XcdBarrier b; b.bar = bar; b.x = xb_xcc_id(); b.st = st; b.lead = threadIdx.x == 0;
    if (threadIdx.x == 0) (void)xb_add(&bar[XB_XCNT(b.x)], 1u);
    return b;
}
__device__ __forceinline__ void xcd_barrier_complete(unsigned* bar, unsigned x, unsigned& nloc, unsigned& nx) {
    const unsigned G = gridDim.x * gridDim.y * gridDim.z;
    unsigned sum, cnt, mine, sp = 0u;
    for (;;) {
        sum = 0u; cnt = 0u; mine = 0u;
#pragma unroll
        for (unsigned j = 0; j < 16; ++j) { const unsigned c = xb_ld(&bar[XB_XCNT(j)]); sum += c; cnt += (c > 0u) ? 1u : 0u; mine = (j == x) ? c : mine; }
        if (sum == G) break;
        __builtin_amdgcn_s_sleep(1);
        if ((++sp & 255u) == 0u) { if (xb_ld(&bar[XB_TMO])) break; if (sp > XB_SPIN_CAP) { atomicAdd(&bar[XB_TMO], 1u); break; } }
    }
    nloc = mine > 0u ? mine : 1u; nx = cnt > 0u ? cnt : 1u;
}

__device__ __forceinline__ void xcd_barrier(const XcdBarrier& b) {
    asm volatile("s_waitcnt vmcnt(0)" ::: "memory");
    __syncthreads();
    if (b.lead) {
        unsigned* bar = b.bar;
        __builtin_amdgcn_s_waitcnt(0);
        unsigned nloc = b.st[0], nx = b.st[1];
        if (nloc == 0u) { xcd_barrier_complete(bar, b.x, nloc, nx); b.st[0] = nloc; b.st[1] = nx; }
        const unsigned old = xb_add(&bar[XB_XSUB(b.x)], 1u);
        const unsigned gen = old / nloc;
        if (old + 1u == (gen + 1u) * nloc) {
            __builtin_amdgcn_fence(__ATOMIC_RELEASE, "agent");
            asm volatile("s_waitcnt vmcnt(0)" ::: "memory");
            const unsigned og = xb_add(&bar[XB_TOP], 1u);
            const unsigned tg = og / nx;
            if (og + 1u == (tg + 1u) * nx) xb_add(&bar[XB_TOPGEN], 1u);
            else XB_SPIN(xb_ld(&bar[XB_TOPGEN]) == tg, bar);
            __builtin_amdgcn_fence(__ATOMIC_ACQUIRE, "agent");
            xb_add(&bar[XB_XGEN(b.x)], 1u);
            asm volatile("s_waitcnt vmcnt(0)" ::: "memory");
        } else {
            XB_SPIN(xb_ld(&bar[XB_XGEN(b.x)]) == gen, bar);
            __builtin_amdgcn_fence(__ATOMIC_ACQUIRE, "agent");
            asm volatile("s_waitcnt vmcnt(0)" ::: "memory");
        }
    }
    __syncthreads();
}
DEV void ph_diff_combine(const Params& p, int l, int gw, int ngw, int lane) {
    bf16_t* P = (bf16_t*)(p.ws + WS_P); const bf16_t* OD = (const bf16_t*)(p.ws + WS_OD); const float* misc = (const float*)(p.ws + WS_MISC);
    const float lam = misc[l]; const float linit = lambda_init_of(l);
    const float g0 = p.in[I_SUB][(size_t)l * 128 + 2 * lane] * (1.f - linit), g1 = p.in[I_SUB][(size_t)l * 128 + 2 * lane + 1] * (1.f - linit);
    for (int row = gw; row < M; row += ngw) {
#pragma unroll
        for (int h = 0; h < 4; ++h) { const unsigned o0 = *(const unsigned*)(OD + (size_t)row * 1024 + h * 256 + 2 * lane), o1 = *(const unsigned*)(OD + (size_t)row * 1024 + h * 256 + 128 + 2 * lane);
            const float ya = bflo(o0) - lam * bflo(o1), yb = bfhi(o0) - lam * bfhi(o1);
            const float rs = rsqrtf(wave_sum(ya * ya + yb * yb, lane) * (1.f / 128.f) + EPS);
            *(unsigned*)(P + (size_t)row * PW + PDQ + h * 128 + 2 * lane) = pk2(ya * rs * g0, yb * rs * g1); }
    }
}
constexpr int LDS_TAB_OFF = 86016;
DEV void ph_diff_table(const Params& p, LAS unsigned char* lds, int tid) {
    LAS float* tab = (LAS float*)(lds + LDS_TAB_OFF); const float* bt = (const float*)(p.ws + WS_MISC) + 64;
    for (int j = tid; j < 4 * attn_body::TAB_N; j += NTHREADS) { const int h = j / attn_body::TAB_N, d = j % attn_body::TAB_N - attn_body::TAB_PAD;
        tab[j] = (d >= 0 && d < 127) ? (bt[h * 128 + d] - bt[h * 128 + 127]) * 1.4426950408889634f : 0.f; }
}
#ifndef MK_FUSED
#define MK_FUSED 1
#endif
constexpr int PH_PER_LAYER = 15, N_PHASES = NL * PH_PER_LAYER + 1;
template <int ST>
__global__ void __launch_bounds__(NTHREADS, 2) mk_phase(Params p, int l) {
    extern __shared__ __attribute__((aligned(16))) unsigned char lds_raw[];
    LAS unsigned char* lds = (LAS unsigned char*)lds_raw;
    const int tid = threadIdx.x, lane = tid & 63, wave = __builtin_amdgcn_readfirstlane(tid >> 6);
    const int gw = BIDX * NWAVES + wave, ngw = GDIM * NWAVES;
    bf16_t* wt = (bf16_t*)(p.ws + WS_WT); bf16_t* XN = (bf16_t*)(p.ws + WS_XN); bf16_t* P = (bf16_t*)(p.ws + WS_P); bf16_t* H = (bf16_t*)(p.ws + WS_H);
    float* DT = (float*)(p.ws + WS_DT); bf16_t* HALO = (bf16_t*)(p.ws + WS_HALO); const float* mod = (const float*)(p.ws + WS_MOD);
    if constexpr (ST == 15) { ph_final_norm(p.out, p.in[I_FN], gw, ngw, lane); return; }
    const float* modl = mod + (size_t)l * NB * MODW;
    const float* xcur = (l == 0 && ST <= 3) ? p.in[I_X] : p.out;
    if constexpr (ST == 0) { ph_convert(p, l, lds, gw, ngw, wave, lane); if (l == 0) ph_mod(p, lds, tid, wave, lane); }
    if constexpr (ST == 1) ph_norm(xcur, p.in[I_N1] + (size_t)l * D, modl, 0, 1, XN, gw, ngw, lane);
    if constexpr (ST == 2) { pg8::Gemm g{XN, wt + WT_13A / 2, M, 2 * DFF, D, D}; pg8::StaticOrder So; So.init(M, 2 * DFF, (int)GDIM, (int)BIDX); pg8::EpiSwigluT E{H}; pg8::gemm_phase<pg8::EpiSwigluT, pg8::StaticOrder, true, true>(lds, g, So, E, tid); }
    if constexpr (ST == 3) { pg8::Gemm g{H, wt + WT_2A / 2, M, D, DFF, DFF}; pg8::StaticOrder So; So.init(M, D, (int)GDIM, (int)BIDX); pg8::EpiResidT E{xcur, p.out, modl + 2 * D, 0.5f}; pg8::gemm_phase<pg8::EpiResidT, pg8::StaticOrder, true, true>(lds, g, So, E, tid); }
    if constexpr (ST == 4) ph_norm(p.out, p.in[I_NM] + (size_t)l * D, modl, 3, 4, XN, gw, ngw, lane);
    if constexpr (ST == 5) { pg8::Gemm g{XN, wt + WT_IN / 2, M, NIN, D, D}; pg8::StaticOrder So; So.init(M, NIN, (int)GDIM, (int)BIDX); pg8::EpiInT E{P, DT, HALO}; pg8::gemm_phase<pg8::EpiInT, pg8::StaticOrder, true, true>(lds, g, So, E, tid); }
    if constexpr (ST == 6) ph_conv(p, l, tid);
    if constexpr (ST == 7) ph_ssd_state(p, l, lds, tid, wave, lane);
    if constexpr (ST == 16) ph_sb_attn(p, lds, gw, ngw, wave, lane);
    if constexpr (ST == 17) ph_diff_attn(p, l, lds, gw, ngw, wave, lane);
    if constexpr (ST == 8) ph_ssd_scan(p, tid);
    if constexpr (ST == 9) ph_ssd_out(p, l, lds, tid, wave, lane);
    if constexpr (ST == 10) ph_mixfinal(p, l, tid);
    if constexpr (ST == 11) { pg8::Gemm g{P, wt + WT_OUT / 2, M, D, 2048, PW}; pg8::StaticOrder So; So.init(M, D, (int)GDIM, (int)BIDX); pg8::EpiResidT E{p.out, p.out, modl + 5 * D, 1.0f}; pg8::gemm_phase<pg8::EpiResidT, pg8::StaticOrder, true, true>(lds, g, So, E, tid); }
    if constexpr (ST == 12) ph_norm(p.out, p.in[I_N2] + (size_t)l * D, modl, 6, 7, XN, gw, ngw, lane);
    if constexpr (ST == 13) { pg8::Gemm g{XN, wt + WT_13B / 2, M, 2 * DFF, D, D}; pg8::StaticOrder So; So.init(M, 2 * DFF, (int)GDIM, (int)BIDX); pg8::EpiSwigluT E{H}; pg8::gemm_phase<pg8::EpiSwigluT, pg8::StaticOrder, true, true>(lds, g, So, E, tid); }
    if constexpr (ST == 14) { pg8::Gemm g{H, wt + WT_2B / 2, M, D, DFF, DFF}; pg8::StaticOrder So; So.init(M, D, (int)GDIM, (int)BIDX); pg8::EpiResidT E{p.out, p.out, modl + 8 * D, 0.5f}; pg8::gemm_phase<pg8::EpiResidT, pg8::StaticOrder, true, true>(lds, g, So, E, tid); }
}


constexpr int LDS_MISC_OFF = 147456 - 64;
DEV Params load_params(const __attribute__((address_space(4))) Params* pp) { Params q;
#pragma unroll
    for (int i = 0; i < 26; ++i) q.in[i] = pp->in[i];
    q.out = pp->out; q.ws = pp->ws; return q; }
#define KARGS() const __attribute__((address_space(4))) Params* pp_ = (const __attribute__((address_space(4))) Params*)__builtin_amdgcn_kernarg_segment_ptr(); asm volatile("" : "+s"(pp_)); const Params p = load_params(pp_)
__global__ void __launch_bounds__(NTHREADS, 2) mk_fwd(Params p_arg) {
    extern __shared__ __attribute__((aligned(16))) unsigned char lds_raw[];
    LAS unsigned char* lds = (LAS unsigned char*)lds_raw;
    volatile LAS unsigned* MISC = (volatile LAS unsigned*)(lds + LDS_MISC_OFF);
    const int wave_s = __builtin_amdgcn_readfirstlane((int)threadIdx.x >> 6);
    if (threadIdx.x < 16) MISC[threadIdx.x] = 0u;
    __syncthreads();
    { KARGS(); (void)xcd_barrier_post((unsigned*)(p.ws + WS_BAR), MISC + 8); }
#define IDS() KARGS(); const int wave = wave_s; const int lane = olane(); const int tid = wave * 64 + lane; const int gw = BIDX * NWAVES + wave, ngw = GDIM * NWAVES; (void)lane; (void)gw; (void)ngw; \
    bf16_t* wt = (bf16_t*)(p.ws + WS_WT); bf16_t* XN = (bf16_t*)(p.ws + WS_XN); bf16_t* P = (bf16_t*)(p.ws + WS_P); bf16_t* H = (bf16_t*)(p.ws + WS_H); (void)wt; (void)XN; (void)P; (void)H; \
    const float* modl = (const float*)(p.ws + WS_MOD) + (size_t)l * NB * MODW; const float* xin = (l == 0) ? p.in[I_X] : p.out; (void)modl; (void)xin;
#define GEMM(A_, lda_, W_, N_, K_, EPI, ...) do { pg8::Gemm g{A_, W_, M, N_, K_, lda_}; pg8::StaticOrder So; So.init(M, N_, (int)GDIM, (int)BIDX); pg8::EPI E{__VA_ARGS__}; \
        pg8::gemm_phase<pg8::EPI, pg8::StaticOrder, true, true>(lds, g, So, E, tid); } while (0)
#define SYNC() do { KARGS(); XcdBarrier bar_; bar_.bar = (unsigned*)(p.ws + WS_BAR); bar_.x = xb_xcc_id(); bar_.st = (volatile LAS unsigned*)(lds + LDS_MISC_OFF) + 8; bar_.lead = (wave_s == 0) && (olane() == 0); xcd_barrier(bar_); } while (0)
#pragma unroll 1
    for (int l = 0; l < NL; ++l) {
        { IDS(); ph_convert(p, l, lds, gw, ngw, wave, lane); if (l == 0) ph_mod(p, lds, tid, wave, lane); }
        SYNC();
        { IDS(); ph_norm(xin, p.in[I_N1] + (size_t)l * D, modl, 0, 1, XN, gw, ngw, lane); }
        SYNC();
        { IDS(); GEMM(XN, D, wt + WT_13A / 2, 2 * DFF, D, EpiSwigluT, H); }
        SYNC();
        { IDS(); GEMM(H, DFF, wt + WT_2A / 2, D, DFF, EpiResidT, xin, p.out, modl + 2 * D, 0.5f); }
        SYNC();
        { IDS(); ph_norm(p.out, p.in[I_NM] + (size_t)l * D, modl, 3, 4, XN, gw, ngw, lane); }
        SYNC();
        { IDS(); GEMM(XN, D, wt + WT_IN / 2, NIN, D, EpiInT, P, (float*)(p.ws + WS_DT), (bf16_t*)(p.ws + WS_HALO)); }
        SYNC();
        { IDS(); ph_conv(p, l, tid); }
        SYNC();
        { IDS(); ph_ssd_state(p, l, lds, tid, wave, lane); __syncthreads(); }
        { IDS(); const int G = GDIM, bid = BIDX; const int vcu = (G % 8 == 0) ? (bid % 8) * (G / 8) + bid / 8 : bid;
          attn_body::sb_attn_phase((char*)lds_raw, (attn_body::bf16*)P, vcu, G, tid); }
        { IDS(); __syncthreads(); ph_diff_table(p, lds, tid); __syncthreads(); const int G = GDIM, bid = BIDX; const int vcu = (G % 8 == 0) ? (bid % 8) * (G / 8) + bid / 8 : bid;
          attn_body::diff_attn_phase<8>((char*)lds_raw, (const attn_body::bf16*)P, (attn_body::bf16*)(p.ws + WS_OD), (const LAS float*)(lds + LDS_TAB_OFF), vcu, G, tid); }
        SYNC();
        { IDS(); ph_ssd_scan(p, tid); }
        SYNC();
        { IDS(); ph_ssd_out(p, l, lds, tid, wave, lane); }
        SYNC();
        { IDS(); ph_mixfinal(p, l, tid); ph_diff_combine(p, l, gw, ngw, lane); }
        SYNC();
        { IDS(); GEMM(P, PW, wt + WT_OUT / 2, D, 2048, EpiResidT, p.out, p.out, modl + 5 * D, 1.0f); }
        SYNC();
        { IDS(); ph_norm(p.out, p.in[I_N2] + (size_t)l * D, modl, 6, 7, XN, gw, ngw, lane); }
        SYNC();
        { IDS(); GEMM(XN, D, wt + WT_13B / 2, 2 * DFF, D, EpiSwigluT, H); }
        SYNC();
        { IDS(); GEMM(H, DFF, wt + WT_2B / 2, D, DFF, EpiResidT, p.out, p.out, modl + 8 * D, 0.5f); }
        SYNC();
    }
    { const int l = 0; IDS(); ph_final_norm(p.out, p.in[I_FN], gw, ngw, lane); }
}

constexpr int LDS_BYTES = 147456;
extern "C" void kernel_launch(void* const* d_in, const int* in_sizes, int n_in, void* d_out, int out_size, void* d_ws, size_t ws_size, hipStream_t stream) {
    static int grid = 0;
    if (grid == 0) {
        if (n_in != 26 || out_size != M * D || ws_size < WS_END) { fprintf(stderr, "kernel_launch: unexpected shapes (n_in %d out %d ws %zu)\n", n_in, out_size, ws_size); grid = -1; return; }
        int dev = 0, cus = 0;
        if (hipGetDevice(&dev) != hipSuccess || hipDeviceGetAttribute(&cus, hipDeviceAttributeMultiprocessorCount, dev) != hipSuccess) { grid = -1; return; }
        if (hipFuncSetAttribute((const void*)mk_fwd, hipFuncAttributeMaxDynamicSharedMemorySize, LDS_BYTES) != hipSuccess) { grid = -1; return; }
#define SETATTR(ST) if (hipFuncSetAttribute((const void*)mk_phase<ST>, hipFuncAttributeMaxDynamicSharedMemorySize, LDS_BYTES) != hipSuccess) { grid = -1; return; }
        SETATTR(0) SETATTR(1) SETATTR(2) SETATTR(3) SETATTR(4) SETATTR(5) SETATTR(6) SETATTR(7) SETATTR(8) SETATTR(9) SETATTR(10) SETATTR(11) SETATTR(12) SETATTR(13) SETATTR(14) SETATTR(15) SETATTR(16) SETATTR(17)
        grid = cus;
    }
    if (grid < 0) return;
    Params p{};
    for (int i = 0; i < 26; ++i) p.in[i] = (const float*)d_in[i];
    p.out = (float*)d_out; p.ws = (unsigned char*)d_ws;
#if MK_FUSED
    (void)hipMemsetAsync((char*)d_ws + WS_BAR, 0, 64 * KiB, stream);
    hipLaunchKernelGGL(mk_fwd, dim3(grid), dim3(NTHREADS), LDS_BYTES, stream, p);
#else
#define LAUNCH(ST, l) hipLaunchKernelGGL(mk_phase<ST>, dim3(grid), dim3(NTHREADS), LDS_BYTES, stream, p, l)
    for (int l = 0; l < NL; ++l) {
        LAUNCH(0, l); LAUNCH(1, l); LAUNCH(2, l); LAUNCH(3, l); LAUNCH(4, l); LAUNCH(5, l); LAUNCH(6, l); LAUNCH(7, l); LAUNCH(16, l);
        LAUNCH(8, l); LAUNCH(9, l); LAUNCH(10, l); LAUNCH(11, l); LAUNCH(12, l); LAUNCH(13, l); LAUNCH(14, l);
    }
    LAUNCH(15, 0);
#endif
}
```

```cpp
#include <hip/hip_runtime.h>
#include <cstdio>
#include <cstdint>
#include <cmath>

#define DEV __device__ __forceinline__
#define LAS __attribute__((address_space(3)))
typedef unsigned short bf16_t;
typedef unsigned u32x4 __attribute__((ext_vector_type(4)));
typedef unsigned u32x2 __attribute__((ext_vector_type(2)));
typedef float f32x4 __attribute__((ext_vector_type(4)));

constexpr int D = 1024, NB = 4, S = 4096, M = NB * S, NL = 2, DFF = 2816, MODW = 9 * D;
constexpr int PW = 5632, NIN = 5888;
constexpr int PZ = 0, PSQ = 1024, PDQ = 1536, PSK = 2048, PSV = 2560, PDK = 3072, PDV = 3584, PXBC = 4096;
constexpr int PXS = PXBC, PBM = PXBC + 1024, PCM = PXBC + 1280;
constexpr int CH = 128, NCHUNK = S / CH, GCH = NB * NCHUNK;
constexpr float EPS = 1e-6f;
constexpr int NTHREADS = 512, NWAVES = 8;

constexpr size_t KiB = 1024, MiB = 1024 * 1024;
constexpr size_t WS_BAR = 0;
constexpr size_t WS_MOD = 64 * KiB;
constexpr size_t WS_ROWSS = 352 * KiB;
constexpr size_t WS_CD = 480 * KiB;
constexpr size_t WS_MISC = 488 * KiB;
constexpr size_t WS_HALO = 512 * KiB;
constexpr size_t WS_WT = 2 * MiB;
constexpr size_t WT_13A = 0, WT_2A = 11 * MiB, WT_IN = 16 * MiB + 512 * KiB, WT_OUT = 28 * MiB, WT_13B = 32 * MiB, WT_2B = 43 * MiB;
constexpr size_t WS_XN = 51 * MiB;
constexpr size_t WS_ST = 51 * MiB;
constexpr size_t WS_P = 115 * MiB;
constexpr size_t WS_H = WS_P;
constexpr size_t WS_DT = 291 * MiB;
constexpr size_t WS_OD = 292 * MiB;
constexpr size_t WS_END = 324 * MiB;

struct Params { const float* in[26]; float* out; unsigned char* ws; };
enum { I_X = 0, I_C, I_ADAW, I_ADAB, I_N1, I_W13A, I_W2A, I_NM, I_WIN, I_CW, I_CB, I_DTB, I_ALOG, I_SD, I_SN, I_LQ1, I_LK1, I_LQ2, I_LK2, I_SUB, I_RB, I_WOUT, I_N2, I_W13B, I_W2B, I_FN };

DEV float bf2f(bf16_t v) { return __uint_as_float(((unsigned)v) << 16); }
DEV float bflo(unsigned w) { return __uint_as_float(w << 16); }
DEV float bfhi(unsigned w) { return __uint_as_float(w & 0xffff0000u); }
DEV unsigned f2bf(float f) { unsigned u = __float_as_uint(f); return (u + 0x7fffu + ((u >> 16) & 1u)) >> 16; }
DEV unsigned pk2(float lo, float hi) { return f2bf(lo) | (f2bf(hi) << 16); }
DEV float siluf(float x) { return x / (1.f + __expf(-x)); }
DEV float softplusf(float x) { return fmaxf(x, 0.f) + __logf(1.f + __expf(-fabsf(x))); }
DEV float lane_get(float v, int src) { return __int_as_float(__builtin_amdgcn_ds_bpermute(src << 2, __float_as_int(v))); }
DEV float wave_sum(float v, int lane) {
#pragma unroll
    for (int o = 1; o < 64; o <<= 1) v += lane_get(v, lane ^ o);
    return v;
}
DEV float wave_max(float v, int lane) {
#pragma unroll
    for (int o = 1; o < 64; o <<= 1) v = fmaxf(v, lane_get(v, lane ^ o));
    return v;
}
DEV float wave_incl_scan(float v, int lane) {
#pragma unroll
    for (int o = 1; o < 64; o <<= 1) { float t = lane_get(v, lane - o); if (lane >= o) v += t; }
    return v;
}
#define BIDX obid()
#define GDIM ((int)gridDim.x)
#define LDS_WAIT() asm volatile("s_waitcnt lgkmcnt(0)" ::: "memory")
DEV float lambda_init_of(int l) { return l == 0 ? 0.2f : 0.35550906759097f; }
DEV int olane() { int l; asm volatile("v_mbcnt_lo_u32_b32 %0, -1, 0\n\tv_mbcnt_hi_u32_b32 %0, -1, %0" : "=v"(l)); return l; }
DEV int obid() { int b = blockIdx.x; asm volatile("" : "+s"(b)); return b; }

DEV void transpose_item(const float* W, int K, int N, bf16_t* WT, int dst_n0, int src_n0, int nvalid, int k0, LAS float* scr, int lane) {
    const int c = lane & 31;
#pragma unroll 8
    for (int i = 0; i < 32; ++i) { const int kk = 2 * i + (lane >> 5); scr[kk * 33 + c] = (c < nvalid) ? W[(size_t)(k0 + kk) * N + src_n0 + c] : 0.f; }
    LDS_WAIT();
    const int c8 = lane & 7;
#pragma unroll
    for (int j = 0; j < 4; ++j) { const int n = (lane >> 3) + 8 * j; const LAS float* s = scr + (8 * c8) * 33 + n;
        u32x4 o; o.x = pk2(s[0 * 33], s[1 * 33]); o.y = pk2(s[2 * 33], s[3 * 33]); o.z = pk2(s[4 * 33], s[5 * 33]); o.w = pk2(s[6 * 33], s[7 * 33]);
        *(u32x4*)(WT + (size_t)(dst_n0 + n) * K + k0 + 8 * c8) = o; }
    LDS_WAIT();
}
DEV void src_map_swiglu(int n0, int& src, int& nv) { const int pn = n0 >> 8, bj = (n0 >> 7) & 1, i0 = n0 & 127; src = bj * DFF + pn * 128 + i0; nv = 32; }
DEV void src_map_in(int n0, int& src, int& nv) {
    nv = 32;
    if (n0 < 1024) src = n0;
    else if (n0 < 1536) src = 2576 + (n0 - 1024);
    else if (n0 < 2048) src = 4112 + (n0 - 1536);
    else if (n0 < 2560) src = 3088 + (n0 - 2048);
    else if (n0 < 3072) src = 3600 + (n0 - 2560);
    else if (n0 < 3584) src = 4624 + (n0 - 3072);
    else if (n0 < 4096) src = 5136 + (n0 - 3584);
    else if (n0 < 5632) src = 1024 + (n0 - 4096);
    else if (n0 == 5632) { src = 2560; nv = 16; }
    else { src = 0; nv = 0; }
}
DEV void ph_convert(const Params& p, int l, LAS unsigned char* lds, int gw, int ngw, int wave, int lane) {
    LAS float* scr = (LAS float*)(lds + wave * 16384);
    bf16_t* wt = (bf16_t*)(p.ws + WS_WT);
    constexpr int I13 = 16 * 176, I2 = 44 * 32, IIN = 16 * 184, IOUT = 32 * 32;
    constexpr int NITEMS = 2 * I13 + 2 * I2 + IIN + IOUT;
    for (int it = gw; it < NITEMS; it += ngw) {
        int r = it;
        if (r < 2 * I13) { const int which = r / I13; r %= I13; const int kb = r / 176, nb = r % 176; int src, nv; src_map_swiglu(nb * 32, src, nv);
            transpose_item(p.in[which ? I_W13B : I_W13A] + (size_t)l * D * 2 * DFF, D, 2 * DFF, wt + (which ? WT_13B : WT_13A) / 2, nb * 32, src, nv, kb * 64, scr, lane); continue; }
        r -= 2 * I13;
        if (r < 2 * I2) { const int which = r / I2; r %= I2; const int kb = r / 32, nb = r % 32;
            transpose_item(p.in[which ? I_W2B : I_W2A] + (size_t)l * DFF * D, DFF, D, wt + (which ? WT_2B : WT_2A) / 2, nb * 32, nb * 32, 32, kb * 64, scr, lane); continue; }
        r -= 2 * I2;
        if (r < IIN) { const int kb = r / 184, nb = r % 184; int src, nv; src_map_in(nb * 32, src, nv);
            transpose_item(p.in[I_WIN] + (size_t)l * D * 5648, D, 5648, wt + WT_IN / 2, nb * 32, src, nv, kb * 64, scr, lane); continue; }
        r -= IIN;
        { const int kb = r / 32, nb = r % 32;
            transpose_item(p.in[I_WOUT] + (size_t)l * 2048 * D, 2048, D, wt + WT_OUT / 2, nb * 32, nb * 32, 32, kb * 64, scr, lane); }
    }
}

DEV void ph_mod(const Params& p, LAS unsigned char* lds, int tid, int wave, int lane) {
    LAS float* cond = (LAS float*)lds;
    LAS float* part = (LAS float*)(lds + 16384);
    __syncthreads();
    for (int i = tid; i < NB * D; i += NTHREADS) cond[i] = siluf(p.in[I_C][i]);
    __syncthreads();
    float* mod = (float*)(p.ws + WS_MOD);
    for (int unit = BIDX; unit < NL * 144; unit += GDIM) {
        const int l = unit / 144, j = (unit % 144) * 64 + lane;
        const float* w = p.in[I_ADAW] + (size_t)l * D * MODW + j;
        float a0 = 0.f, a1 = 0.f, a2 = 0.f, a3 = 0.f;
        for (int k = wave * 128; k < wave * 128 + 128; ++k) { const float wv = w[(size_t)k * MODW]; a0 += cond[k] * wv; a1 += cond[D + k] * wv; a2 += cond[2 * D + k] * wv; a3 += cond[3 * D + k] * wv; }
        part[(wave * 4 + 0) * 64 + lane] = a0; part[(wave * 4 + 1) * 64 + lane] = a1; part[(wave * 4 + 2) * 64 + lane] = a2; part[(wave * 4 + 3) * 64 + lane] = a3;
        __syncthreads();
        if (wave < 4) { float s = 0.f;
#pragma unroll
            for (int w8 = 0; w8 < 8; ++w8) s += part[(w8 * 4 + wave) * 64 + lane];
            mod[((size_t)l * NB + wave) * MODW + j] = s + p.in[I_ADAB][(size_t)l * MODW + j]; }
        __syncthreads();
    }
    if (BIDX == 0) {
        float* misc = (float*)(p.ws + WS_MISC);
        if (wave < NL) { int l = wave; asm volatile("" : "+s"(l));
            const float s1 = wave_sum(p.in[I_LQ1][l * 64 + lane] * p.in[I_LK1][l * 64 + lane], lane);
            const float s2 = wave_sum(p.in[I_LQ2][l * 64 + lane] * p.in[I_LK2][l * 64 + lane], lane);
            const float linit = lambda_init_of(l);
            if (lane == 0) misc[l] = expf(s1) - expf(s2) + linit; }
        if (tid < 512) { const int h = tid >> 7, d = tid & 127; int bk;
            if (d < 16) bk = d; else { bk = 16 + (int)(logf((float)d / 16.f) / logf(8.f) * 16.f); if (bk > 31) bk = 31; }
            misc[64 + h * 128 + d] = p.in[I_RB][bk * 4 + h]; }
    }
}

DEV void ph_norm(const float* xsrc, const float* g, const float* modl, int ishift, int iscale, bf16_t* XN, int gw, int ngw, int lane) {
    for (int m = gw; m < M; m += ngw) {
        const int b = m / S; const float* xr = xsrc + (size_t)m * D;
        f32x4 v[4]; float ss = 0.f;
#pragma unroll
        for (int j = 0; j < 4; ++j) { v[j] = *(const f32x4*)(xr + 4 * lane + 256 * j); ss += (v[j].x * v[j].x + v[j].y * v[j].y) + (v[j].z * v[j].z + v[j].w * v[j].w); }
        const float rstd = rsqrtf(wave_sum(ss, lane) * (1.f / D) + EPS);
        const float* sh = modl + (size_t)b * MODW + ishift * D; const float* sc = modl + (size_t)b * MODW + iscale * D;
#pragma unroll
        for (int j = 0; j < 4; ++j) { const int c = 4 * lane + 256 * j; const f32x4 gg = *(const f32x4*)(g + c), s1 = *(const f32x4*)(sc + c), s0 = *(const f32x4*)(sh + c);
            const f32x4 o = v[j] * rstd * gg * (s1 + 1.f) + s0; u32x2 w; w.x = pk2(o.x, o.y); w.y = pk2(o.z, o.w); *(u32x2*)(XN + (size_t)m * D + c) = w; }
    }
}
DEV void ph_final_norm(float* x, const float* g, int gw, int ngw, int lane) {
    for (int m = gw; m < M; m += ngw) {
        float* xr = x + (size_t)m * D; f32x4 v[4]; float ss = 0.f;
#pragma unroll
        for (int j = 0; j < 4; ++j) { v[j] = *(const f32x4*)(xr + 4 * lane + 256 * j); ss += (v[j].x * v[j].x + v[j].y * v[j].y) + (v[j].z * v[j].z + v[j].w * v[j].w); }
        const float rstd = rsqrtf(wave_sum(ss, lane) * (1.f / D) + EPS);
#pragma unroll
        for (int j = 0; j < 4; ++j) { const int c = 4 * lane + 256 * j; const f32x4 gg = *(const f32x4*)(g + c); *(f32x4*)(xr + c) = v[j] * rstd * gg; }
    }
}

struct EpiSwiglu { bf16_t* H;
    DEV void elem2(int row, int j, float a, float u) const { H[(size_t)row * DFF + j] = (bf16_t)f2bf(siluf(a) * u); } };
struct EpiResid { const float* xsrc; float* out; const float* gate; float f;
    DEV void elem(int row, int col, float v) const { const int b = row / S; const size_t o = (size_t)row * D + col; out[o] = xsrc[o] + f * gate[(size_t)b * MODW + col] * v; } };
struct EpiIn { bf16_t* P; float* DT; bf16_t* HALO;
    DEV void elem(int row, int col, float v) const {
        if (col < PW) { const bf16_t h = (bf16_t)f2bf(v); P[(size_t)row * PW + col] = h;
            if (col >= PXBC) { const int r = row & 127; if (r >= 125) HALO[((size_t)((row >> 7) + 1) * 3 + (r - 125)) * 1536 + (col - PXBC)] = h; } }
        else if (col < PW + 16) DT[(size_t)row * 16 + (col - PW)] = v; } };

template <bool SW, class Epi>
DEV void gemm_naive(const bf16_t* A, int lda, const bf16_t* Bt, int Ndest, int K, const Epi& E, LAS unsigned char* lds, int tid) {
    LAS float* As = (LAS float*)lds;
    LAS float* Bs = (LAS float*)(lds + 128 * 33 * 4);
    LAS float* Bs2 = (LAS float*)(lds + 192 * 33 * 4);
    const int ntn = SW ? (Ndest / 256) * 2 : Ndest / 64;
    const int ntiles = (M / 128) * ntn;
    const int ty = tid >> 4, tx = tid & 15;
    for (int tile = BIDX; tile < ntiles; tile += GDIM) {
        const int tm = tile / ntn, tn = tile % ntn;
        const int m0 = tm * 128;
        const int n0 = SW ? (tn >> 1) * 256 + (tn & 1) * 64 : tn * 64;
        float acc[4][4], acc2[4][4];
#pragma unroll
        for (int i = 0; i < 4; ++i)
#pragma unroll
            for (int j = 0; j < 4; ++j) { acc[i][j] = 0.f; acc2[i][j] = 0.f; }
        for (int k0 = 0; k0 < K; k0 += 32) {
            { const int row = tid >> 2, kc = (tid & 3) * 8; const u32x4 v = *(const u32x4*)(A + (size_t)(m0 + row) * lda + k0 + kc); LAS float* d = As + row * 33 + kc;
              d[0] = bflo(v.x); d[1] = bfhi(v.x); d[2] = bflo(v.y); d[3] = bfhi(v.y); d[4] = bflo(v.z); d[5] = bfhi(v.z); d[6] = bflo(v.w); d[7] = bfhi(v.w); }
            if (tid < 256) { const int row = tid >> 2, kc = (tid & 3) * 8; const u32x4 v = *(const u32x4*)(Bt + (size_t)(n0 + row) * K + k0 + kc); LAS float* d = Bs + row * 33 + kc;
              d[0] = bflo(v.x); d[1] = bfhi(v.x); d[2] = bflo(v.y); d[3] = bfhi(v.y); d[4] = bflo(v.z); d[5] = bfhi(v.z); d[6] = bflo(v.w); d[7] = bfhi(v.w); }
            else if (SW) { const int t2 = tid - 256; const int row = t2 >> 2, kc = (t2 & 3) * 8; const u32x4 v = *(const u32x4*)(Bt + (size_t)(n0 + 128 + row) * K + k0 + kc); LAS float* d = Bs2 + row * 33 + kc;
              d[0] = bflo(v.x); d[1] = bfhi(v.x); d[2] = bflo(v.y); d[3] = bfhi(v.y); d[4] = bflo(v.z); d[5] = bfhi(v.z); d[6] = bflo(v.w); d[7] = bfhi(v.w); }
            __syncthreads();
#pragma unroll 8
            for (int kk = 0; kk < 32; ++kk) {
                float a[4], b[4], b2[4];
#pragma unroll
                for (int i = 0; i < 4; ++i) a[i] = As[(ty * 4 + i) * 33 + kk];
#pragma unroll
                for (int j = 0; j < 4; ++j) { b[j] = Bs[(tx * 4 + j) * 33 + kk]; if (SW) b2[j] = Bs2[(tx * 4 + j) * 33 + kk]; }
#pragma unroll
                for (int i = 0; i < 4; ++i)
#pragma unroll
                    for (int j = 0; j < 4; ++j) { acc[i][j] += a[i] * b[j]; if (SW) acc2[i][j] += a[i] * b2[j]; }
            }
            __syncthreads();
        }
#pragma unroll
        for (int i = 0; i < 4; ++i)
#pragma unroll
            for (int j = 0; j < 4; ++j) {
                if constexpr (SW) E.elem2(m0 + ty * 4 + i, (tn >> 1) * 128 + (tn & 1) * 64 + tx * 4 + j, acc[i][j], acc2[i][j]);
                else E.elem(m0 + ty * 4 + i, n0 + tx * 4 + j, acc[i][j]);
            }
    }
}

namespace pg8 {
#define PG8_LAS __attribute__((address_space(3)))
typedef unsigned short bf16_t;
typedef short bf16x8 __attribute__((ext_vector_type(8)));
typedef float f32x4 __attribute__((ext_vector_type(4)));
typedef unsigned u32x4 __attribute__((ext_vector_type(4)));
constexpr int BM = 256, BK = 64, HALF = 128, HTB = HALF * BK * 2  , STAGE_BYTES = 8 * HTB, NXCD = 8, WGM = 8;

__host__ __device__ __forceinline__ int lds_byte(int r, int c) { const int st = (r >> 4) * 2 + (c >> 5), rr = r & 15, cc = c & 31, ob = rr * 64 + cc * 2; return st * 1024 + (ob ^ (((ob >> 9) & 1) << 5)); }
__host__ __device__ __forceinline__ void stage_rc(int b, int& R, int& C) { const int st = b / 1024, sb = b % 1024, swz = sb ^ (((sb >> 9) & 1) << 5); R = (st >> 1) * 16 + swz / 64; C = (st & 1) * 32 + (swz % 64) / 2; }
__host__ __device__ __forceinline__ int perm32(int rho) { const int n = rho >> 4, i = rho & 15; return 8 * (i >> 2) + 4 * n + (i & 3); }

struct Unit { int pm, pn; };
struct Gemm { const bf16_t* A; const bf16_t* Bt; int M, N, K, lda; };

struct StaticOrder {
    int nM, nN, nwg, G, c;
    __host__ __device__ void init(int M, int N, int G_, int c_) { nM = M / BM; nN = N / BM; nwg = nM * nN; G = G_; c = c_; }
    __host__ __device__ bool next(int i, Unit& u) const {
        const long L = (long)i * G + c; if (L >= nwg) return false;
        int wgid = (int)L; { const int q = nwg / NXCD, r = nwg % NXCD, xcd = wgid % NXCD, off = wgid / NXCD; wgid = (xcd < r ? xcd * (q + 1) : r * (q + 1) + (xcd - r) * q) + off; }
        const int nig = WGM * nN, gid = wgid / nig, fm = gid * WGM, gsz = (nM - fm) < WGM ? (nM - fm) : WGM;
        u.pm = fm + ((wgid % nig) % gsz); u.pn = (wgid % nig) / gsz; return true;
    }
    __device__ __forceinline__ void a_ready(const Unit&) const {}
    __device__ __forceinline__ void done(const Unit&) const {}
};
__device__ __forceinline__ unsigned cvt_pk_bf16(float lo, float hi) { unsigned r; asm volatile("v_cvt_pk_bf16_f32 %0, %1, %2" : "=v"(r) : "v"(lo), "v"(hi)); return r; }

__device__ __forceinline__ float silu1(float x) { return x * __builtin_amdgcn_rcpf(1.f + __expf(-x)); }
struct EpiSwigluT { static constexpr bool PERM = true, AFTER_DRAIN = false; bf16_t* H;
    __device__ __forceinline__ void operator()(const f32x4 (&acc)[2][2][4][2], const Unit& u, int wr, int wc, int fr, int fq) const {
        const int row0 = u.pm * BM + wr * 64 + fr, col0 = u.pn * HALF + wc * 32 + 8 * fq;
#pragma unroll
        for (int ai = 0; ai < 2; ++ai)
#pragma unroll
            for (int m = 0; m < 4; ++m) { bf16_t* rowp = H + (size_t)(row0 + ai * HALF + m * 16) * 2816 + col0;
                const f32x4 a0 = acc[ai][0][m][0], a1 = acc[ai][0][m][1], u0 = acc[ai][1][m][0], u1 = acc[ai][1][m][1]; u32x4 w;
                w.x = cvt_pk_bf16(silu1(a0[0]) * u0[0], silu1(a0[1]) * u0[1]); w.y = cvt_pk_bf16(silu1(a0[2]) * u0[2], silu1(a0[3]) * u0[3]);
                w.z = cvt_pk_bf16(silu1(a1[0]) * u1[0], silu1(a1[1]) * u1[1]); w.w = cvt_pk_bf16(silu1(a1[2]) * u1[2], silu1(a1[3]) * u1[3]);
                *(u32x4*)rowp = w; }
    }
};
struct EpiResidT { static constexpr bool PERM = false, AFTER_DRAIN = false; const float* xsrc; float* out; const float* gate; float f;
    __device__ __forceinline__ void operator()(const f32x4 (&acc)[2][2][4][2], const Unit& u, int wr, int wc, int fr, int fq) const {
        const int row0 = u.pm * BM + wr * 64 + fr, col0 = u.pn * BM + wc * 32 + 4 * fq; const int b = (u.pm * BM) / 4096;
#pragma unroll
        for (int bj = 0; bj < 2; ++bj)
#pragma unroll
            for (int n = 0; n < 2; ++n) { const int c = col0 + bj * HALF + n * 16; const f32x4 gv = *(const f32x4*)(gate + (size_t)b * 9216 + c) * f;
#pragma unroll
                for (int ai = 0; ai < 2; ++ai)
#pragma unroll
                    for (int m = 0; m < 4; ++m) { const size_t off = (size_t)(row0 + ai * HALF + m * 16) * 1024 + c; *(f32x4*)(out + off) = *(const f32x4*)(xsrc + off) + gv * acc[ai][bj][m][n]; } }
    }
};
struct EpiInT { static constexpr bool PERM = true, AFTER_DRAIN = false; bf16_t* P; float* DT; bf16_t* HALO;
    __device__ __forceinline__ void operator()(const f32x4 (&acc)[2][2][4][2], const Unit& u, int wr, int wc, int fr, int fq) const {
        const int row0 = u.pm * BM + wr * 64 + fr;
        if (u.pn < 22) { const int col0 = u.pn * BM + wc * 32 + 8 * fq; const float qs = (u.pn >= 4 && u.pn <= 7) ? 0.125f * 1.4426950408889634f : 1.f;
#pragma unroll
            for (int ai = 0; ai < 2; ++ai)
#pragma unroll
                for (int m = 0; m < 4; ++m) { const int row = row0 + ai * HALF + m * 16;
#pragma unroll
                    for (int bj = 0; bj < 2; ++bj) { const f32x4 v0 = acc[ai][bj][m][0] * qs, v1 = acc[ai][bj][m][1] * qs; u32x4 w;
                        w.x = cvt_pk_bf16(v0[0], v0[1]); w.y = cvt_pk_bf16(v0[2], v0[3]); w.z = cvt_pk_bf16(v1[0], v1[1]); w.w = cvt_pk_bf16(v1[2], v1[3]);
                        *(u32x4*)(P + (size_t)row * 5632 + col0 + bj * HALF) = w;
                        if (m == 3 && u.pn >= 16 && wr == 1 && fr >= 13) *(u32x4*)(HALO + ((size_t)((row >> 7) + 1) * 3 + (fr - 13)) * 1536 + (col0 + bj * HALF - 4096)) = w; } }
        } else if (wc == 0 && fq < 2) {
#pragma unroll
            for (int ai = 0; ai < 2; ++ai)
#pragma unroll
                for (int m = 0; m < 4; ++m) { const int row = row0 + ai * HALF + m * 16;
#pragma unroll
                    for (int n = 0; n < 2; ++n) *(f32x4*)(DT + (size_t)row * 16 + 8 * fq + 4 * n) = acc[ai][0][m][n]; }
        }
    }
};

template <class Epi, class Sched, bool ALIGN_EPI = false, bool SP2 = false>
__device__ __forceinline__ void gemm_phase(PG8_LAS unsigned char* lds, const Gemm g, const Sched& S, const Epi& E, const int tid) {
    const int wid = __builtin_amdgcn_readfirstlane(tid >> 6), lane = tid & 63, wr = wid >> 2, wc = wid & 3, fr = lane & 15, fq = lane >> 4;
    const int K = g.K, nt = K / BK;
    unsigned voffA[2], voffB[2];
#pragma unroll
    for (int i = 0; i < 2; ++i) { int R, C; stage_rc(tid * 16 + i * 8192, R, C); const int Rb = Epi::PERM ? ((R & ~31) + perm32(R & 31)) : R;
        voffA[i] = (unsigned)(R * g.lda + C) * 2u; voffB[i] = (unsigned)(Rb * K + C) * 2u; }
    const size_t kstep = (size_t)(BK * 2);
    const size_t hstep = (size_t)HALF * K * 2, hstepA = (size_t)HALF * g.lda * 2;
    const size_t tstep = 2 * hstep, tstepA = 2 * hstepA;
    const unsigned ldsw = (unsigned)wid * 1024u;
    const int aoff = lds_byte(wr * 64 + fr, fq * 8), boff = lds_byte(wc * 32 + fr, fq * 8);
#define PG8_SA(b, h) (((b) * 2 + (h)) * HTB)
#define PG8_SB(b, h) ((4 + (b) * 2 + (h)) * HTB)
#define PG8_STAGE(bufoff, gbase, voff) do { _Pragma("unroll") for (int _i = 0; _i < 2; ++_i) \
        __builtin_amdgcn_global_load_lds((const unsigned*)((const char*)(gbase) + (voff)[_i]), (PG8_LAS unsigned*)(lds + (bufoff) + ldsw + _i * 8192), 16, 0, 0); } while (0)
#define PG8_LDA(dst, b, h) do { _Pragma("unroll") for (int m = 0; m < 4; ++m) _Pragma("unroll") for (int k = 0; k < 2; ++k) dst[m][k] = *(const PG8_LAS bf16x8*)(lds + PG8_SA(b, h) + aoff + m * 2048 + k * 1024); } while (0)
#define PG8_LDB(dst, b, h) do { _Pragma("unroll") for (int n = 0; n < 2; ++n) _Pragma("unroll") for (int k = 0; k < 2; ++k) dst[n][k] = *(const PG8_LAS bf16x8*)(lds + PG8_SB(b, h) + boff + n * 2048 + k * 1024); } while (0)
#define PG8_MMA(ai, bj, At, Bt) do { __builtin_amdgcn_s_setprio(1); _Pragma("unroll") for (int m = 0; m < 4; ++m) _Pragma("unroll") for (int n = 0; n < 2; ++n) _Pragma("unroll") for (int k = 0; k < 2; ++k) \
        acc[ai][bj][m][n] = __builtin_amdgcn_mfma_f32_16x16x32_bf16(Bt[n][k], At[m][k], acc[ai][bj][m][n], 0, 0, 0); __builtin_amdgcn_s_setprio(0); } while (0)
#define PG8_WAIT_V(n) asm volatile("s_waitcnt vmcnt(" #n ")" ::: "memory")
#define PG8_WAIT_L(n) asm volatile("s_waitcnt lgkmcnt(" #n ")" ::: "memory")
#define PG8_BAR __builtin_amdgcn_s_barrier()
#define PG8_SCHED __builtin_amdgcn_sched_barrier(0)
    Unit cur, nxt; int ui = 0;
    if (!S.next(0, cur)) return;
    f32x4 acc[2][2][4][2];
#pragma unroll
    for (int a = 0; a < 2; ++a)
#pragma unroll
        for (int b = 0; b < 2; ++b)
#pragma unroll
            for (int m = 0; m < 4; ++m)
#pragma unroll
                for (int n = 0; n < 2; ++n) acc[a][b][m][n] = (f32x4){0.f, 0.f, 0.f, 0.f};
    bf16x8 At[4][2], B0[2][2], B1[2][2];
    const char* cA = (const char*)g.A + (size_t)cur.pm * tstepA; const char* cB = (const char*)g.Bt + (size_t)cur.pn * tstep;
    S.a_ready(cur);
    if constexpr (SP2) {
        PG8_STAGE(PG8_SB(0, 0), cB, voffB); PG8_STAGE(PG8_SB(0, 1), cB + hstep, voffB); PG8_STAGE(PG8_SA(0, 0), cA, voffA); PG8_STAGE(PG8_SA(0, 1), cA + hstepA, voffA);
        if (wr == 1) PG8_BAR;
        PG8_WAIT_V(2); PG8_BAR;
        PG8_STAGE(PG8_SB(1, 0), cB + kstep, voffB); PG8_STAGE(PG8_SA(1, 0), cA + kstep, voffA); PG8_STAGE(PG8_SB(1, 1), cB + hstep + kstep, voffB);
        PG8_WAIT_V(6); PG8_BAR;
    } else {
        PG8_STAGE(PG8_SB(0, 0), cB, voffB); PG8_STAGE(PG8_SA(0, 0), cA, voffA); PG8_STAGE(PG8_SB(0, 1), cB + hstep, voffB); PG8_STAGE(PG8_SA(0, 1), cA + hstepA, voffA);
        if (wr == 1) PG8_BAR;
        PG8_WAIT_V(4); PG8_BAR;
        PG8_STAGE(PG8_SB(1, 0), cB + kstep, voffB); PG8_STAGE(PG8_SA(1, 0), cA + kstep, voffA); PG8_STAGE(PG8_SB(1, 1), cB + hstep + kstep, voffB);
        PG8_WAIT_V(6); PG8_BAR;
    }
    for (;;) {
        const bool has_next = S.next(ui + 1, nxt);
        const char* nA = has_next ? (const char*)g.A + (size_t)nxt.pm * tstepA : cA; const char* nB = has_next ? (const char*)g.Bt + (size_t)nxt.pn * tstep : cB;
        for (int t = 0; t < nt; t += 2) {
            const bool last = (t == nt - 2);
            const char* a1 = cA + (size_t)(t + 1) * kstep;
            const char* a2 = last ? nA : cA + (size_t)(t + 2) * kstep; const char* b2 = last ? nB : cB + (size_t)(t + 2) * kstep;
            const char* a3 = a2 + kstep; const char* b3 = b2 + kstep;
            if (last && has_next) S.a_ready(nxt);
            if constexpr (SP2) {
            PG8_LDB(B0, 0, 0); PG8_LDB(B1, 0, 1); PG8_SCHED; PG8_LDA(At, 0, 0); PG8_STAGE(PG8_SA(1, 1), a1 + hstepA, voffA);
            PG8_WAIT_V(8); PG8_WAIT_L(0); PG8_BAR; PG8_MMA(0, 0, At, B0); PG8_MMA(0, 1, At, B1); PG8_BAR; PG8_SCHED;
            PG8_LDA(At, 0, 1); PG8_STAGE(PG8_SB(0, 0), b2, voffB); PG8_STAGE(PG8_SB(0, 1), b2 + hstep, voffB); PG8_STAGE(PG8_SA(0, 0), a2, voffA);
            PG8_WAIT_V(8); PG8_WAIT_L(0); PG8_BAR; PG8_MMA(1, 0, At, B0); PG8_MMA(1, 1, At, B1); PG8_BAR; PG8_SCHED;
            PG8_LDB(B0, 1, 0); PG8_LDB(B1, 1, 1); PG8_SCHED; PG8_LDA(At, 1, 0); PG8_STAGE(PG8_SA(0, 1), a2 + hstepA, voffA);
            PG8_WAIT_V(8); PG8_WAIT_L(0); PG8_BAR; PG8_MMA(0, 0, At, B0); PG8_MMA(0, 1, At, B1); PG8_BAR; PG8_SCHED;
            PG8_LDA(At, 1, 1); PG8_STAGE(PG8_SB(1, 0), b3, voffB); PG8_STAGE(PG8_SB(1, 1), b3 + hstep, voffB); PG8_STAGE(PG8_SA(1, 0), a3, voffA);
            PG8_WAIT_V(8); PG8_WAIT_L(0); PG8_BAR; PG8_MMA(1, 0, At, B0); PG8_MMA(1, 1, At, B1); PG8_BAR; PG8_SCHED;
            } else {
            PG8_LDB(B0, 0, 0); PG8_SCHED; PG8_LDA(At, 0, 0); PG8_STAGE(PG8_SA(1, 1), a1 + hstepA, voffA);
            PG8_WAIT_L(8); PG8_BAR; PG8_WAIT_L(0); PG8_MMA(0, 0, At, B0); PG8_BAR; PG8_SCHED;
            PG8_LDB(B1, 0, 1); PG8_STAGE(PG8_SB(0, 0), b2, voffB);
            PG8_BAR; PG8_WAIT_L(0); PG8_MMA(0, 1, At, B1); PG8_BAR;
            PG8_LDA(At, 0, 1); PG8_STAGE(PG8_SA(0, 0), a2, voffA);
            PG8_BAR; PG8_WAIT_L(0); PG8_MMA(1, 0, At, B0); PG8_BAR; PG8_SCHED;
            PG8_STAGE(PG8_SB(0, 1), b2 + hstep, voffB);
            PG8_WAIT_V(6); PG8_BAR; PG8_MMA(1, 1, At, B1); PG8_BAR;
            PG8_LDB(B0, 1, 0); PG8_SCHED; PG8_LDA(At, 1, 0); PG8_STAGE(PG8_SA(0, 1), a2 + hstepA, voffA);
            PG8_WAIT_L(8); PG8_BAR; PG8_WAIT_L(0); PG8_MMA(0, 0, At, B0); PG8_BAR; PG8_SCHED;
            PG8_LDB(B1, 1, 1); PG8_STAGE(PG8_SB(1, 0), b3, voffB);
            PG8_BAR; PG8_WAIT_L(0); PG8_MMA(0, 1, At, B1); PG8_BAR;
            PG8_LDA(At, 1, 1); PG8_STAGE(PG8_SA(1, 0), a3, voffA);
            PG8_BAR; PG8_WAIT_L(0); PG8_MMA(1, 0, At, B0); PG8_BAR; PG8_SCHED;
            PG8_STAGE(PG8_SB(1, 1), b3 + hstep, voffB);
            PG8_WAIT_V(6); PG8_BAR; PG8_MMA(1, 1, At, B1); PG8_BAR;
            }
        }
        if constexpr (ALIGN_EPI) { if (wr == 0) PG8_BAR; }
        if constexpr (!Epi::AFTER_DRAIN) { E(acc, cur, wr, wc, fr, fq); S.done(cur); }
        if (!has_next) break;
#pragma unroll
        for (int a = 0; a < 2; ++a)
#pragma unroll
            for (int b = 0; b < 2; ++b)
#pragma unroll
                for (int m = 0; m < 4; ++m)
#pragma unroll
                    for (int n = 0; n < 2; ++n) acc[a][b][m][n] = (f32x4){0.f, 0.f, 0.f, 0.f};
        cur = nxt; cA = nA; cB = nB; ++ui;
        if constexpr (ALIGN_EPI) { if (wr == 1) PG8_BAR; }
    }
    PG8_WAIT_V(0);
    if constexpr (!ALIGN_EPI) { if (wr == 0) PG8_BAR; }
    PG8_BAR;
    if constexpr (Epi::AFTER_DRAIN) { E.fused(acc, cur, wr, wc, fr, fq, lds, wid, lane); S.done(cur); }
#undef PG8_SA
#undef PG8_SB
#undef PG8_STAGE
#undef PG8_LDA
#undef PG8_LDB
#undef PG8_MMA
#undef PG8_WAIT_V
#undef PG8_WAIT_L
#undef PG8_BAR
#undef PG8_SCHED
}
}
DEV void ph_conv(const Params& p, int l, int tid) {
    bf16_t* P = (bf16_t*)(p.ws + WS_P); const bf16_t* HALO = (const bf16_t*)(p.ws + WS_HALO);
    const float* cw = p.in[I_CW] + (size_t)l * 1536 * 4; const float* cb = p.in[I_CB] + (size_t)l * 1536;
    for (int task = BIDX * NTHREADS + tid; task < GCH * 768; task += GDIM * NTHREADS) {
        const int gc = task / 768, ch = (task % 768) * 2; const int r0 = gc * CH;
        const f32x4 w0 = *(const f32x4*)(cw + ch * 4), w1 = *(const f32x4*)(cw + ch * 4 + 4); const float b0 = cb[ch], b1 = cb[ch + 1];
        float a3 = 0.f, a2 = 0.f, a1 = 0.f, c3 = 0.f, c2 = 0.f, c1 = 0.f;
        if (gc % NCHUNK != 0) { const bf16_t* hp = HALO + (size_t)gc * 3 * 1536 + ch;
            const unsigned h0 = *(const unsigned*)(hp), h1 = *(const unsigned*)(hp + 1536), h2 = *(const unsigned*)(hp + 2 * 1536);
            a3 = bflo(h0); c3 = bfhi(h0); a2 = bflo(h1); c2 = bfhi(h1); a1 = bflo(h2); c1 = bfhi(h2); }
        unsigned* col = (unsigned*)(P + (size_t)r0 * PW + PXBC + ch);
        for (int i = 0; i < CH; ++i) {
            const unsigned raw = col[(size_t)i * (PW / 2)]; const float a0 = bflo(raw), c0 = bfhi(raw);
            const float ya = b0 + w0.x * a3 + w0.y * a2 + w0.z * a1 + w0.w * a0, yc = b1 + w1.x * c3 + w1.y * c2 + w1.z * c1 + w1.w * c0;
            col[(size_t)i * (PW / 2)] = pk2(siluf(ya), siluf(yc));
            a3 = a2; a2 = a1; a1 = a0; c3 = c2; c2 = c1; c1 = c0;
        }
    }
}

DEV void ssd_head_scalars(const Params& p, int l, int r0, int h, LAS float* s_dt, LAS float* s_ac, int tid, int wave, int lane) {
    const float* DT = (const float*)(p.ws + WS_DT);
    if (tid < CH) { const float dtv = softplusf(DT[(size_t)(r0 + tid) * 16 + h] + p.in[I_DTB][l * 16 + h]); s_dt[tid] = dtv; s_ac[tid] = dtv * (-__expf(p.in[I_ALOG][l * 16 + h])); }
    __syncthreads();
    if (wave == 0) { const float v0 = s_ac[2 * lane], v1 = s_ac[2 * lane + 1]; const float s = v0 + v1; const float inc = wave_incl_scan(s, lane); s_ac[2 * lane] = inc - s + v0; s_ac[2 * lane + 1] = inc; }
    __syncthreads();
}
DEV void ph_ssd_state(const Params& p, int l, LAS unsigned char* lds, int tid, int wave, int lane) {
    LAS bf16_t* Bs = (LAS bf16_t*)lds;
    LAS float* xdd = (LAS float*)(lds + 34816);
    LAS float* s_dt = (LAS float*)(lds + 34816 + 32768);
    LAS float* s_ac = s_dt + 128;
    const bf16_t* P = (const bf16_t*)(p.ws + WS_P); float* ST = (float*)(p.ws + WS_ST); float* CD = (float*)(p.ws + WS_CD);
    for (int unit = BIDX; unit < GCH * 16; unit += GDIM) {
        const int gc = unit >> 4, h = unit & 15, g = h >> 3, r0 = gc * CH;
        __syncthreads();
        ssd_head_scalars(p, l, r0, h, s_dt, s_ac, tid, wave, lane);
        { const int row = tid >> 2, c0 = (tid & 3) * 32; const bf16_t* src = P + (size_t)(r0 + row) * PW + PBM + g * 128 + c0;
#pragma unroll
          for (int q = 0; q < 4; ++q) *(LAS u32x4*)(Bs + row * 136 + c0 + q * 8) = *(const u32x4*)(src + q * 8); }
        { const int row = tid >> 2, p0 = (tid & 3) * 16; const bf16_t* src = P + (size_t)(r0 + row) * PW + PXS + h * 64 + p0; const float f = s_dt[row] * __expf(s_ac[127] - s_ac[row]);
#pragma unroll
          for (int q = 0; q < 2; ++q) { const u32x4 v = *(const u32x4*)(src + q * 8); LAS float* d = xdd + row * 64 + p0 + q * 8;
              d[0] = bflo(v.x) * f; d[1] = bfhi(v.x) * f; d[2] = bflo(v.y) * f; d[3] = bfhi(v.y) * f; d[4] = bflo(v.z) * f; d[5] = bfhi(v.z) * f; d[6] = bflo(v.w) * f; d[7] = bfhi(v.w) * f; } }
        __syncthreads();
        const int pp = tid >> 3, ng = tid & 7; float acc[16];
#pragma unroll
        for (int j = 0; j < 16; ++j) acc[j] = 0.f;
        for (int ll = 0; ll < CH; ++ll) { const float xv = xdd[ll * 64 + pp]; const u32x4 b0 = *(const LAS u32x4*)(Bs + ll * 136 + ng * 16), b1 = *(const LAS u32x4*)(Bs + ll * 136 + ng * 16 + 8);
            acc[0] += xv * bflo(b0.x); acc[1] += xv * bfhi(b0.x); acc[2] += xv * bflo(b0.y); acc[3] += xv * bfhi(b0.y); acc[4] += xv * bflo(b0.z); acc[5] += xv * bfhi(b0.z); acc[6] += xv * bflo(b0.w); acc[7] += xv * bfhi(b0.w);
            acc[8] += xv * bflo(b1.x); acc[9] += xv * bfhi(b1.x); acc[10] += xv * bflo(b1.y); acc[11] += xv * bfhi(b1.y); acc[12] += xv * bflo(b1.z); acc[13] += xv * bfhi(b1.z); acc[14] += xv * bflo(b1.w); acc[15] += xv * bfhi(b1.w); }
        float* dst = ST + (((size_t)gc * 16 + h) * 64 + pp) * 128 + ng * 16;
#pragma unroll
        for (int q = 0; q < 4; ++q) *(f32x4*)(dst + q * 4) = (f32x4){acc[q * 4], acc[q * 4 + 1], acc[q * 4 + 2], acc[q * 4 + 3]};
        if (tid == 0) CD[gc * 16 + h] = __expf(s_ac[127]);
    }
}
DEV void ph_ssd_scan(const Params& p, int tid) {
    float* ST = (float*)(p.ws + WS_ST); const float* CD = (const float*)(p.ws + WS_CD);
    for (int e = BIDX * NTHREADS + tid; e < NB * 16 * 64 * 128; e += GDIM * NTHREADS) {
        const int b = e >> 17, h = (e >> 13) & 15, pn = e & 8191; float hc = 0.f;
        for (int c = 0; c < NCHUNK; ++c) { const int gc = b * NCHUNK + c; const size_t idx = ((size_t)gc * 16 + h) * 8192 + pn; const float t = ST[idx]; ST[idx] = hc; hc = hc * CD[gc * 16 + h] + t; }
    }
}
DEV void ph_ssd_out(const Params& p, int l, LAS unsigned char* lds, int tid, int wave, int lane) {
    LAS bf16_t* Cs = (LAS bf16_t*)lds;
    LAS bf16_t* Bs = (LAS bf16_t*)(lds + 34816);
    LAS float* prev = (LAS float*)(lds + 34816);
    LAS bf16_t* CBs = (LAS bf16_t*)(lds + 2 * 34816);
    LAS float* xd = (LAS float*)(lds + 3 * 34816);
    LAS float* s_dt = (LAS float*)(lds + 4 * 34816); LAS float* s_ac = s_dt + 128; LAS float* s_ss = s_dt + 256;
    bf16_t* P = (bf16_t*)(p.ws + WS_P); const float* ST = (const float*)(p.ws + WS_ST); float* ROWSS = (float*)(p.ws + WS_ROWSS);
    for (int unit = BIDX; unit < GCH * 2; unit += GDIM) {
        const int gc = unit >> 1, g = unit & 1, r0 = gc * CH;
        __syncthreads();
        { const int row = tid >> 2, c0 = (tid & 3) * 32; const bf16_t* sc = P + (size_t)(r0 + row) * PW + PCM + g * 128 + c0; const bf16_t* sb = P + (size_t)(r0 + row) * PW + PBM + g * 128 + c0;
#pragma unroll
          for (int q = 0; q < 4; ++q) { *(LAS u32x4*)(Cs + row * 136 + c0 + q * 8) = *(const u32x4*)(sc + q * 8); *(LAS u32x4*)(Bs + row * 136 + c0 + q * 8) = *(const u32x4*)(sb + q * 8); } }
        if (tid < CH) s_ss[tid] = 0.f;
        __syncthreads();
        { const int lr = tid >> 2, s0 = (tid & 3) * 32; float acc[32];
#pragma unroll
          for (int j = 0; j < 32; ++j) acc[j] = 0.f;
          for (int n = 0; n < 128; n += 8) { const u32x4 cv = *(const LAS u32x4*)(Cs + lr * 136 + n);
              const float c0 = bflo(cv.x), c1 = bfhi(cv.x), c2 = bflo(cv.y), c3 = bfhi(cv.y), c4 = bflo(cv.z), c5 = bfhi(cv.z), c6 = bflo(cv.w), c7 = bfhi(cv.w);
#pragma unroll
              for (int j = 0; j < 32; ++j) { const u32x4 bv = *(const LAS u32x4*)(Bs + (s0 + j) * 136 + n);
                  acc[j] += c0 * bflo(bv.x) + c1 * bfhi(bv.x) + c2 * bflo(bv.y) + c3 * bfhi(bv.y) + c4 * bflo(bv.z) + c5 * bfhi(bv.z) + c6 * bflo(bv.w) + c7 * bfhi(bv.w); } }
#pragma unroll
          for (int j = 0; j < 32; j += 2) *(LAS unsigned*)(CBs + lr * 136 + s0 + j) = pk2(acc[j], acc[j + 1]); }
        for (int e = 0; e < 8; ++e) {
            const int h = g * 8 + e;
            __syncthreads();
            ssd_head_scalars(p, l, r0, h, s_dt, s_ac, tid, wave, lane);
            { const int pp = tid >> 3, n0 = (tid & 7) * 16; const float* src = ST + (((size_t)gc * 16 + h) * 64 + pp) * 128 + n0;
#pragma unroll
              for (int q = 0; q < 4; ++q) { const f32x4 v = *(const f32x4*)(src + q * 4); LAS float* d = prev + pp * 129 + n0 + q * 4; d[0] = v.x; d[1] = v.y; d[2] = v.z; d[3] = v.w; } }
            const int lr = tid >> 2, p0 = (tid & 3) * 16; float xraw[16];
            { const bf16_t* src = P + (size_t)(r0 + lr) * PW + PXS + h * 64 + p0; const float f = s_dt[lr];
#pragma unroll
              for (int q = 0; q < 2; ++q) { const u32x4 v = *(const u32x4*)(src + q * 8);
                  xraw[q * 8 + 0] = bflo(v.x); xraw[q * 8 + 1] = bfhi(v.x); xraw[q * 8 + 2] = bflo(v.y); xraw[q * 8 + 3] = bfhi(v.y); xraw[q * 8 + 4] = bflo(v.z); xraw[q * 8 + 5] = bfhi(v.z); xraw[q * 8 + 6] = bflo(v.w); xraw[q * 8 + 7] = bfhi(v.w); }
#pragma unroll
              for (int j = 0; j < 16; ++j) xd[lr * 68 + p0 + j] = xraw[j] * f; }
            __syncthreads();
            float y[16], yo[16];
#pragma unroll
            for (int j = 0; j < 16; ++j) { y[j] = 0.f; yo[j] = 0.f; }
            const float al = s_ac[lr];
            for (int s = 0; s <= lr; ++s) { const float cb = bf2f(CBs[lr * 136 + s]) * __expf(al - s_ac[s]);
#pragma unroll
                for (int q = 0; q < 4; ++q) { const f32x4 xv = *(const LAS f32x4*)(xd + s * 68 + p0 + q * 4); y[q * 4] += cb * xv.x; y[q * 4 + 1] += cb * xv.y; y[q * 4 + 2] += cb * xv.z; y[q * 4 + 3] += cb * xv.w; } }
            for (int n = 0; n < 128; ++n) { const float c = bf2f(Cs[lr * 136 + n]);
#pragma unroll
                for (int j = 0; j < 16; ++j) yo[j] += c * prev[(p0 + j) * 129 + n]; }
            const float ea = __expf(al), dh = p.in[I_SD][l * 16 + h];
            bf16_t* zp = P + (size_t)(r0 + lr) * PW + PZ + h * 64 + p0; float ssl = 0.f; unsigned ow[8];
            { const u32x4 z0 = *(const u32x4*)zp, z1 = *(const u32x4*)(zp + 8); float zz[16];
              zz[0] = bflo(z0.x); zz[1] = bfhi(z0.x); zz[2] = bflo(z0.y); zz[3] = bfhi(z0.y); zz[4] = bflo(z0.z); zz[5] = bfhi(z0.z); zz[6] = bflo(z0.w); zz[7] = bfhi(z0.w);
              zz[8] = bflo(z1.x); zz[9] = bfhi(z1.x); zz[10] = bflo(z1.y); zz[11] = bfhi(z1.y); zz[12] = bflo(z1.z); zz[13] = bfhi(z1.z); zz[14] = bflo(z1.w); zz[15] = bfhi(z1.w);
#pragma unroll
              for (int j = 0; j < 16; ++j) { const float v = (y[j] + ea * yo[j] + dh * xraw[j]) * siluf(zz[j]); ssl += v * v; y[j] = v; }
#pragma unroll
              for (int j = 0; j < 8; ++j) ow[j] = pk2(y[2 * j], y[2 * j + 1]); }
            *(u32x4*)zp = (u32x4){ow[0], ow[1], ow[2], ow[3]}; *(u32x4*)(zp + 8) = (u32x4){ow[4], ow[5], ow[6], ow[7]};
            ssl += lane_get(ssl, lane ^ 1); ssl += lane_get(ssl, lane ^ 2);
            if ((tid & 3) == 0) s_ss[lr] += ssl;
        }
        __syncthreads();
        if (tid < CH) ROWSS[(size_t)(r0 + tid) * 2 + g] = s_ss[tid];
    }
}
DEV void ph_mixfinal(const Params& p, int l, int gw, int ngw, int lane) {
    bf16_t* P = (bf16_t*)(p.ws + WS_P); const float* ng = p.in[I_SN] + (size_t)l * 1024 + 16 * lane;
    for (int row = gw; row < M; row += ngw) {
        u32x4* q = (u32x4*)(P + (size_t)row * PW + PZ + 16 * lane); const u32x4 a = q[0], b = q[1];
        float v[16] = {bflo(a.x), bfhi(a.x), bflo(a.y), bfhi(a.y), bflo(a.z), bfhi(a.z), bflo(a.w), bfhi(a.w), bflo(b.x), bfhi(b.x), bflo(b.y), bfhi(b.y), bflo(b.z), bfhi(b.z), bflo(b.w), bfhi(b.w)};
        float ss = 0.f;
#pragma unroll
        for (int j = 0; j < 16; ++j) ss += v[j] * v[j];
#pragma unroll
        for (int o = 1; o < 32; o <<= 1) ss += lane_get(ss, lane ^ o);
        const float rs = rsqrtf(ss * (1.f / 512.f) + EPS);
        u32x4 oa, ob;
        oa.x = pk2(v[0] * rs * ng[0], v[1] * rs * ng[1]); oa.y = pk2(v[2] * rs * ng[2], v[3] * rs * ng[3]); oa.z = pk2(v[4] * rs * ng[4], v[5] * rs * ng[5]); oa.w = pk2(v[6] * rs * ng[6], v[7] * rs * ng[7]);
        ob.x = pk2(v[8] * rs * ng[8], v[9] * rs * ng[9]); ob.y = pk2(v[10] * rs * ng[10], v[11] * rs * ng[11]); ob.z = pk2(v[12] * rs * ng[12], v[13] * rs * ng[13]); ob.w = pk2(v[14] * rs * ng[14], v[15] * rs * ng[15]);
        q[0] = oa; q[1] = ob;
    }
}

DEV void ph_sb_attn(const Params& p, LAS unsigned char* lds, int gw, int ngw, int wave, int lane) {
    LAS float* qs = (LAS float*)(lds + 65536 + wave * 512);
    bf16_t* P = (bf16_t*)(p.ws + WS_P);
    for (int task = gw; task < NB * 8 * S; task += ngw) {
        const int t = task % S, bh = task / S, h = bh & 7, b = bh >> 3; const size_t rowb = (size_t)b * S;
        bf16_t* qp = P + (rowb + t) * PW + PSQ + h * 64;
        qs[lane] = bf2f(qp[lane]) * 0.125f; LDS_WAIT();
        float o = 0.f, R = 0.f;
        for (int k1 = t - 1; k1 >= 0; k1 -= 64) {
            const int s = k1 - lane; const bool valid = s >= 0; float z = 0.f;
            if (valid) { const bf16_t* kp = P + (rowb + s) * PW + PSK + h * 64;
#pragma unroll
                for (int q = 0; q < 8; ++q) { const u32x4 kv = *(const u32x4*)(kp + q * 8); const LAS float* qq = qs + q * 8;
                    z += qq[0] * bflo(kv.x) + qq[1] * bfhi(kv.x) + qq[2] * bflo(kv.y) + qq[3] * bfhi(kv.y) + qq[4] * bflo(kv.z) + qq[5] * bfhi(kv.z) + qq[6] * bflo(kv.w) + qq[7] * bfhi(kv.w); } }
            const float Lg = valid ? -softplusf(z) : 0.f;
            const float cum = wave_incl_scan(Lg, lane);
            const float w = valid ? __expf(z + R + cum) : 0.f;
            const int nv = (k1 + 1 < 64) ? k1 + 1 : 64;
            for (int i = 0; i < nv; ++i) { const float wi = lane_get(w, i); o += wi * bf2f(P[(rowb + (k1 - i)) * PW + PSV + h * 64 + lane]); }
            R += lane_get(cum, 63);
            if (R < -104.f) break;
        }
        qp[lane] = (bf16_t)f2bf(o);
        LDS_WAIT();
    }
}
DEV void ph_diff_attn(const Params& p, int l, LAS unsigned char* lds, int gw, int ngw, int wave, int lane) {
    LAS float* qs = (LAS float*)(lds + 65536 + 4096 + wave * 512);
    bf16_t* P = (bf16_t*)(p.ws + WS_P); const float* misc = (const float*)(p.ws + WS_MISC);
    const float lam = misc[l]; const float linit = lambda_init_of(l);
    for (int task = gw; task < NB * 4 * S; task += ngw) {
        const int t = task % S, bh = task / S, h = bh & 3, b = bh >> 2; const size_t rowb = (size_t)b * S;
        bf16_t* qp = P + (rowb + t) * PW + PDQ + h * 128;
        qs[lane] = bf2f(qp[lane]) * 0.125f; qs[64 + lane] = bf2f(qp[64 + lane]) * 0.125f; LDS_WAIT();
        const float* bt = misc + 64 + h * 128;
        float m0 = -INFINITY, m1 = -INFINITY, l0 = 0.f, l1 = 0.f, o0a = 0.f, o0b = 0.f, o1a = 0.f, o1b = 0.f;
        for (int k1 = t; k1 >= 0; k1 -= 64) {
            const int s = k1 - lane; const bool valid = s >= 0; float z0 = 0.f, z1 = 0.f;
            if (valid) { const bf16_t* kp = P + (rowb + s) * PW + PDK + h * 128;
#pragma unroll
                for (int q = 0; q < 8; ++q) { const u32x4 kv = *(const u32x4*)(kp + q * 8); const LAS float* qq = qs + q * 8;
                    z0 += qq[0] * bflo(kv.x) + qq[1] * bfhi(kv.x) + qq[2] * bflo(kv.y) + qq[3] * bfhi(kv.y) + qq[4] * bflo(kv.z) + qq[5] * bfhi(kv.z) + qq[6] * bflo(kv.w) + qq[7] * bfhi(kv.w); }
#pragma unroll
                for (int q = 0; q < 8; ++q) { const u32x4 kv = *(const u32x4*)(kp + 64 + q * 8); const LAS float* qq = qs + 64 + q * 8;
                    z1 += qq[0] * bflo(kv.x) + qq[1] * bfhi(kv.x) + qq[2] * bflo(kv.y) + qq[3] * bfhi(kv.y) + qq[4] * bflo(kv.z) + qq[5] * bfhi(kv.z) + qq[6] * bflo(kv.w) + qq[7] * bfhi(kv.w); } }
            const int dist = t - s; const float bias = bt[dist < 127 ? dist : 127];
            z0 = valid ? z0 + bias : -INFINITY; z1 = valid ? z1 + bias : -INFINITY;
            const float n0 = fmaxf(m0, wave_max(z0, lane)), n1 = fmaxf(m1, wave_max(z1, lane));
            const float sc0 = __expf(m0 - n0), sc1 = __expf(m1 - n1);
            const float p0 = valid ? __expf(z0 - n0) : 0.f, p1 = valid ? __expf(z1 - n1) : 0.f;
            l0 = l0 * sc0 + wave_sum(p0, lane); l1 = l1 * sc1 + wave_sum(p1, lane); o0a *= sc0; o0b *= sc0; o1a *= sc1; o1b *= sc1; m0 = n0; m1 = n1;
            const int nv = (k1 + 1 < 64) ? k1 + 1 : 64;
            for (int i = 0; i < nv; ++i) { const float a = lane_get(p0, i), c = lane_get(p1, i); const unsigned vv = *(const unsigned*)(P + (rowb + (k1 - i)) * PW + PDV + h * 128 + 2 * lane);
                const float va = bflo(vv), vb = bfhi(vv); o0a += a * va; o0b += a * vb; o1a += c * va; o1b += c * vb; }
        }
        const float ya = o0a / l0 - lam * o1a / l1, yb = o0b / l0 - lam * o1b / l1;
        const float rs = rsqrtf(wave_sum(ya * ya + yb * yb, lane) * (1.f / 128.f) + EPS) * (1.f - linit);
        const float* sg = p.in[I_SUB] + (size_t)l * 128 + 2 * lane;
        *(unsigned*)(qp + 2 * lane) = pk2(ya * rs * sg[0], yb * rs * sg[1]);
        LDS_WAIT();
    }
}


#include <hip/hip_bf16.h>
#include <cmath>
namespace attn_body {
using bf16=__hip_bfloat16;
using bf16x8=__attribute__((ext_vector_type(8)))short;
using s16x4=__attribute__((ext_vector_type(4)))short;
using f32x16=__attribute__((ext_vector_type(16)))float;
using u32x4=__attribute__((ext_vector_type(4)))unsigned;
constexpr int BATCH=4,SEQ=4096,D=64,DM=5632,OPITCH=1024;
constexpr int NW=8,QBLK=32,QB=QBLK*NW,KVBLK=64,NQB=SEQ/QB;
constexpr int ATTN_PITCH=DM, ATTN_UNIT_ROWS=QB; constexpr int TAB_PAD=264, TAB_N=720;
__device__ __forceinline__ int crow(int r,int hi){return (r&3)+8*(r>>2)+4*hi;}
#define SBAR() __builtin_amdgcn_sched_barrier(0)
__device__ __forceinline__ void cmask(f32x16&p0,f32x16&p1,int jb,int qrel,int hi){
  const float NEG=-INFINITY; int kb=64*jb+4*hi; asm volatile("":"+v"(kb));
  #pragma unroll
  for(int r=0;r<16;++r){int kv=kb+(r&3)+8*(r>>2); if(kv>qrel)p0[r]=NEG; if(kv+32>qrel)p1[r]=NEG;}
}

constexpr int NSLOT=3, SLOTB=8192;
constexpr int LDS_K=0, LDS_V=NSLOT*SLOTB, LDS_WS=2*NSLOT*SLOTB, LDS_OST=LDS_WS+NW*64*4, LDS_BYTES=LDS_OST+NW*4096;
constexpr float C2=0.125f*1.4426950408889634f;
__device__ __forceinline__ void glds16(const void*gsrc,unsigned lds_dst){unsigned keep;
  asm volatile("s_mov_b32 %0, m0\n\ts_mov_b32 m0, %2\n\ts_nop 0\n\tglobal_load_lds_dwordx4 %1, off\n\ts_mov_b32 m0, %0":"=&s"(keep):"v"(gsrc),"s"(lds_dst):"memory");}
__device__ __forceinline__ float max3f(float a,float b,float c){float r;asm("v_max3_f32 %0, %1, %2, %3":"=v"(r):"v"(a),"v"(b),"v"(c));return r;}
__device__ __forceinline__ float max2f(float a,float b){float r;asm("v_max_f32_e32 %0, %1, %2":"=v"(r):"v"(a),"v"(b));return r;}
__device__ __forceinline__ float fadd_s(float a,float b){float r;asm("v_add_f32_e32 %0, %1, %2":"=v"(r):"v"(a),"v"(b));return r;}
__device__ __forceinline__ float fsub_s(float a,float b){float r;asm("v_sub_f32_e32 %0, %1, %2":"=v"(r):"v"(a),"v"(b));return r;}
typedef float f32x2_t __attribute__((ext_vector_type(2))); typedef __bf16 bf16x2_t __attribute__((ext_vector_type(2)));
__device__ __forceinline__ unsigned cvtpk_s(float lo,float hi){f32x2_t v={lo,hi};bf16x2_t b=__builtin_convertvector(v,bf16x2_t);return __builtin_bit_cast(unsigned,b);}
#define WAIT_BAR(N) asm volatile("s_waitcnt vmcnt(" #N ") lgkmcnt(0)\n\ts_barrier":::"memory")

__device__ __forceinline__ void qkt(f32x16&p0,f32x16&p1,const char*Kslot,const bf16x8*qr,int r32,int hi){ const f32x16 zc_={};
  const char*kb=Kslot+hi*1024+r32*16;
  #pragma unroll
  for(int d0=0;d0<4;++d0){
    const bf16x8 b0=*reinterpret_cast<const bf16x8*>(kb+d0*2048);
    const bf16x8 b1=*reinterpret_cast<const bf16x8*>(kb+d0*2048+512);
    if(d0==0){p0=__builtin_amdgcn_mfma_f32_32x32x16_bf16(b0,qr[0],zc_,0,0,0);p1=__builtin_amdgcn_mfma_f32_32x32x16_bf16(b1,qr[0],zc_,0,0,0);}
    else{p0=__builtin_amdgcn_mfma_f32_32x32x16_bf16(b0,qr[d0],p0,0,0,0);p1=__builtin_amdgcn_mfma_f32_32x32x16_bf16(b1,qr[d0],p1,0,0,0);}}
}
typedef __attribute__((address_space(3))) const char* lds_cptr;
typedef short v4i16_t __attribute__((ext_vector_type(4)));
__device__ __forceinline__ void kload8(bf16x8*kf,lds_cptr kp){
  kf[0]=*(const __attribute__((address_space(3))) bf16x8*)(kp);      kf[1]=*(const __attribute__((address_space(3))) bf16x8*)(kp+512);
  kf[2]=*(const __attribute__((address_space(3))) bf16x8*)(kp+2048); kf[3]=*(const __attribute__((address_space(3))) bf16x8*)(kp+2560);
  kf[4]=*(const __attribute__((address_space(3))) bf16x8*)(kp+4096); kf[5]=*(const __attribute__((address_space(3))) bf16x8*)(kp+4608);
  kf[6]=*(const __attribute__((address_space(3))) bf16x8*)(kp+6144); kf[7]=*(const __attribute__((address_space(3))) bf16x8*)(kp+6656);
}
__device__ __forceinline__ void kload2(bf16x8*kf,lds_cptr kp,int j){ kf[2*j]=*(const __attribute__((address_space(3))) bf16x8*)(kp+j*2048); kf[2*j+1]=*(const __attribute__((address_space(3))) bf16x8*)(kp+j*2048+512); }
__device__ __forceinline__ s16x4 vtr(lds_cptr p){ return __builtin_bit_cast(s16x4,__builtin_amdgcn_ds_read_tr16_b64_v4i16((__attribute__((address_space(3))) v4i16_t*)p)); }
__device__ __forceinline__ float rowmax(const f32x16&p0,const f32x16&p1){
  float a=max3f(p0[0],p0[1],p1[0]),b=max3f(p0[2],p0[3],p1[1]);a=max3f(a,p1[2],p1[3]);
  #pragma unroll
  for(int r=4;r<16;r+=4){a=max3f(a,p0[r],p0[r+1]);b=max3f(b,p0[r+2],p0[r+3]);a=max3f(a,p1[r],p1[r+1]);b=max3f(b,p1[r+2],p1[r+3]);}
  const float m=max2f(a,b);
  auto rr=__builtin_amdgcn_permlane32_swap(__float_as_uint(m),__float_as_uint(m),false,false);
  return max2f(__uint_as_float(rr[0]),__uint_as_float(rr[1]));
}
__device__ __forceinline__ void pv(f32x16*o,int vb,bf16x8 pa0,bf16x8 pa1,bf16x8 pa2,bf16x8 pa3){
  #pragma unroll
  for(int d0=0;d0<2;++d0){s16x4 lo[4],hi[4];
    #pragma unroll
    for(int ks=0;ks<4;++ks){
      asm volatile("ds_read_b64_tr_b16 %0,%1 offset:%c2":"=&v"(lo[ks]):"v"(vb),"i"(d0*4096+ks*1024):"memory");
      asm volatile("ds_read_b64_tr_b16 %0,%1 offset:%c2":"=&v"(hi[ks]):"v"(vb),"i"(d0*4096+ks*1024+512):"memory");}
    asm volatile("s_waitcnt lgkmcnt(0)":::"memory");SBAR();
    #define PK(k) (bf16x8){lo[k][0],lo[k][1],lo[k][2],lo[k][3],hi[k][0],hi[k][1],hi[k][2],hi[k][3]}
    o[d0]=__builtin_amdgcn_mfma_f32_32x32x16_bf16(pa0,PK(0),o[d0],0,0,0);
    o[d0]=__builtin_amdgcn_mfma_f32_32x32x16_bf16(pa1,PK(1),o[d0],0,0,0);
    o[d0]=__builtin_amdgcn_mfma_f32_32x32x16_bf16(pa2,PK(2),o[d0],0,0,0);
    o[d0]=__builtin_amdgcn_mfma_f32_32x32x16_bf16(pa3,PK(3),o[d0],0,0,0);
    #undef PK
  }
}

#ifndef ATTN_STORE16
#define ATTN_STORE16(p,v) (*(u32x4*)(p)=(v))
#endif
template<int THRL> __device__ __forceinline__ void attn_unit(int b,int qb,const bf16*Q,const bf16*__restrict__ K,const bf16*__restrict__ V,bf16*O,char*shm,const __attribute__((address_space(3))) float*tabl,const int tid){
  const int lane=tid&63,r32=lane&31,hi=lane>>5; const int wid=__builtin_amdgcn_readfirstlane(tid>>6);
  const long rowbase=(long)b*SEQ; const int q0=qb*QB;
  const bf16*Qw=Q+(rowbase+q0+wid*QBLK)*DM;
  const bf16*Kh=K+rowbase*DM,*Vh=V+rowbase*DM;
  const unsigned lds0=(unsigned)(uintptr_t)shm;
  float*wsf=(float*)(shm+LDS_WS)+wid*64;
  const bf16*ksrc=Kh+(long)lane*DM+wid*8;
  const bf16*vsrc=Vh+(long)(16*(wid&3)+(lane>>2))*DM+(wid>>2)*32+(lane&3)*8;
  const unsigned kdst=lds0+LDS_K+wid*1024, vdst=lds0+LDS_V+wid*1024;
  #define DMA_K(t,slot) glds16(ksrc+(long)(t)*KVBLK*DM,(unsigned)__builtin_amdgcn_readfirstlane(kdst+(slot)))
  #define DMA_V(t,slot) glds16(vsrc+(long)(t)*KVBLK*DM,(unsigned)__builtin_amdgcn_readfirstlane(vdst+(slot)))
  const int vb0=(int)(lds0+LDS_V)+((lane>>4)&1)*32+(lane&3)*8+(4*hi+((lane&15)>>2))*64;
  const char*Kbase=shm+LDS_K; bf16x8 kf[8];
  const lds_cptr shm3=(lds_cptr)shm; const lds_cptr kp0=shm3+LDS_K+hi*1024+r32*16; const lds_cptr vp0=shm3+LDS_V+((lane>>4)&1)*32+(lane&3)*8+(4*hi+((lane&15)>>2))*64;
  const int NT=(q0+QB)/KVBLK;
  DMA_K(0,0);DMA_V(0,0);DMA_K(1,SLOTB);
  bf16x8 qr[4];
  #pragma unroll
  for(int d0=0;d0<4;++d0)qr[d0]=*reinterpret_cast<const bf16x8*>(&Qw[(long)r32*DM+d0*16+hi*8]);
  float z0_=0.f;asm volatile("":"+v"(z0_));
  float mhat=z0_,l_reg=z0_;f32x16 o[2]; const f32x16 zc_={};
  _Pragma("unroll") for(int r=0;r<16;++r){o[0][r]=z0_;o[1][r]=z0_;}
  const int qrel=wid*QBLK+r32;
  #define CMASK(P0,P1,t) do{int jb_=(t)-(NT-4); if(jb_>=0)cmask(P0,P1,jb_,qrel,hi);}while(0)
  #define BIASADD(P0,P1,t) do{ const __attribute__((address_space(3))) float*tp_=tabl+(q0+qrel-64*(t)-4*hi+(TAB_PAD-63)); \
    _Pragma("unroll") for(int r=0;r<16;++r){ const int c_=(r&3)+8*(r>>2); P0[r]+=tp_[63-c_]; P1[r]+=tp_[31-c_]; if((r&1)==1){SBAR();} } }while(0)
  bool resc=false;
  #define START(P0,P1) do{ const float rm=rowmax(P0,P1); resc=false; \
    { const float dl=rm; mhat=fadd_s(mhat,dl); \
      _Pragma("unroll") for(int r=0;r<16;++r){P0[r]=fsub_s(P0[r],dl);P1[r]=fsub_s(P1[r],dl);} \
      } \
    _Pragma("unroll") for(int r=0;r<16;++r)P0[r]=__builtin_amdgcn_exp2f(P0[r]); }while(0)
  #define RESC() do{ if(resc){ asm volatile("s_waitcnt lgkmcnt(0)":::"memory"); \
      _Pragma("unroll") for(int d_=0;d_<2;++d_) _Pragma("unroll") for(int r=0;r<16;++r)o[d_][r]*=wsf[crow(r,hi)]; } }while(0)
  f32x16 pA0,pA1,pB0,pB1;
  int sl_prev=0,sl_cur=0,sl_next=SLOTB;
  #define ROT() do{sl_prev=sl_cur;sl_cur=sl_next;sl_next=(sl_next==(NSLOT-1)*SLOTB)?0:sl_next+SLOTB;}while(0)
  DMA_K(2,2*SLOTB);
  WAIT_BAR(3);
  qkt(pA0,pA1,Kbase,qr,r32,hi);asm volatile("s_nop 15\n\ts_nop 7":"+v"(pA0),"+v"(pA1)); if(NT<=6){BIASADD(pA0,pA1,0);} CMASK(pA0,pA1,0);
  START(pA0,pA1);
  _Pragma("unroll") for(int r=0;r<16;++r)pA1[r]=__builtin_amdgcn_exp2f(pA1[r]);
  WAIT_BAR(0);
  DMA_K(3,0);DMA_V(1,SLOTB);
  ROT();
  kload8(kf,kp0+sl_cur);
  WAIT_BAR(2);
  s16x4 vlo[8],vhi[8]; u32x4 pw0,pw1,pw2,pw3;
  #define PKW(P,B) cvtpk_s(P[B],P[B+1])
  #define PAF(k) __builtin_bit_cast(bf16x8,pw##k)
  #define VFR(i) (bf16x8){vlo[i][0],vlo[i][1],vlo[i][2],vlo[i][3],vhi[i][0],vhi[i][1],vhi[i][2],vhi[i][3]}
  #define PIN(x) asm volatile("":"+v"(x))
  #define MX3(a,b,c) __builtin_fmaxf(__builtin_fmaxf((a),(b)),(c))
  #define GAPA(MF,A0,A1,A2,A3,W0,W1,PW) do{ MF; sacc+=A0; sacc+=A1; sacc+=A2; sacc+=A3; PIN(sacc); W0; W1; PIN(PW); SBAR(); }while(0)
  #define EX(v) __builtin_amdgcn_exp2f(v)
  #define GAPB(MF,X,B) do{ MF; X[B]=EX(X[B]); X[B+1]=EX(X[B+1]); X[B+2]=EX(X[B+2]); X[B+3]=EX(X[B+3]); PIN(X); SBAR(); }while(0)
  #define VRD(i) do{ vlo[i]=vtr(vp_+(((i)>>2)*4096+((i)&3)*1024)); vhi[i]=vtr(vp_+(((i)>>2)*4096+((i)&3)*1024+512)); }while(0)
  #define KRD(G,j) do{ if(G){ kload2(kf,kp0+sl_next,j); SBAR(); } }while(0)
  #define STEP(C0,C1,P0,P1,t,GK,GV,GL) do{ SBAR(); \
    const lds_cptr vp_=vp0+sl_prev; \
    VRD(0); SBAR(); float sacc=(P0[0]+P0[1]); \
    GAPA(C0=__builtin_amdgcn_mfma_f32_32x32x16_bf16(kf[0],qr[0],zc_,0,0,0), P0[2],P0[3],P0[4],P0[5],     pw0[0]=PKW(P0,0), pw0[1]=PKW(P0,2), pw0); \
    VRD(4); SBAR(); GAPA(C1=__builtin_amdgcn_mfma_f32_32x32x16_bf16(kf[1],qr[0],zc_,0,0,0), P0[6],P0[7],P0[8],P0[9],     pw0[2]=PKW(P0,4), pw0[3]=PKW(P0,6), pw0); \
    VRD(1); SBAR(); GAPA(C0=__builtin_amdgcn_mfma_f32_32x32x16_bf16(kf[2],qr[1],C0,0,0,0),   P0[10],P0[11],P0[12],P0[13], pw1[0]=PKW(P0,8), pw1[1]=PKW(P0,10), pw1); \
    VRD(5); SBAR(); GAPA(C1=__builtin_amdgcn_mfma_f32_32x32x16_bf16(kf[3],qr[1],C1,0,0,0),   P0[14],P0[15],P1[0],P1[1],   pw1[2]=PKW(P0,12),pw1[3]=PKW(P0,14), pw1); \
    VRD(2); SBAR(); GAPA(C0=__builtin_amdgcn_mfma_f32_32x32x16_bf16(kf[4],qr[2],C0,0,0,0),   P1[2],P1[3],P1[4],P1[5],     pw2[0]=PKW(P1,0), pw2[1]=PKW(P1,2), pw2); \
    VRD(6); SBAR(); GAPA(C1=__builtin_amdgcn_mfma_f32_32x32x16_bf16(kf[5],qr[2],C1,0,0,0),   P1[6],P1[7],P1[8],P1[9],     pw2[2]=PKW(P1,4), pw2[3]=PKW(P1,6), pw2); \
    VRD(3); SBAR(); GAPA(C0=__builtin_amdgcn_mfma_f32_32x32x16_bf16(kf[6],qr[3],C0,0,0,0),   P1[10],P1[11],P1[12],P1[13], pw3[0]=PKW(P1,8), pw3[1]=PKW(P1,10), pw3); \
    VRD(7); SBAR(); GAPA(C1=__builtin_amdgcn_mfma_f32_32x32x16_bf16(kf[7],qr[3],C1,0,0,0),   P1[14],P1[15],0.f,0.f,       pw3[2]=PKW(P1,12),pw3[3]=PKW(P1,14), pw3); \
    l_reg+=sacc; \
    if(GK){DMA_K((t)+3,sl_cur);} if(GV){DMA_V((t)+1,sl_next);} \
    BIASQ(C0,C1,t); CMASK(C0,C1,t); \
    { float a=MX3(C0[0],C0[1],C1[0]),b=MX3(C0[2],C0[3],C1[1]); a=MX3(a,C1[2],C1[3]); \
      _Pragma("unroll") for(int r=4;r<16;r+=4){a=MX3(a,C0[r],C0[r+1]);b=MX3(b,C0[r+2],C0[r+3]);a=MX3(a,C1[r],C1[r+1]);b=MX3(b,C1[r+2],C1[r+3]);} \
      float rm=__builtin_fmaxf(a,b); { auto rr=__builtin_amdgcn_permlane32_swap(__float_as_uint(rm),__float_as_uint(rm),false,false); rm=__builtin_fmaxf(__uint_as_float(rr[0]),__uint_as_float(rr[1])); } \
      rm-=mhat; resc=false; \
      if(__builtin_expect(__any(rm>(float)THRL),0)){ const float dl=__builtin_fmaxf(rm,0.f); mhat+=dl; \
        const float f=__builtin_amdgcn_exp2f(-dl); l_reg*=f; if(hi==0)wsf[r32]=f; resc=true; } \
      _Pragma("unroll") for(int r=0;r<16;++r){C0[r]-=mhat;C1[r]-=mhat;} } \
    SBAR(); \
    GAPB(o[0]=__builtin_amdgcn_mfma_f32_32x32x16_bf16(PAF(0),VFR(0),o[0],0,0,0), C0,0); \
    GAPB(o[1]=__builtin_amdgcn_mfma_f32_32x32x16_bf16(PAF(0),VFR(4),o[1],0,0,0), C0,4); \
    KRD(GL,0); GAPB(o[0]=__builtin_amdgcn_mfma_f32_32x32x16_bf16(PAF(1),VFR(1),o[0],0,0,0), C0,8); \
    KRD(GL,1); GAPB(o[1]=__builtin_amdgcn_mfma_f32_32x32x16_bf16(PAF(1),VFR(5),o[1],0,0,0), C0,12); \
    KRD(GL,2); GAPB(o[0]=__builtin_amdgcn_mfma_f32_32x32x16_bf16(PAF(2),VFR(2),o[0],0,0,0), C1,0); \
    KRD(GL,3); GAPB(o[1]=__builtin_amdgcn_mfma_f32_32x32x16_bf16(PAF(2),VFR(6),o[1],0,0,0), C1,4); \
    GAPB(o[0]=__builtin_amdgcn_mfma_f32_32x32x16_bf16(PAF(3),VFR(3),o[0],0,0,0), C1,8); \
    GAPB(o[1]=__builtin_amdgcn_mfma_f32_32x32x16_bf16(PAF(3),VFR(7),o[1],0,0,0), C1,12); \
    }while(0)
  int t=1;
  #undef CMASK
  #define CMASK(P0,P1,t) do{}while(0)
  #define BIASQ(P0,P1,t) do{}while(0)
  for(;t+7<NT;t+=2){
    STEP(pB0,pB1,pA0,pA1,t,true,true,true);     WAIT_BAR(2); RESC(); ROT();
    STEP(pA0,pA1,pB0,pB1,t+1,true,true,true);   WAIT_BAR(2); RESC(); ROT();
  }
  #undef CMASK
  #undef BIASQ
  #define CMASK(P0,P1,t) do{int jb_=(t)-(NT-4); if(jb_>=0)cmask(P0,P1,jb_,qrel,hi);}while(0)
  #define BIASQ(P0,P1,t) BIASADD(P0,P1,t)
  #define ENDW(tt) do{ if((tt)+3<NT){WAIT_BAR(2);} else if((tt)+2<NT){WAIT_BAR(1);} else {WAIT_BAR(0);} }while(0)
  for(;t+1<NT;t+=2){
    STEP(pB0,pB1,pA0,pA1,t,(t+3<NT),(t+1<NT),(t+1<NT));       ENDW(t);   RESC(); ROT();
    STEP(pA0,pA1,pB0,pB1,t+1,(t+4<NT),(t+2<NT),(t+2<NT));     ENDW(t+1); RESC(); ROT();
  }
  STEP(pB0,pB1,pA0,pA1,NT-1,false,false,false); RESC();
  { float sacc=pB0[0]+pB0[1]; _Pragma("unroll") for(int r=2;r<16;++r)sacc+=pB0[r]; _Pragma("unroll") for(int r=0;r<16;++r)sacc+=pB1[r]; l_reg+=sacc;
    pw0=(u32x4){PKW(pB0,0),PKW(pB0,2),PKW(pB0,4),PKW(pB0,6)};pw1=(u32x4){PKW(pB0,8),PKW(pB0,10),PKW(pB0,12),PKW(pB0,14)};pw2=(u32x4){PKW(pB1,0),PKW(pB1,2),PKW(pB1,4),PKW(pB1,6)};pw3=(u32x4){PKW(pB1,8),PKW(pB1,10),PKW(pB1,12),PKW(pB1,14)};
    SBAR(); pv(o,vb0+sl_cur,PAF(0),PAF(1),PAF(2),PAF(3)); }
  #undef PKW
  #undef PAF
  #undef VFR
  #undef PIN
  #undef MX3
  #undef GAPA
  #undef GAPB
  #undef EX
  #undef VRD
  #undef KRD
  #undef STEP
  #undef ENDW
  {auto rr=__builtin_amdgcn_permlane32_swap(__float_as_uint(l_reg),__float_as_uint(l_reg),false,false);l_reg=__uint_as_float(rr[0])+__uint_as_float(rr[1]);}
  int lane_e=lane; asm volatile("":"+v"(lane_e)); const int r32e=lane_e&31,hie=lane_e>>5;
  float*wsfe=(float*)(shm+LDS_WS)+wid*64;
  if(hie==0)wsfe[32+r32e]=l_reg;asm volatile("s_waitcnt lgkmcnt(0)":::"memory");
  float rli[16];
  #pragma unroll
  for(int r=0;r<16;++r)rli[r]=__builtin_amdgcn_rcpf(wsfe[32+crow(r,hie)]);
  bf16*Ow=O+(rowbase+q0+wid*QBLK)*OPITCH;
  { bf16*stg=(bf16*)(shm+LDS_OST)+wid*2048;
    #pragma unroll
    for(int r=0;r<16;++r){const int orow=crow(r,hie);
      #pragma unroll
      for(int d0=0;d0<2;++d0)stg[orow*64+d0*32+r32e]=__float2bfloat16(o[d0][r]*rli[r]);}
    asm volatile("s_waitcnt lgkmcnt(0)":::"memory");
    #pragma unroll
    for(int i=0;i<4;++i){const int row=i*8+(lane_e>>3),ch=lane_e&7; const u32x4 v=*(const u32x4*)(stg+row*64+ch*8); ATTN_STORE16(Ow+(long)row*OPITCH+ch*8,v);} }
  asm volatile("s_waitcnt lgkmcnt(0)\n\ts_barrier":::"memory");
  #undef DMA_K
  #undef DMA_V
  #undef CMASK
  #undef BIASQ
  #undef BIASADD
  #undef START
  #undef RESC
  #undef ROT
}
constexpr int ATTN_LDS_BYTES=LDS_BYTES;
constexpr int SB_KB=0, SB_VB=16384, SB_FLG=32768, SB_OST=33024, SB_LDS=SB_OST+NW*4096;
__device__ __forceinline__ void sb_unit(int b,int qb,bf16*Qp,const bf16*__restrict__ Kp,const bf16*__restrict__ Vp,char*shm,const int tid){
  const int lane=tid&63,r32=lane&31,hi=lane>>5; const int wid=__builtin_amdgcn_readfirstlane(tid>>6);
  const long rowbase=(long)b*SEQ; const int q0=qb*QB;
  bf16*Qw=Qp+(rowbase+q0+wid*QBLK)*DM;
  bf16x8 qr[4];
  #pragma unroll
  for(int d0=0;d0<4;++d0)qr[d0]=*reinterpret_cast<const bf16x8*>(&Qw[(long)r32*DM+d0*16+hi*8]);
  bf16x8 UA,UB,ONES;
  #pragma unroll
  for(int j=0;j<8;++j){ const int kvp=8*(j>>2)+4*hi+(j&3); UA[j]=(kvp>r32)?(short)0x3F80:(short)0; UB[j]=(kvp+16>r32)?(short)0x3F80:(short)0; ONES[j]=(short)0x3F80; }
  float z0_=0.f;asm volatile("":"+v"(z0_));
  f32x16 o[2]; float R=z0_;
  #pragma unroll
  for(int r=0;r<16;++r){o[0][r]=z0_;o[1][r]=z0_;}
  const int qw0=q0+wid*QBLK, qabs=qw0+r32;
  const int NT=(q0+QB)/KVBLK;
  const bf16*ksrc=Kp+(rowbase+lane)*DM+wid*8;
  const bf16*vsrc=Vp+(rowbase+16*(wid&3)+(lane>>2))*DM+(wid>>2)*32+(lane&3)*8;
  typedef __attribute__((address_space(3))) u32x4* lds_u4p;
  const lds_cptr shm3=(lds_cptr)shm;
  const unsigned lds0=(unsigned)(uintptr_t)shm;
  volatile __attribute__((address_space(3))) int*flg=(volatile __attribute__((address_space(3))) int*)(shm3+SB_FLG);
  u32x4 kreg,vreg; int kt=NT-1,cur=0;
  kreg=*(const u32x4*)(ksrc+(long)kt*KVBLK*DM); vreg=*(const u32x4*)(vsrc+(long)kt*KVBLK*DM);
  bool done_w=false;
  for(;;){
    *(lds_u4p)(shm3+SB_KB+cur*8192+wid*1024+lane*16)=kreg; *(lds_u4p)(shm3+SB_VB+cur*8192+wid*1024+lane*16)=vreg;
    __syncthreads();
    if(kt>0){ kreg=*(const u32x4*)(ksrc+(long)(kt-1)*KVBLK*DM); vreg=*(const u32x4*)(vsrc+(long)(kt-1)*KVBLK*DM); }
    if(64*kt<qw0+31 && !done_w){
      f32x16 p0,p1; qkt(p0,p1,shm+SB_KB+cur*8192,qr,r32,hi);
      const int kv0=64*kt+4*hi;
      f32x16 L0,L1;
      #pragma unroll
      for(int r=0;r<16;++r){ const int kv=kv0+(r&3)+8*(r>>2);
        { const float z=p0[r]; const float sp=__builtin_fmaxf(z,0.f)+__builtin_amdgcn_logf(1.f+__builtin_amdgcn_exp2f(-__builtin_fabsf(z))); L0[r]=(kv<qabs)?-sp:0.f; }
        { const float z=p1[r]; const float sp=__builtin_fmaxf(z,0.f)+__builtin_amdgcn_logf(1.f+__builtin_amdgcn_exp2f(-__builtin_fabsf(z))); L1[r]=(kv+32<qabs)?-sp:0.f; } }
      u32x4 lh[4],ll[4];
      #pragma unroll
      for(int s=0;s<4;++s)
        #pragma unroll
        for(int e=0;e<4;++e){ const float a=(s<2)?L0[8*s+2*e]:L1[8*(s-2)+2*e], c=(s<2)?L0[8*s+2*e+1]:L1[8*(s-2)+2*e+1];
          const unsigned h2=cvtpk_s(a,c); lh[s][e]=h2; ll[s][e]=cvtpk_s(a-__uint_as_float(h2<<16),c-__uint_as_float(h2&0xffff0000u)); }
      #define BF8(x) __builtin_bit_cast(bf16x8,x)
      const f32x16 zc_={};
      f32x16 T0=__builtin_amdgcn_mfma_f32_32x32x16_bf16(UA,BF8(lh[0]),zc_,0,0,0);
      T0=__builtin_amdgcn_mfma_f32_32x32x16_bf16(UA,BF8(ll[0]),T0,0,0,0);
      T0=__builtin_amdgcn_mfma_f32_32x32x16_bf16(UB,BF8(lh[1]),T0,0,0,0); T0=__builtin_amdgcn_mfma_f32_32x32x16_bf16(UB,BF8(ll[1]),T0,0,0,0);
      T0=__builtin_amdgcn_mfma_f32_32x32x16_bf16(ONES,BF8(lh[2]),T0,0,0,0); T0=__builtin_amdgcn_mfma_f32_32x32x16_bf16(ONES,BF8(ll[2]),T0,0,0,0);
      T0=__builtin_amdgcn_mfma_f32_32x32x16_bf16(ONES,BF8(lh[3]),T0,0,0,0); T0=__builtin_amdgcn_mfma_f32_32x32x16_bf16(ONES,BF8(ll[3]),T0,0,0,0);
      f32x16 T1=__builtin_amdgcn_mfma_f32_32x32x16_bf16(UA,BF8(lh[2]),zc_,0,0,0);
      T1=__builtin_amdgcn_mfma_f32_32x32x16_bf16(UA,BF8(ll[2]),T1,0,0,0);
      T1=__builtin_amdgcn_mfma_f32_32x32x16_bf16(UB,BF8(lh[3]),T1,0,0,0); T1=__builtin_amdgcn_mfma_f32_32x32x16_bf16(UB,BF8(ll[3]),T1,0,0,0);
      float tot=T0[0]+L0[0]; { auto rr=__builtin_amdgcn_permlane32_swap(__float_as_uint(tot),__float_as_uint(tot),false,false); tot=__uint_as_float(rr[0]); }
      #pragma unroll
      for(int r=0;r<16;++r){ const int kv=kv0+(r&3)+8*(r>>2);
        p0[r]=(kv<qabs)?__builtin_amdgcn_exp2f(p0[r]+L0[r]+T0[r]+R):0.f; p1[r]=(kv+32<qabs)?__builtin_amdgcn_exp2f(p1[r]+L1[r]+T1[r]+R):0.f; }
      R+=tot;
      u32x4 pw0,pw1,pw2,pw3;
      pw0=(u32x4){cvtpk_s(p0[0],p0[1]),cvtpk_s(p0[2],p0[3]),cvtpk_s(p0[4],p0[5]),cvtpk_s(p0[6],p0[7])}; pw1=(u32x4){cvtpk_s(p0[8],p0[9]),cvtpk_s(p0[10],p0[11]),cvtpk_s(p0[12],p0[13]),cvtpk_s(p0[14],p0[15])};
      pw2=(u32x4){cvtpk_s(p1[0],p1[1]),cvtpk_s(p1[2],p1[3]),cvtpk_s(p1[4],p1[5]),cvtpk_s(p1[6],p1[7])}; pw3=(u32x4){cvtpk_s(p1[8],p1[9]),cvtpk_s(p1[10],p1[11]),cvtpk_s(p1[12],p1[13]),cvtpk_s(p1[14],p1[15])};
      SBAR();
      const int vb=(int)(lds0+SB_VB+cur*8192)+((lane>>4)&1)*32+(lane&3)*8+(4*hi+((lane&15)>>2))*64;
      pv(o,vb,BF8(pw0),BF8(pw1),BF8(pw2),BF8(pw3));
      #undef BF8
      done_w=__all(R<-150.f);
    }
    if(lane==0)flg[wid]=done_w?1:0;
    __syncthreads();
    int alld=1;
    #pragma unroll
    for(int w=0;w<NW;++w)alld&=flg[w];
    if(alld||kt==0)break;
    --kt;cur^=1;
  }
  { int lane_e=lane; asm volatile("":"+v"(lane_e)); const int r32e=lane_e&31,hie=lane_e>>5;
    bf16*stg=(bf16*)(shm+SB_OST)+wid*2048;
    #pragma unroll
    for(int r=0;r<16;++r){const int orow=crow(r,hie);
      #pragma unroll
      for(int d0=0;d0<2;++d0)stg[orow*64+d0*32+r32e]=__float2bfloat16(o[d0][r]);}
    asm volatile("s_waitcnt lgkmcnt(0)":::"memory");
    #pragma unroll
    for(int i=0;i<4;++i){const int row=i*8+(lane_e>>3),ch=lane_e&7; const u32x4 v=*(const u32x4*)(stg+row*64+ch*8); *(u32x4*)(Qw+(long)row*DM+ch*8)=v;} }
  __syncthreads();
}
__device__ __forceinline__ void sb_attn_phase(char*lds,bf16*P,int vcu,int G,const int tid){
  #pragma unroll 1
  for(int u=vcu;u<512;u+=G){ int u_=u; asm volatile("":"+s"(u_)); int tid_=tid; asm volatile("":"+v"(tid_));
    const int qb=u_&15,bh=u_>>4,h=bh&7,b=bh>>3;
    sb_unit(b,qb,P+1024+h*64,P+2048+h*64,P+2560+h*64,lds,tid_); }
}
constexpr int SO_C=0, SO_CBT=32768, SO_XD=73728, SO_SC=139264, SO_END=SO_SC+4096;
__device__ __forceinline__ bf16x8 vfrag(lds_cptr vb,int i){ const s16x4 lo=vtr(vb+((i>>2)*4096+(i&3)*1024)), hh=vtr(vb+((i>>2)*4096+(i&3)*1024+512)); return (bf16x8){lo[0],lo[1],lo[2],lo[3],hh[0],hh[1],hh[2],hh[3]}; }
__device__ __forceinline__ float bfl(unsigned w){return __uint_as_float(w<<16);} __device__ __forceinline__ float bfh(unsigned w){return __uint_as_float(w&0xffff0000u);}
__device__ __forceinline__ float lane_get_f(float v,int src){ return __int_as_float(__builtin_amdgcn_ds_bpermute(src<<2,__float_as_int(v))); }
__device__ __forceinline__ void ssd_scalars(__attribute__((address_space(3))) float*sc,const float*DT,int r0,int h,float dtb,float alog,int lane){
  const float a2=-__expf(alog)*1.4426950408889634f;
  float d0=DT[(size_t)(r0+2*lane)*16+h]+dtb, d1=DT[(size_t)(r0+2*lane+1)*16+h]+dtb;
  d0=__builtin_fmaxf(d0,0.f)+__logf(1.f+__expf(-__builtin_fabsf(d0))); d1=__builtin_fmaxf(d1,0.f)+__logf(1.f+__expf(-__builtin_fabsf(d1)));
  const float v0=d0*a2,v1=d1*a2; float s=v0+v1;
  #pragma unroll
  for(int o=1;o<64;o<<=1){ const float t=lane_get_f(s,lane-o); if(lane>=o)s+=t; }
  sc[2*lane]=s-v1; sc[2*lane+1]=s; sc[128+2*lane]=d0; sc[128+2*lane+1]=d1;
  asm volatile("s_waitcnt lgkmcnt(0)":::"memory");
}
__device__ __forceinline__ void ssd_out_unit(int gc,int g,bf16*P,const float*ST,const float*DT,const float*dtb,const float*alog,const float*dsk,char*shm,const int tid){
  const int lane=tid&63,r32=lane&31,hi=lane>>5; const int wid=__builtin_amdgcn_readfirstlane(tid>>6); const int e=wid>>1,pr=wid&1;
  const int r0=gc*128; const lds_cptr s3=(lds_cptr)shm;
  typedef __attribute__((address_space(3))) u32x4* lds_u4p; typedef __attribute__((address_space(3))) float* lds_fp;
  #define MF(a,b,c) __builtin_amdgcn_mfma_f32_32x32x16_bf16(a,b,c,0,0,0)
  #pragma unroll
  for(int i=0;i<4;++i){ const int q=tid+512*i,row=q&127,ch=q>>7; *(lds_u4p)(s3+SO_C+ch*2048+row*16)=*(const u32x4*)(P+(size_t)(r0+row)*DM+5376+g*128+ch*8); }
  __syncthreads();
  for(int blk=wid;blk<10;blk+=8){ const int lb=(blk<1)?0:(blk<3)?1:(blk<6)?2:3, sb=blk-lb*(lb+1)/2; f32x16 acc={};
    const bf16*bp=P+(size_t)(r0+32*sb+r32)*DM+5120+g*128+8*hi;
    #pragma unroll
    for(int ks=0;ks<8;++ks){ const bf16x8 a=*reinterpret_cast<const bf16x8*>(bp+16*ks); const bf16x8 b=*(const __attribute__((address_space(3))) bf16x8*)(s3+SO_C+(2*ks+hi)*2048+(32*lb+r32)*16); acc=MF(a,b,acc); }
    #pragma unroll
    for(int r=0;r<16;++r)*(lds_fp)(s3+SO_CBT+blk*4096+r*256+lane*4)=acc[r]; }
  #pragma unroll 1
  for(int rd=0;rd<2;++rd){
    __syncthreads();
    const int h=8*g+4*rd+e;
    const lds_fp sc=(lds_fp)(s3+SO_SC+e*1024);
    ssd_scalars(sc,DT,r0,h,dtb[h],alog[h],lane);
    #pragma unroll
    for(int i=0;i<8;++i){ const int row=64*pr+16*(i&3)+(lane>>2); const u32x4 v=*(const u32x4*)(P+(size_t)(r0+row)*DM+4096+h*64+(i>>2)*32+(lane&3)*8); const float f=sc[128+row];
      u32x4 w; w.x=cvtpk_s(bfl(v.x)*f,bfh(v.x)*f); w.y=cvtpk_s(bfl(v.y)*f,bfh(v.y)*f); w.z=cvtpk_s(bfl(v.z)*f,bfh(v.z)*f); w.w=cvtpk_s(bfl(v.w)*f,bfh(v.w)*f);
      *(lds_u4p)(s3+SO_XD+e*16384+pr*8192+i*1024+lane*16)=w; }
    __syncthreads();
    const float dh=dsk[h];
    #pragma unroll 1
    for(int li=0;li<2;++li){ const int lb=pr?(1+li):(3*li);
      f32x16 acc[2]; acc[0]=f32x16{}; acc[1]=f32x16{};
      const float*pp=ST+(((size_t)gc*16+h)*64+r32)*128+8*hi;
      #pragma unroll
      for(int ks=0;ks<8;++ks){ const bf16x8 a=*(const __attribute__((address_space(3))) bf16x8*)(s3+SO_C+(2*ks+hi)*2048+(32*lb+r32)*16);
        #pragma unroll
        for(int pb=0;pb<2;++pb){ const float*q=pp+(size_t)pb*32*128+16*ks; const f32x4 x0=*(const f32x4*)q,x1=*(const f32x4*)(q+4);
          u32x4 w; w.x=cvtpk_s(x0[0],x0[1]); w.y=cvtpk_s(x0[2],x0[3]); w.z=cvtpk_s(x1[0],x1[1]); w.w=cvtpk_s(x1[2],x1[3]);
          acc[pb]=MF(a,__builtin_bit_cast(bf16x8,w),acc[pb]); } }
      #pragma unroll
      for(int r=0;r<16;++r){ const float f=__builtin_amdgcn_exp2f(sc[32*lb+crow(r,hi)]); acc[0][r]*=f; acc[1][r]*=f; }
      const float al=sc[32*lb+r32];
      for(int sb=0;sb<=lb;++sb){ const int blk=lb*(lb+1)/2+sb; float gv[16];
        #pragma unroll
        for(int r=0;r<16;++r){ const float c=*(lds_fp)(s3+SO_CBT+blk*4096+r*256+lane*4); const int sr=crow(r,hi);
          const float v=c*__builtin_amdgcn_exp2f(al-sc[32*sb+sr]); gv[r]=(sb==lb&&sr>r32)?0.f:v; }
        u32x4 w0,w1; w0.x=cvtpk_s(gv[0],gv[1]); w0.y=cvtpk_s(gv[2],gv[3]); w0.z=cvtpk_s(gv[4],gv[5]); w0.w=cvtpk_s(gv[6],gv[7]);
        w1.x=cvtpk_s(gv[8],gv[9]); w1.y=cvtpk_s(gv[10],gv[11]); w1.z=cvtpk_s(gv[12],gv[13]); w1.w=cvtpk_s(gv[14],gv[15]);
        const lds_cptr vb=s3+SO_XD+e*16384+(sb>>1)*8192+((lane>>4)&1)*32+(lane&3)*8+(4*hi+((lane&15)>>2))*64;
        #pragma unroll
        for(int pb=0;pb<2;++pb){ acc[pb]=MF(__builtin_bit_cast(bf16x8,w0),vfrag(vb,(sb&1)*2+4*pb),acc[pb]); acc[pb]=MF(__builtin_bit_cast(bf16x8,w1),vfrag(vb,(sb&1)*2+1+4*pb),acc[pb]); } }
      #pragma unroll
      for(int pb=0;pb<2;++pb)
        #pragma unroll
        for(int r=0;r<16;++r){ bf16*zp=P+(size_t)(r0+32*lb+crow(r,hi))*DM+h*64+32*pb+r32; const float x=__bfloat162float(zp[4096]),z=__bfloat162float(zp[0]);
          const float v=(acc[pb][r]+dh*x)*z*__builtin_amdgcn_rcpf(1.f+__expf(-z)); zp[0]=__float2bfloat16(v); }
    }
  }
  #undef MF
  __syncthreads();
}
constexpr int SS_B=0, SS_X=32768, SS_SC=98304, SS_END=SS_SC+4096;
__device__ __forceinline__ void ssd_state_unit(int gc,int g,const bf16*P,float*ST,float*CD,const float*DT,const float*dtb,const float*alog,char*shm,const int tid){
  const int lane=tid&63,r32=lane&31,hi=lane>>5; const int wid=__builtin_amdgcn_readfirstlane(tid>>6); const int e=wid>>1,pr=wid&1;
  const int r0=gc*128; const lds_cptr s3=(lds_cptr)shm;
  typedef __attribute__((address_space(3))) u32x4* lds_u4p; typedef __attribute__((address_space(3))) float* lds_fp;
  #pragma unroll
  for(int i=0;i<4;++i){ const int row=64*(i>>1)+16*(wid&3)+(lane>>2),col=64*(i&1)+(wid>>2)*32+(lane&3)*8;
    *(lds_u4p)(s3+SS_B+i*8192+wid*1024+lane*16)=*(const u32x4*)(P+(size_t)(r0+row)*DM+5120+g*128+col); }
  const int voff=((lane>>4)&1)*32+(lane&3)*8+(4*hi+((lane&15)>>2))*64;
  #pragma unroll 1
  for(int rd=0;rd<2;++rd){
    __syncthreads();
    const int h=8*g+4*rd+e;
    const lds_fp sc=(lds_fp)(s3+SS_SC+e*1024);
    ssd_scalars(sc,DT,r0,h,dtb[h],alog[h],lane);
    const float aend=sc[127];
    #pragma unroll
    for(int i=0;i<8;++i){ const int row=64*pr+16*(i&3)+(lane>>2); const u32x4 v=*(const u32x4*)(P+(size_t)(r0+row)*DM+4096+h*64+(i>>2)*32+(lane&3)*8); const float f=sc[128+row]*__builtin_amdgcn_exp2f(aend-sc[row]);
      u32x4 w; w.x=cvtpk_s(bfl(v.x)*f,bfh(v.x)*f); w.y=cvtpk_s(bfl(v.y)*f,bfh(v.y)*f); w.z=cvtpk_s(bfl(v.z)*f,bfh(v.z)*f); w.w=cvtpk_s(bfl(v.w)*f,bfh(v.w)*f);
      *(lds_u4p)(s3+SS_X+e*16384+pr*8192+i*1024+lane*16)=w; }
    __syncthreads();
    f32x16 acc[4]; acc[0]=f32x16{}; acc[1]=f32x16{}; acc[2]=f32x16{}; acc[3]=f32x16{};
    #pragma unroll
    for(int ks=0;ks<8;++ks){ const int rh=ks>>2,kk=ks&3;
      const bf16x8 a=vfrag(s3+SS_X+e*16384+rh*8192+voff,kk+4*pr);
      #pragma unroll
      for(int nb=0;nb<4;++nb){ const bf16x8 bq=vfrag(s3+SS_B+(rh*2+(nb>>1))*8192+voff,kk+4*(nb&1)); acc[nb]=__builtin_amdgcn_mfma_f32_32x32x16_bf16(a,bq,acc[nb],0,0,0); } }
    float*dst=ST+(((size_t)gc*16+h)*64+32*pr)*128+r32;
    #pragma unroll
    for(int nb=0;nb<4;++nb)
      #pragma unroll
      for(int r=0;r<16;++r)dst[(size_t)crow(r,hi)*128+32*nb]=acc[nb][r];
    if(pr==0&&lane==0)CD[gc*16+h]=__builtin_amdgcn_exp2f(aend);
  }
  __syncthreads();
}
template<int THRL=8> __device__ __forceinline__ void diff_attn_phase(char*lds,const bf16*P,bf16*OD,const __attribute__((address_space(3))) float*tab,int vcu,int G,const int tid){
  for(int st=vcu;st<256;st+=G){
    #pragma unroll 1
    for(int i=0;i<4;++i){ int st_=st; asm volatile("":"+s"(st_)); int tid_=tid; asm volatile("":"+v"(tid_));
      const int bhv=st_>>2,s=st_&3,b=bhv>>4,hv=bhv&15,h=hv>>2,m=(hv>>1)&1,vh=hv&1;
      const bf16*Q=P+1536+h*128+m*64,*K=P+3072+h*128+m*64,*V=P+3584+h*128+vh*64; bf16*O=OD+hv*64;
      const int qb=(i==0)?s:(i==1)?7-s:(i==2)?8+s:15-s; attn_unit<THRL>(b,qb,Q,K,V,O,lds,tab+h*TAB_N,tid_); } }
}
#undef SBAR
#undef WAIT_BAR
}
#define GAS __attribute__((address_space(1)))
typedef GAS unsigned gu32;
#define RLX_AGENT __ATOMIC_RELAXED, __HIP_MEMORY_SCOPE_AGENT
#define XB_TMO      128
#define XB_XCNT(j)  (256  + 64 * (j))
#define XB_XSUB(j)  (1280 + 64 * (j))
#define XB_XGEN(j)  (2304 + 64 * (j))
#define XB_TOP      3328
#define XB_TOPGEN   3392
#define XCD_BAR_WORDS 3456
#define XB_SPIN_CAP (1u << 18)

__device__ __forceinline__ unsigned xb_ld(unsigned* p)              { return __hip_atomic_load(p, __ATOMIC_RELAXED, __HIP_MEMORY_SCOPE_AGENT); }
__device__ __forceinline__ unsigned xb_add(unsigned* p, unsigned v) { return __hip_atomic_fetch_add(p, v, __ATOMIC_RELAXED, __HIP_MEMORY_SCOPE_AGENT); }
__device__ __forceinline__ unsigned xb_xcc_id() { return (unsigned)__builtin_amdgcn_s_getreg((3 << 11) | 20) & 0xFu; }
#define XB_SPIN(cond, bar) do { unsigned _sp = 0; while (cond) { __builtin_amdgcn_s_sleep(1); \
    if ((++_sp & 255u) == 0u) { if (xb_ld(&(bar)[XB_TMO])) break; if (_sp > XB_SPIN_CAP) { atomicAdd(&(bar)[XB_TMO], 1u); break; } } } } while (0)

struct XcdBarrier {
    unsigned* bar; unsigned x; bool lead;
    volatile LAS unsigned* st;
};

__device__ __forceinline__ XcdBarrier xcd_barrier_post(unsigned* bar, volatile LAS unsigned* st) {
    XcdBarrier b; b.bar = bar; b.x = xb_xcc_id(); b.st = st; b.lead = threadIdx.x == 0;
    if (threadIdx.x == 0) (void)xb_add(&bar[XB_XCNT(b.x)], 1u);
    return b;
}
__device__ __forceinline__ void xcd_barrier_complete(unsigned* bar, unsigned x, unsigned& nloc, unsigned& nx) {
    const unsigned G = gridDim.x * gridDim.y * gridDim.z;
    unsigned sum, cnt, mine, sp = 0u;
    for (;;) {
        sum = 0u; cnt = 0u; mine = 0u;
#pragma unroll
        for (unsigned j = 0; j < 16; ++j) { const unsigned c = xb_ld(&bar[XB_XCNT(j)]); sum += c; cnt += (c > 0u) ? 1u : 0u; mine = (j == x) ? c : mine; }
        if (sum == G) break;
        __builtin_amdgcn_s_sleep(1);
        if ((++sp & 255u) == 0u) { if (xb_ld(&bar[XB_TMO])) break; if (sp > XB_SPIN_CAP) { atomicAdd(&bar[XB_TMO], 1u); break; } }
    }
    nloc = mine > 0u ? mine : 1u; nx = cnt > 0u ? cnt : 1u;
}

__device__ __forceinline__ void xcd_barrier(const XcdBarrier& b) {
    asm volatile("s_waitcnt vmcnt(0)" ::: "memory");
    __syncthreads();
    if (b.lead) {
        unsigned* bar = b.bar;
        __builtin_amdgcn_s_waitcnt(0);
        unsigned nloc = b.st[0], nx = b.st[1];
        if (nloc == 0u) { xcd_barrier_complete(bar, b.x, nloc, nx); b.st[0] = nloc; b.st[1] = nx; }
        const unsigned old = xb_add(&bar[XB_XSUB(b.x)], 1u);
        const unsigned gen = old / nloc;
        if (old + 1u == (gen + 1u) * nloc) {
            __builtin_amdgcn_fence(__ATOMIC_RELEASE, "agent");
            asm volatile("s_waitcnt vmcnt(0)" ::: "memory");
            const unsigned og = xb_add(&bar[XB_TOP], 1u);
            const unsigned tg = og / nx;
            if (og + 1u == (tg + 1u) * nx) xb_add(&bar[XB_TOPGEN], 1u);
            else XB_SPIN(xb_ld(&bar[XB_TOPGEN]) == tg, bar);
            __builtin_amdgcn_fence(__ATOMIC_ACQUIRE, "agent");
            xb_add(&bar[XB_XGEN(b.x)], 1u);
            asm volatile("s_waitcnt vmcnt(0)" ::: "memory");
        } else {
            XB_SPIN(xb_ld(&bar[XB_XGEN(b.x)]) == gen, bar);
            __builtin_amdgcn_fence(__ATOMIC_ACQUIRE, "agent");
            asm volatile("s_waitcnt vmcnt(0)" ::: "memory");
        }
    }
    __syncthreads();
}
DEV void ph_diff_combine(const Params& p, int l, int gw, int ngw, int lane) {
    bf16_t* P = (bf16_t*)(p.ws + WS_P); const bf16_t* OD = (const bf16_t*)(p.ws + WS_OD); const float* misc = (const float*)(p.ws + WS_MISC);
    const float lam = misc[l]; const float linit = lambda_init_of(l);
    const float g0 = p.in[I_SUB][(size_t)l * 128 + 2 * lane] * (1.f - linit), g1 = p.in[I_SUB][(size_t)l * 128 + 2 * lane + 1] * (1.f - linit);
    for (int row = gw; row < M; row += ngw) {
#pragma unroll
        for (int h = 0; h < 4; ++h) { const unsigned o0 = *(const unsigned*)(OD + (size_t)row * 1024 + h * 256 + 2 * lane), o1 = *(const unsigned*)(OD + (size_t)row * 1024 + h * 256 + 128 + 2 * lane);
            const float ya = bflo(o0) - lam * bflo(o1), yb = bfhi(o0) - lam * bfhi(o1);
            const float rs = rsqrtf(wave_sum(ya * ya + yb * yb, lane) * (1.f / 128.f) + EPS);
            *(unsigned*)(P + (size_t)row * PW + PDQ + h * 128 + 2 * lane) = pk2(ya * rs * g0, yb * rs * g1); }
    }
}
constexpr int LDS_TAB_OFF = 86016;
DEV void ph_diff_table(const Params& p, LAS unsigned char* lds, int tid) {
    LAS float* tab = (LAS float*)(lds + LDS_TAB_OFF); const float* bt = (const float*)(p.ws + WS_MISC) + 64;
    for (int j = tid; j < 4 * attn_body::TAB_N; j += NTHREADS) { const int h = j / attn_body::TAB_N, d = j % attn_body::TAB_N - attn_body::TAB_PAD;
        tab[j] = (d >= 0 && d < 127) ? (bt[h * 128 + d] - bt[h * 128 + 127]) * 1.4426950408889634f : 0.f; }
}
constexpr int LDS_MISC_OFF = 147456 - 64;
DEV Params load_params(const __attribute__((address_space(4))) Params* pp) { Params q;
#pragma unroll
    for (int i = 0; i < 26; ++i) q.in[i] = pp->in[i];
    q.out = pp->out; q.ws = pp->ws; return q; }
#define KARGS() const __attribute__((address_space(4))) Params* pp_ = (const __attribute__((address_space(4))) Params*)__builtin_amdgcn_kernarg_segment_ptr(); asm volatile("" : "+s"(pp_)); const Params p = load_params(pp_)
__global__ void __launch_bounds__(NTHREADS, 2) mk_fwd(Params p_arg) {
    extern __shared__ __attribute__((aligned(16))) unsigned char lds_raw[];
    LAS unsigned char* lds = (LAS unsigned char*)lds_raw;
    volatile LAS unsigned* MISC = (volatile LAS unsigned*)(lds + LDS_MISC_OFF);
    const int wave_s = __builtin_amdgcn_readfirstlane((int)threadIdx.x >> 6);
    if (threadIdx.x < 16) MISC[threadIdx.x] = 0u;
    __syncthreads();
    { KARGS(); (void)xcd_barrier_post((unsigned*)(p.ws + WS_BAR), MISC + 8); }
#define IDS() KARGS(); const int wave = wave_s; const int lane = olane(); const int tid = wave * 64 + lane; const int gw = BIDX * NWAVES + wave, ngw = GDIM * NWAVES; (void)lane; (void)gw; (void)ngw; \
    bf16_t* wt = (bf16_t*)(p.ws + WS_WT); bf16_t* XN = (bf16_t*)(p.ws + WS_XN); bf16_t* P = (bf16_t*)(p.ws + WS_P); bf16_t* H = (bf16_t*)(p.ws + WS_H); (void)wt; (void)XN; (void)P; (void)H; \
    const float* modl = (const float*)(p.ws + WS_MOD) + (size_t)l * NB * MODW; const float* xin = (l == 0) ? p.in[I_X] : p.out; (void)modl; (void)xin;
#define GEMM(A_, lda_, W_, N_, K_, EPI, ...) do { pg8::Gemm g{A_, W_, M, N_, K_, lda_}; pg8::StaticOrder So; So.init(M, N_, (int)GDIM, (int)BIDX); pg8::EPI E{__VA_ARGS__}; \
        pg8::gemm_phase<pg8::EPI, pg8::StaticOrder, true, true>(lds, g, So, E, tid); } while (0)
#define SYNC() do { KARGS(); XcdBarrier bar_; bar_.bar = (unsigned*)(p.ws + WS_BAR); bar_.x = xb_xcc_id(); bar_.st = (volatile LAS unsigned*)(lds + LDS_MISC_OFF) + 8; bar_.lead = (wave_s == 0) && (olane() == 0); xcd_barrier(bar_); } while (0)
#pragma unroll 1
    for (int l = 0; l < NL; ++l) {
        { IDS(); ph_convert(p, l, lds, gw, ngw, wave, lane); if (l == 0) ph_mod(p, lds, tid, wave, lane); }
        SYNC();
        { IDS(); ph_norm(xin, p.in[I_N1] + (size_t)l * D, modl, 0, 1, XN, gw, ngw, lane); }
        SYNC();
        { IDS(); GEMM(XN, D, wt + WT_13A / 2, 2 * DFF, D, EpiSwigluT, H); }
        SYNC();
        { IDS(); GEMM(H, DFF, wt + WT_2A / 2, D, DFF, EpiResidT, xin, p.out, modl + 2 * D, 0.5f); }
        SYNC();
        { IDS(); ph_norm(p.out, p.in[I_NM] + (size_t)l * D, modl, 3, 4, XN, gw, ngw, lane); }
        SYNC();
        { IDS(); GEMM(XN, D, wt + WT_IN / 2, NIN, D, EpiInT, P, (float*)(p.ws + WS_DT), (bf16_t*)(p.ws + WS_HALO)); }
        SYNC();
        { IDS(); ph_conv(p, l, tid); }
        SYNC();
        { IDS(); const int G = GDIM;
#pragma unroll 1
          for (int unit = BIDX; unit < GCH * 2; unit += G) { int u_ = unit; asm volatile("" : "+s"(u_)); int tid_ = tid; asm volatile("" : "+v"(tid_));
            attn_body::ssd_state_unit(u_ >> 1, u_ & 1, (const attn_body::bf16*)P, (float*)(p.ws + WS_ST), (float*)(p.ws + WS_CD), (const float*)(p.ws + WS_DT), p.in[I_DTB] + l * 16, p.in[I_ALOG] + l * 16, (char*)lds_raw, tid_); } }
        { IDS(); const int G = GDIM, bid = BIDX; const int vcu = (G % 8 == 0) ? (bid % 8) * (G / 8) + bid / 8 : bid;
          attn_body::sb_attn_phase((char*)lds_raw, (attn_body::bf16*)P, vcu, G, tid); }
        { IDS(); __syncthreads(); ph_diff_table(p, lds, tid); __syncthreads(); const int G = GDIM, bid = BIDX; const int vcu = (G % 8 == 0) ? (bid % 8) * (G / 8) + bid / 8 : bid;
          attn_body::diff_attn_phase<8>((char*)lds_raw, (const attn_body::bf16*)P, (attn_body::bf16*)(p.ws + WS_OD), (const LAS float*)(lds + LDS_TAB_OFF), vcu, G, tid); }
        SYNC();
        { IDS(); ph_ssd_scan(p, tid); }
        SYNC();
        { IDS(); const int G = GDIM;
#pragma unroll 1
          for (int unit = BIDX; unit < GCH * 2; unit += G) { int u_ = unit; asm volatile("" : "+s"(u_)); int tid_ = tid; asm volatile("" : "+v"(tid_));
            attn_body::ssd_out_unit(u_ >> 1, u_ & 1, (attn_body::bf16*)P, (const float*)(p.ws + WS_ST), (const float*)(p.ws + WS_DT), p.in[I_DTB] + l * 16, p.in[I_ALOG] + l * 16, p.in[I_SD] + l * 16, (char*)lds_raw, tid_); } }
        SYNC();
        { IDS(); ph_mixfinal(p, l, gw, ngw, lane); ph_diff_combine(p, l, gw, ngw, lane); }
        SYNC();
        { IDS(); GEMM(P, PW, wt + WT_OUT / 2, D, 2048, EpiResidT, p.out, p.out, modl + 5 * D, 1.0f); }
        SYNC();
        { IDS(); ph_norm(p.out, p.in[I_N2] + (size_t)l * D, modl, 6, 7, XN, gw, ngw, lane); }
        SYNC();
        { IDS(); GEMM(XN, D, wt + WT_13B / 2, 2 * DFF, D, EpiSwigluT, H); }
        SYNC();
        { IDS(); GEMM(H, DFF, wt + WT_2B / 2, D, DFF, EpiResidT, p.out, p.out, modl + 8 * D, 0.5f); }
        SYNC();
    }
    { const int l = 0; IDS(); ph_final_norm(p.out, p.in[I_FN], gw, ngw, lane); }
}

constexpr int LDS_BYTES = 147456;
extern "C" void kernel_launch(void* const* d_in, const int* in_sizes, int n_in, void* d_out, int out_size, void* d_ws, size_t ws_size, hipStream_t stream) {
    static int grid = 0;
    if (grid == 0) {
        if (n_in != 26 || out_size != M * D || ws_size < WS_END) { fprintf(stderr, "kernel_launch: unexpected shapes (n_in %d out %d ws %zu)\n", n_in, out_size, ws_size); grid = -1; return; }
        int dev = 0, cus = 0;
        if (hipGetDevice(&dev) != hipSuccess || hipDeviceGetAttribute(&cus, hipDeviceAttributeMultiprocessorCount, dev) != hipSuccess) { grid = -1; return; }
        if (hipFuncSetAttribute((const void*)mk_fwd, hipFuncAttributeMaxDynamicSharedMemorySize, LDS_BYTES) != hipSuccess) { grid = -1; return; }
        grid = cus;
    }
    if (grid < 0) return;
    Params p{};
    for (int i = 0; i < 26; ++i) p.in[i] = (const float*)d_in[i];
    p.out = (float*)d_out; p.ws = (unsigned char*)d_ws;
    (void)hipMemsetAsync((char*)d_ws + WS_BAR, 0, 64 * KiB, stream);
    hipLaunchKernelGGL(mk_fwd, dim3(grid), dim3(NTHREADS), LDS_BYTES, stream, p);

}
```

```cpp
#include <hip/hip_runtime.h>
#include <cstdio>
#include <cstdint>
#include <cmath>

#define DEV __device__ __forceinline__
#define LAS __attribute__((address_space(3)))
typedef unsigned short bf16_t;
typedef unsigned u32x4 __attribute__((ext_vector_type(4)));
typedef unsigned u32x2 __attribute__((ext_vector_type(2)));
typedef float f32x4 __attribute__((ext_vector_type(4)));

constexpr int D = 1024, NB = 4, S = 4096, M = NB * S, NL = 2, DFF = 2816, MODW = 9 * D;
constexpr int PW = 5632, NIN = 5888;
constexpr int PZ = 0, PSQ = 1024, PDQ = 1536, PSK = 2048, PSV = 2560, PDK = 3072, PDV = 3584, PXBC = 4096;
constexpr int PXS = PXBC, PBM = PXBC + 1024, PCM = PXBC + 1280;
constexpr int CH = 128, NCHUNK = S / CH, GCH = NB * NCHUNK;
constexpr float EPS = 1e-6f;
constexpr int NTHREADS = 512, NWAVES = 8;

constexpr size_t KiB = 1024, MiB = 1024 * 1024;
constexpr size_t WS_BAR = 0;
constexpr size_t WS_MOD = 64 * KiB;
constexpr size_t WS_ROWSS = 352 * KiB;
constexpr size_t WS_CD = 480 * KiB;
constexpr size_t WS_MISC = 488 * KiB;
constexpr size_t WS_HALO = 512 * KiB;
constexpr size_t WS_WT = 2 * MiB;
constexpr size_t WT_13A = 0, WT_2A = 11 * MiB, WT_IN = 16 * MiB + 512 * KiB, WT_OUT = 28 * MiB, WT_13B = 32 * MiB, WT_2B = 43 * MiB;
constexpr size_t WS_XN = 51 * MiB;
constexpr size_t WS_ST = 51 * MiB;
constexpr size_t WS_P = 115 * MiB;
constexpr size_t WS_H = WS_P;
constexpr size_t WS_DT = 291 * MiB;
constexpr size_t WS_OD = 292 * MiB;
constexpr size_t WS_END = 324 * MiB;

struct Params { const float* in[26]; float* out; unsigned char* ws; };
enum { I_X = 0, I_C, I_ADAW, I_ADAB, I_N1, I_W13A, I_W2A, I_NM, I_WIN, I_CW, I_CB, I_DTB, I_ALOG, I_SD, I_SN, I_LQ1, I_LK1, I_LQ2, I_LK2, I_SUB, I_RB, I_WOUT, I_N2, I_W13B, I_W2B, I_FN };

DEV float bf2f(bf16_t v) { return __uint_as_float(((unsigned)v) << 16); }
DEV float bflo(unsigned w) { return __uint_as_float(w << 16); }
DEV float bfhi(unsigned w) { return __uint_as_float(w & 0xffff0000u); }
DEV unsigned f2bf(float f) { unsigned u = __float_as_uint(f); return (u + 0x7fffu + ((u >> 16) & 1u)) >> 16; }
DEV unsigned pk2(float lo, float hi) { return f2bf(lo) | (f2bf(hi) << 16); }
DEV float siluf(float x) { return x / (1.f + __expf(-x)); }
DEV float softplusf(float x) { return fmaxf(x, 0.f) + __logf(1.f + __expf(-fabsf(x))); }
DEV float lane_get(float v, int src) { return __int_as_float(__builtin_amdgcn_ds_bpermute(src << 2, __float_as_int(v))); }
DEV float wave_sum(float v, int lane) {
#pragma unroll
    for (int o = 1; o < 64; o <<= 1) v += lane_get(v, lane ^ o);
    return v;
}
DEV float wave_max(float v, int lane) {
#pragma unroll
    for (int o = 1; o < 64; o <<= 1) v = fmaxf(v, lane_get(v, lane ^ o));
    return v;
}
DEV float wave_incl_scan(float v, int lane) {
#pragma unroll
    for (int o = 1; o < 64; o <<= 1) { float t = lane_get(v, lane - o); if (lane >= o) v += t; }
    return v;
}
#define BIDX obid()
#define GDIM ((int)gridDim.x)
#define LDS_WAIT() asm volatile("s_waitcnt lgkmcnt(0)" ::: "memory")
DEV float lambda_init_of(int l) { return l == 0 ? 0.2f : 0.35550906759097f; }
DEV int olane() { int l; asm volatile("v_mbcnt_lo_u32_b32 %0, -1, 0\n\tv_mbcnt_hi_u32_b32 %0, -1, %0" : "=v"(l)); return l; }
DEV int obid() { int b = blockIdx.x; asm volatile("" : "+s"(b)); return b; }

DEV void transpose_item(const float* W, int K, int N, bf16_t* WT, int dst_n0, int src_n0, int nvalid, int k0, LAS float* scr, int lane) {
    const int c = lane & 31;
#pragma unroll 8
    for (int i = 0; i < 32; ++i) { const int kk = 2 * i + (lane >> 5); scr[kk * 33 + c] = (c < nvalid) ? W[(size_t)(k0 + kk) * N + src_n0 + c] : 0.f; }
    LDS_WAIT();
    const int c8 = lane & 7;
#pragma unroll
    for (int j = 0; j < 4; ++j) { const int n = (lane >> 3) + 8 * j; const LAS float* s = scr + (8 * c8) * 33 + n;
        u32x4 o; o.x = pk2(s[0 * 33], s[1 * 33]); o.y = pk2(s[2 * 33], s[3 * 33]); o.z = pk2(s[4 * 33], s[5 * 33]); o.w = pk2(s[6 * 33], s[7 * 33]);
        *(u32x4*)(WT + (size_t)(dst_n0 + n) * K + k0 + 8 * c8) = o; }
    LDS_WAIT();
}
DEV void src_map_swiglu(int n0, int& src, int& nv) { const int pn = n0 >> 8, bj = (n0 >> 7) & 1, i0 = n0 & 127; src = bj * DFF + pn * 128 + i0; nv = 32; }
DEV void src_map_in(int n0, int& src, int& nv) {
    nv = 32;
    if (n0 < 1024) src = n0;
    else if (n0 < 1536) src = 2576 + (n0 - 1024);
    else if (n0 < 2048) src = 4112 + (n0 - 1536);
    else if (n0 < 2560) src = 3088 + (n0 - 2048);
    else if (n0 < 3072) src = 3600 + (n0 - 2560);
    else if (n0 < 3584) src = 4624 + (n0 - 3072);
    else if (n0 < 4096) src = 5136 + (n0 - 3584);
    else if (n0 < 5632) src = 1024 + (n0 - 4096);
    else if (n0 == 5632) { src = 2560; nv = 16; }
    else { src = 0; nv = 0; }
}
DEV void ph_convert(const Params& p, int l, LAS unsigned char* lds, int gw, int ngw, int wave, int lane) {
    LAS float* scr = (LAS float*)(lds + wave * 16384);
    bf16_t* wt = (bf16_t*)(p.ws + WS_WT);
    constexpr int I13 = 16 * 176, I2 = 44 * 32, IIN = 16 * 184, IOUT = 32 * 32;
    constexpr int NITEMS = 2 * I13 + 2 * I2 + IIN + IOUT;
    for (int it = gw; it < NITEMS; it += ngw) {
        int r = it;
        if (r < 2 * I13) { const int which = r / I13; r %= I13; const int kb = r / 176, nb = r % 176; int src, nv; src_map_swiglu(nb * 32, src, nv);
            transpose_item(p.in[which ? I_W13B : I_W13A] + (size_t)l * D * 2 * DFF, D, 2 * DFF, wt + (which ? WT_13B : WT_13A) / 2, nb * 32, src, nv, kb * 64, scr, lane); continue; }
        r -= 2 * I13;
        if (r < 2 * I2) { const int which = r / I2; r %= I2; const int kb = r / 32, nb = r % 32;
            transpose_item(p.in[which ? I_W2B : I_W2A] + (size_t)l * DFF * D, DFF, D, wt + (which ? WT_2B : WT_2A) / 2, nb * 32, nb * 32, 32, kb * 64, scr, lane); continue; }
        r -= 2 * I2;
        if (r < IIN) { const int kb = r / 184, nb = r % 184; int src, nv; src_map_in(nb * 32, src, nv);
            transpose_item(p.in[I_WIN] + (size_t)l * D * 5648, D, 5648, wt + WT_IN / 2, nb * 32, src, nv, kb * 64, scr, lane); continue; }
        r -= IIN;
        { const int kb = r / 32, nb = r % 32;
            transpose_item(p.in[I_WOUT] + (size_t)l * 2048 * D, 2048, D, wt + WT_OUT / 2, nb * 32, nb * 32, 32, kb * 64, scr, lane); }
    }
}

DEV void ph_mod(const Params& p, LAS unsigned char* lds, int tid, int wave, int lane) {
    LAS float* cond = (LAS float*)lds;
    LAS float* part = (LAS float*)(lds + 16384);
    __syncthreads();
    for (int i = tid; i < NB * D; i += NTHREADS) cond[i] = siluf(p.in[I_C][i]);
    __syncthreads();
    float* mod = (float*)(p.ws + WS_MOD);
    for (int unit = BIDX; unit < NL * 144; unit += GDIM) {
        const int l = unit / 144, j = (unit % 144) * 64 + lane;
        const float* w = p.in[I_ADAW] + (size_t)l * D * MODW + j;
        float a0 = 0.f, a1 = 0.f, a2 = 0.f, a3 = 0.f;
        for (int k = wave * 128; k < wave * 128 + 128; ++k) { const float wv = w[(size_t)k * MODW]; a0 += cond[k] * wv; a1 += cond[D + k] * wv; a2 += cond[2 * D + k] * wv; a3 += cond[3 * D + k] * wv; }
        part[(wave * 4 + 0) * 64 + lane] = a0; part[(wave * 4 + 1) * 64 + lane] = a1; part[(wave * 4 + 2) * 64 + lane] = a2; part[(wave * 4 + 3) * 64 + lane] = a3;
        __syncthreads();
        if (wave < 4) { float s = 0.f;
#pragma unroll
            for (int w8 = 0; w8 < 8; ++w8) s += part[(w8 * 4 + wave) * 64 + lane];
            mod[((size_t)l * NB + wave) * MODW + j] = s + p.in[I_ADAB][(size_t)l * MODW + j]; }
        __syncthreads();
    }
    if (BIDX == 0) {
        float* misc = (float*)(p.ws + WS_MISC);
        if (wave < NL) { int l = wave; asm volatile("" : "+s"(l));
            const float s1 = wave_sum(p.in[I_LQ1][l * 64 + lane] * p.in[I_LK1][l * 64 + lane], lane);
            const float s2 = wave_sum(p.in[I_LQ2][l * 64 + lane] * p.in[I_LK2][l * 64 + lane], lane);
            const float linit = lambda_init_of(l);
            if (lane == 0) misc[l] = expf(s1) - expf(s2) + linit; }
        if (tid < 512) { const int h = tid >> 7, d = tid & 127; int bk;
            if (d < 16) bk = d; else { bk = 16 + (int)(logf((float)d / 16.f) / logf(8.f) * 16.f); if (bk > 31) bk = 31; }
            misc[64 + h * 128 + d] = p.in[I_RB][bk * 4 + h]; }
    }
}

DEV void ph_norm(const float* xsrc, const float* g, const float* modl, int ishift, int iscale, bf16_t* XN, int gw, int ngw, int lane) {
    for (int m = gw; m < M; m += ngw) {
        const int b = m / S; const float* xr = xsrc + (size_t)m * D;
        f32x4 v[4]; float ss = 0.f;
#pragma unroll
        for (int j = 0; j < 4; ++j) { v[j] = *(const f32x4*)(xr + 4 * lane + 256 * j); ss += (v[j].x * v[j].x + v[j].y * v[j].y) + (v[j].z * v[j].z + v[j].w * v[j].w); }
        const float rstd = rsqrtf(wave_sum(ss, lane) * (1.f / D) + EPS);
        const float* sh = modl + (size_t)b * MODW + ishift * D; const float* sc = modl + (size_t)b * MODW + iscale * D;
#pragma unroll
        for (int j = 0; j < 4; ++j) { const int c = 4 * lane + 256 * j; const f32x4 gg = *(const f32x4*)(g + c), s1 = *(const f32x4*)(sc + c), s0 = *(const f32x4*)(sh + c);
            const f32x4 o = v[j] * rstd * gg * (s1 + 1.f) + s0; u32x2 w; w.x = pk2(o.x, o.y); w.y = pk2(o.z, o.w); *(u32x2*)(XN + (size_t)m * D + c) = w; }
    }
}
DEV void ph_final_norm(float* x, const float* g, int gw, int ngw, int lane) {
    for (int m = gw; m < M; m += ngw) {
        float* xr = x + (size_t)m * D; f32x4 v[4]; float ss = 0.f;
#pragma unroll
        for (int j = 0; j < 4; ++j) { v[j] = *(const f32x4*)(xr + 4 * lane + 256 * j); ss += (v[j].x * v[j].x + v[j].y * v[j].y) + (v[j].z * v[j].z + v[j].w * v[j].w); }
        const float rstd = rsqrtf(wave_sum(ss, lane) * (1.f / D) + EPS);
#pragma unroll
        for (int j = 0; j < 4; ++j) { const int c = 4 * lane + 256 * j; const f32x4 gg = *(const f32x4*)(g + c); *(f32x4*)(xr + c) = v[j] * rstd * gg; }
    }
}

struct EpiSwiglu { bf16_t* H;
    DEV void elem2(int row, int j, float a, float u) const { H[(size_t)row * DFF + j] = (bf16_t)f2bf(siluf(a) * u); } };
struct EpiResid { const float* xsrc; float* out; const float* gate; float f;
    DEV void elem(int row, int col, float v) const { const int b = row / S; const size_t o = (size_t)row * D + col; out[o] = xsrc[o] + f * gate[(size_t)b * MODW + col] * v; } };
struct EpiIn { bf16_t* P; float* DT; bf16_t* HALO;
    DEV void elem(int row, int col, float v) const {
        if (col < PW) { const bf16_t h = (bf16_t)f2bf(v); P[(size_t)row * PW + col] = h;
            if (col >= PXBC) { const int r = row & 127; if (r >= 125) HALO[((size_t)((row >> 7) + 1) * 3 + (r - 125)) * 1536 + (col - PXBC)] = h; } }
        else if (col < PW + 16) DT[(size_t)row * 16 + (col - PW)] = v; } };

template <bool SW, class Epi>
DEV void gemm_naive(const bf16_t* A, int lda, const bf16_t* Bt, int Ndest, int K, const Epi& E, LAS unsigned char* lds, int tid) {
    LAS float* As = (LAS float*)lds;
    LAS float* Bs = (LAS float*)(lds + 128 * 33 * 4);
    LAS float* Bs2 = (LAS float*)(lds + 192 * 33 * 4);
    const int ntn = SW ? (Ndest / 256) * 2 : Ndest / 64;
    const int ntiles = (M / 128) * ntn;
    const int ty = tid >> 4, tx = tid & 15;
    for (int tile = BIDX; tile < ntiles; tile += GDIM) {
        const int tm = tile / ntn, tn = tile % ntn;
        const int m0 = tm * 128;
        const int n0 = SW ? (tn >> 1) * 256 + (tn & 1) * 64 : tn * 64;
        float acc[4][4], acc2[4][4];
#pragma unroll
        for (int i = 0; i < 4; ++i)
#pragma unroll
            for (int j = 0; j < 4; ++j) { acc[i][j] = 0.f; acc2[i][j] = 0.f; }
        for (int k0 = 0; k0 < K; k0 += 32) {
            { const int row = tid >> 2, kc = (tid & 3) * 8; const u32x4 v = *(const u32x4*)(A + (size_t)(m0 + row) * lda + k0 + kc); LAS float* d = As + row * 33 + kc;
              d[0] = bflo(v.x); d[1] = bfhi(v.x); d[2] = bflo(v.y); d[3] = bfhi(v.y); d[4] = bflo(v.z); d[5] = bfhi(v.z); d[6] = bflo(v.w); d[7] = bfhi(v.w); }
            if (tid < 256) { const int row = tid >> 2, kc = (tid & 3) * 8; const u32x4 v = *(const u32x4*)(Bt + (size_t)(n0 + row) * K + k0 + kc); LAS float* d = Bs + row * 33 + kc;
              d[0] = bflo(v.x); d[1] = bfhi(v.x); d[2] = bflo(v.y); d[3] = bfhi(v.y); d[4] = bflo(v.z); d[5] = bfhi(v.z); d[6] = bflo(v.w); d[7] = bfhi(v.w); }
            else if (SW) { const int t2 = tid - 256; const int row = t2 >> 2, kc = (t2 & 3) * 8; const u32x4 v = *(const u32x4*)(Bt + (size_t)(n0 + 128 + row) * K + k0 + kc); LAS float* d = Bs2 + row * 33 + kc;
              d[0] = bflo(v.x); d[1] = bfhi(v.x); d[2] = bflo(v.y); d[3] = bfhi(v.y); d[4] = bflo(v.z); d[5] = bfhi(v.z); d[6] = bflo(v.w); d[7] = bfhi(v.w); }
            __syncthreads();
#pragma unroll 8
            for (int kk = 0; kk < 32; ++kk) {
                float a[4], b[4], b2[4];
#pragma unroll
                for (int i = 0; i < 4; ++i) a[i] = As[(ty * 4 + i) * 33 + kk];
#pragma unroll
                for (int j = 0; j < 4; ++j) { b[j] = Bs[(tx * 4 + j) * 33 + kk]; if (SW) b2[j] = Bs2[(tx * 4 + j) * 33 + kk]; }
#pragma unroll
                for (int i = 0; i < 4; ++i)
#pragma unroll
                    for (int j = 0; j < 4; ++j) { acc[i][j] += a[i] * b[j]; if (SW) acc2[i][j] += a[i] * b2[j]; }
            }
            __syncthreads();
        }
#pragma unroll
        for (int i = 0; i < 4; ++i)
#pragma unroll
            for (int j = 0; j < 4; ++j) {
                if constexpr (SW) E.elem2(m0 + ty * 4 + i, (tn >> 1) * 128 + (tn & 1) * 64 + tx * 4 + j, acc[i][j], acc2[i][j]);
                else E.elem(m0 + ty * 4 + i, n0 + tx * 4 + j, acc[i][j]);
            }
    }
}

namespace pg8 {
#define PG8_LAS __attribute__((address_space(3)))
typedef unsigned short bf16_t;
typedef short bf16x8 __attribute__((ext_vector_type(8)));
typedef float f32x4 __attribute__((ext_vector_type(4)));
typedef unsigned u32x4 __attribute__((ext_vector_type(4)));
constexpr int BM = 256, BK = 64, HALF = 128, HTB = HALF * BK * 2  , STAGE_BYTES = 8 * HTB, NXCD = 8, WGM = 8;

__host__ __device__ __forceinline__ int lds_byte(int r, int c) { const int st = (r >> 4) * 2 + (c >> 5), rr = r & 15, cc = c & 31, ob = rr * 64 + cc * 2; return st * 1024 + (ob ^ (((ob >> 9) & 1) << 5)); }
__host__ __device__ __forceinline__ void stage_rc(int b, int& R, int& C) { const int st = b / 1024, sb = b % 1024, swz = sb ^ (((sb >> 9) & 1) << 5); R = (st >> 1) * 16 + swz / 64; C = (st & 1) * 32 + (swz % 64) / 2; }
__host__ __device__ __forceinline__ int perm32(int rho) { const int n = rho >> 4, i = rho & 15; return 8 * (i >> 2) + 4 * n + (i & 3); }

struct Unit { int pm, pn; };
struct Gemm { const bf16_t* A; const bf16_t* Bt; int M, N, K, lda; };

struct StaticOrder {
    int nM, nN, nwg, G, c;
    __host__ __device__ void init(int M, int N, int G_, int c_) { nM = M / BM; nN = N / BM; nwg = nM * nN; G = G_; c = c_; }
    __host__ __device__ bool next(int i, Unit& u) const {
        const long L = (long)i * G + c; if (L >= nwg) return false;
        int wgid = (int)L; { const int q = nwg / NXCD, r = nwg % NXCD, xcd = wgid % NXCD, off = wgid / NXCD; wgid = (xcd < r ? xcd * (q + 1) : r * (q + 1) + (xcd - r) * q) + off; }
        const int nig = WGM * nN, gid = wgid / nig, fm = gid * WGM, gsz = (nM - fm) < WGM ? (nM - fm) : WGM;
        u.pm = fm + ((wgid % nig) % gsz); u.pn = (wgid % nig) / gsz; return true;
    }
    __device__ __forceinline__ void a_ready(const Unit&) const {}
    __device__ __forceinline__ void done(const Unit&) const {}
};
__device__ __forceinline__ unsigned cvt_pk_bf16(float lo, float hi) { unsigned r; asm volatile("v_cvt_pk_bf16_f32 %0, %1, %2" : "=v"(r) : "v"(lo), "v"(hi)); return r; }

__device__ __forceinline__ float silu1(float x) { return x * __builtin_amdgcn_rcpf(1.f + __expf(-x)); }
struct EpiSwigluT { static constexpr bool PERM = true, AFTER_DRAIN = false; bf16_t* H;
    __device__ __forceinline__ void operator()(const f32x4 (&acc)[2][2][4][2], const Unit& u, int wr, int wc, int fr, int fq) const {
        const int row0 = u.pm * BM + wr * 64 + fr, col0 = u.pn * HALF + wc * 32 + 8 * fq;
#pragma unroll
        for (int ai = 0; ai < 2; ++ai)
#pragma unroll
            for (int m = 0; m < 4; ++m) { bf16_t* rowp = H + (size_t)(row0 + ai * HALF + m * 16) * 2816 + col0;
                const f32x4 a0 = acc[ai][0][m][0], a1 = acc[ai][0][m][1], u0 = acc[ai][1][m][0], u1 = acc[ai][1][m][1]; u32x4 w;
                w.x = cvt_pk_bf16(silu1(a0[0]) * u0[0], silu1(a0[1]) * u0[1]); w.y = cvt_pk_bf16(silu1(a0[2]) * u0[2], silu1(a0[3]) * u0[3]);
                w.z = cvt_pk_bf16(silu1(a1[0]) * u1[0], silu1(a1[1]) * u1[1]); w.w = cvt_pk_bf16(silu1(a1[2]) * u1[2], silu1(a1[3]) * u1[3]);
                *(u32x4*)rowp = w; }
    }
};
struct EpiResidT { static constexpr bool PERM = false, AFTER_DRAIN = false; const float* xsrc; float* out; const float* gate; float f;
    __device__ __forceinline__ void operator()(const f32x4 (&acc)[2][2][4][2], const Unit& u, int wr, int wc, int fr, int fq) const {
        const int row0 = u.pm * BM + wr * 64 + fr, col0 = u.pn * BM + wc * 32 + 4 * fq; const int b = (u.pm * BM) / 4096;
#pragma unroll
        for (int bj = 0; bj < 2; ++bj)
#pragma unroll
            for (int n = 0; n < 2; ++n) { const int c = col0 + bj * HALF + n * 16; const f32x4 gv = *(const f32x4*)(gate + (size_t)b * 9216 + c) * f;
#pragma unroll
                for (int ai = 0; ai < 2; ++ai)
#pragma unroll
                    for (int m = 0; m < 4; ++m) { const size_t off = (size_t)(row0 + ai * HALF + m * 16) * 1024 + c; *(f32x4*)(out + off) = *(const f32x4*)(xsrc + off) + gv * acc[ai][bj][m][n]; } }
    }
};
struct EpiInT { static constexpr bool PERM = true, AFTER_DRAIN = false; bf16_t* P; float* DT; bf16_t* HALO;
    __device__ __forceinline__ void operator()(const f32x4 (&acc)[2][2][4][2], const Unit& u, int wr, int wc, int fr, int fq) const {
        const int row0 = u.pm * BM + wr * 64 + fr;
        if (u.pn < 22) { const int col0 = u.pn * BM + wc * 32 + 8 * fq; const float qs = (u.pn >= 4 && u.pn <= 7) ? 0.125f * 1.4426950408889634f : 1.f;
#pragma unroll
            for (int ai = 0; ai < 2; ++ai)
#pragma unroll
                for (int m = 0; m < 4; ++m) { const int row = row0 + ai * HALF + m * 16;
#pragma unroll
                    for (int bj = 0; bj < 2; ++bj) { const f32x4 v0 = acc[ai][bj][m][0] * qs, v1 = acc[ai][bj][m][1] * qs; u32x4 w;
                        w.x = cvt_pk_bf16(v0[0], v0[1]); w.y = cvt_pk_bf16(v0[2], v0[3]); w.z = cvt_pk_bf16(v1[0], v1[1]); w.w = cvt_pk_bf16(v1[2], v1[3]);
                        *(u32x4*)(P + (size_t)row * 5632 + col0 + bj * HALF) = w;
                        if (m == 3 && u.pn >= 16 && wr == 1 && fr >= 13) *(u32x4*)(HALO + ((size_t)((row >> 7) + 1) * 3 + (fr - 13)) * 1536 + (col0 + bj * HALF - 4096)) = w; } }
        } else if (wc == 0 && fq < 2) {
#pragma unroll
            for (int ai = 0; ai < 2; ++ai)
#pragma unroll
                for (int m = 0; m < 4; ++m) { const int row = row0 + ai * HALF + m * 16;
#pragma unroll
                    for (int n = 0; n < 2; ++n) *(f32x4*)(DT + (size_t)row * 16 + 8 * fq + 4 * n) = acc[ai][0][m][n]; }
        }
    }
};

template <class Epi, class Sched, bool ALIGN_EPI = false, bool SP2 = false>
__device__ __forceinline__ void gemm_phase(PG8_LAS unsigned char* lds, const Gemm g, const Sched& S, const Epi& E, const int tid) {
    const int wid = __builtin_amdgcn_readfirstlane(tid >> 6), lane = tid & 63, wr = wid >> 2, wc = wid & 3, fr = lane & 15, fq = lane >> 4;
    const int K = g.K, nt = K / BK;
    unsigned voffA[2], voffB[2];
#pragma unroll
    for (int i = 0; i < 2; ++i) { int R, C; stage_rc(tid * 16 + i * 8192, R, C); const int Rb = Epi::PERM ? ((R & ~31) + perm32(R & 31)) : R;
        voffA[i] = (unsigned)(R * g.lda + C) * 2u; voffB[i] = (unsigned)(Rb * K + C) * 2u; }
    const size_t kstep = (size_t)(BK * 2);
    const size_t hstep = (size_t)HALF * K * 2, hstepA = (size_t)HALF * g.lda * 2;
    const size_t tstep = 2 * hstep, tstepA = 2 * hstepA;
    const unsigned ldsw = (unsigned)wid * 1024u;
    const int aoff = lds_byte(wr * 64 + fr, fq * 8), boff = lds_byte(wc * 32 + fr, fq * 8);
#define PG8_SA(b, h) (((b) * 2 + (h)) * HTB)
#define PG8_SB(b, h) ((4 + (b) * 2 + (h)) * HTB)
#define PG8_STAGE(bufoff, gbase, voff) do { _Pragma("unroll") for (int _i = 0; _i < 2; ++_i) \
        __builtin_amdgcn_global_load_lds((const unsigned*)((const char*)(gbase) + (voff)[_i]), (PG8_LAS unsigned*)(lds + (bufoff) + ldsw + _i * 8192), 16, 0, 0); } while (0)
#define PG8_LDA(dst, b, h) do { _Pragma("unroll") for (int m = 0; m < 4; ++m) _Pragma("unroll") for (int k = 0; k < 2; ++k) dst[m][k] = *(const PG8_LAS bf16x8*)(lds + PG8_SA(b, h) + aoff + m * 2048 + k * 1024); } while (0)
#define PG8_LDB(dst, b, h) do { _Pragma("unroll") for (int n = 0; n < 2; ++n) _Pragma("unroll") for (int k = 0; k < 2; ++k) dst[n][k] = *(const PG8_LAS bf16x8*)(lds + PG8_SB(b, h) + boff + n * 2048 + k * 1024); } while (0)
#define PG8_MMA(ai, bj, At, Bt) do { __builtin_amdgcn_s_setprio(1); _Pragma("unroll") for (int m = 0; m < 4; ++m) _Pragma("unroll") for (int n = 0; n < 2; ++n) _Pragma("unroll") for (int k = 0; k < 2; ++k) \
        acc[ai][bj][m][n] = __builtin_amdgcn_mfma_f32_16x16x32_bf16(Bt[n][k], At[m][k], acc[ai][bj][m][n], 0, 0, 0); __builtin_amdgcn_s_setprio(0); } while (0)
#define PG8_WAIT_V(n) asm volatile("s_waitcnt vmcnt(" #n ")" ::: "memory")
#define PG8_WAIT_L(n) asm volatile("s_waitcnt lgkmcnt(" #n ")" ::: "memory")
#define PG8_BAR __builtin_amdgcn_s_barrier()
#define PG8_SCHED __builtin_amdgcn_sched_barrier(0)
    Unit cur, nxt; int ui = 0;
    if (!S.next(0, cur)) return;
    f32x4 acc[2][2][4][2];
#pragma unroll
    for (int a = 0; a < 2; ++a)
#pragma unroll
        for (int b = 0; b < 2; ++b)
#pragma unroll
            for (int m = 0; m < 4; ++m)
#pragma unroll
                for (int n = 0; n < 2; ++n) acc[a][b][m][n] = (f32x4){0.f, 0.f, 0.f, 0.f};
    bf16x8 At[4][2], B0[2][2], B1[2][2];
    const char* cA = (const char*)g.A + (size_t)cur.pm * tstepA; const char* cB = (const char*)g.Bt + (size_t)cur.pn * tstep;
    S.a_ready(cur);
    if constexpr (SP2) {
        PG8_STAGE(PG8_SB(0, 0), cB, voffB); PG8_STAGE(PG8_SB(0, 1), cB + hstep, voffB); PG8_STAGE(PG8_SA(0, 0), cA, voffA); PG8_STAGE(PG8_SA(0, 1), cA + hstepA, voffA);
        if (wr == 1) PG8_BAR;
        PG8_WAIT_V(2); PG8_BAR;
        PG8_STAGE(PG8_SB(1, 0), cB + kstep, voffB); PG8_STAGE(PG8_SA(1, 0), cA + kstep, voffA); PG8_STAGE(PG8_SB(1, 1), cB + hstep + kstep, voffB);
        PG8_WAIT_V(6); PG8_BAR;
    } else {
        PG8_STAGE(PG8_SB(0, 0), cB, voffB); PG8_STAGE(PG8_SA(0, 0), cA, voffA); PG8_STAGE(PG8_SB(0, 1), cB + hstep, voffB); PG8_STAGE(PG8_SA(0, 1), cA + hstepA, voffA);
        if (wr == 1) PG8_BAR;
        PG8_WAIT_V(4); PG8_BAR;
        PG8_STAGE(PG8_SB(1, 0), cB + kstep, voffB); PG8_STAGE(PG8_SA(1, 0), cA + kstep, voffA); PG8_STAGE(PG8_SB(1, 1), cB + hstep + kstep, voffB);
        PG8_WAIT_V(6); PG8_BAR;
    }
    for (;;) {
        const bool has_next = S.next(ui + 1, nxt);
        const char* nA = has_next ? (const char*)g.A + (size_t)nxt.pm * tstepA : cA; const char* nB = has_next ? (const char*)g.Bt + (size_t)nxt.pn * tstep : cB;
        for (int t = 0; t < nt; t += 2) {
            const bool last = (t == nt - 2);
            const char* a1 = cA + (size_t)(t + 1) * kstep;
            const char* a2 = last ? nA : cA + (size_t)(t + 2) * kstep; const char* b2 = last ? nB : cB + (size_t)(t + 2) * kstep;
            const char* a3 = a2 + kstep; const char* b3 = b2 + kstep;
            if (last && has_next) S.a_ready(nxt);
            if constexpr (SP2) {
            PG8_LDB(B0, 0, 0); PG8_LDB(B1, 0, 1); PG8_SCHED; PG8_LDA(At, 0, 0); PG8_STAGE(PG8_SA(1, 1), a1 + hstepA, voffA);
            PG8_WAIT_V(8); PG8_WAIT_L(0); PG8_BAR; PG8_MMA(0, 0, At, B0); PG8_MMA(0, 1, At, B1); PG8_BAR; PG8_SCHED;
            PG8_LDA(At, 0, 1); PG8_STAGE(PG8_SB(0, 0), b2, voffB); PG8_STAGE(PG8_SB(0, 1), b2 + hstep, voffB); PG8_STAGE(PG8_SA(0, 0), a2, voffA);
            PG8_WAIT_V(8); PG8_WAIT_L(0); PG8_BAR; PG8_MMA(1, 0, At, B0); PG8_MMA(1, 1, At, B1); PG8_BAR; PG8_SCHED;
            PG8_LDB(B0, 1, 0); PG8_LDB(B1, 1, 1); PG8_SCHED; PG8_LDA(At, 1, 0); PG8_STAGE(PG8_SA(0, 1), a2 + hstepA, voffA);
            PG8_WAIT_V(8); PG8_WAIT_L(0); PG8_BAR; PG8_MMA(0, 0, At, B0); PG8_MMA(0, 1, At, B1); PG8_BAR; PG8_SCHED;
            PG8_LDA(At, 1, 1); PG8_STAGE(PG8_SB(1, 0), b3, voffB); PG8_STAGE(PG8_SB(1, 1), b3 + hstep, voffB); PG8_STAGE(PG8_SA(1, 0), a3, voffA);
            PG8_WAIT_V(8); PG8_WAIT_L(0); PG8_BAR; PG8_MMA(1, 0, At, B0); PG8_MMA(1, 1, At, B1); PG8_BAR; PG8_SCHED;
            } else {
            PG8_LDB(B0, 0, 0); PG8_SCHED; PG8_LDA(At, 0, 0); PG8_STAGE(PG8_SA(1, 1), a1 + hstepA, voffA);
            PG8_WAIT_L(8); PG8_BAR; PG8_WAIT_L(0); PG8_MMA(0, 0, At, B0); PG8_BAR; PG8_SCHED;
            PG8_LDB(B1, 0, 1); PG8_STAGE(PG8_SB(0, 0), b2, voffB);
            PG8_BAR; PG8_WAIT_L(0); PG8_MMA(0, 1, At, B1); PG8_BAR;
            PG8_LDA(At, 0, 1); PG8_STAGE(PG8_SA(0, 0), a2, voffA);
            PG8_BAR; PG8_WAIT_L(0); PG8_MMA(1, 0, At, B0); PG8_BAR; PG8_SCHED;
            PG8_STAGE(PG8_SB(0, 1), b2 + hstep, voffB);
            PG8_WAIT_V(6); PG8_BAR; PG8_MMA(1, 1, At, B1); PG8_BAR;
            PG8_LDB(B0, 1, 0); PG8_SCHED; PG8_LDA(At, 1, 0); PG8_STAGE(PG8_SA(0, 1), a2 + hstepA, voffA);
            PG8_WAIT_L(8); PG8_BAR; PG8_WAIT_L(0); PG8_MMA(0, 0, At, B0); PG8_BAR; PG8_SCHED;
            PG8_LDB(B1, 1, 1); PG8_STAGE(PG8_SB(1, 0), b3, voffB);
            PG8_BAR; PG8_WAIT_L(0); PG8_MMA(0, 1, At, B1); PG8_BAR;
            PG8_LDA(At, 1, 1); PG8_STAGE(PG8_SA(1, 0), a3, voffA);
            PG8_BAR; PG8_WAIT_L(0); PG8_MMA(1, 0, At, B0); PG8_BAR; PG8_SCHED;
            PG8_STAGE(PG8_SB(1, 1), b3 + hstep, voffB);
            PG8_WAIT_V(6); PG8_BAR; PG8_MMA(1, 1, At, B1); PG8_BAR;
            }
        }
        if constexpr (ALIGN_EPI) { if (wr == 0) PG8_BAR; }
        if constexpr (!Epi::AFTER_DRAIN) { E(acc, cur, wr, wc, fr, fq); S.done(cur); }
        if (!has_next) break;
#pragma unroll
        for (int a = 0; a < 2; ++a)
#pragma unroll
            for (int b = 0; b < 2; ++b)
#pragma unroll
                for (int m = 0; m < 4; ++m)
#pragma unroll
                    for (int n = 0; n < 2; ++n) acc[a][b][m][n] = (f32x4){0.f, 0.f, 0.f, 0.f};
        cur = nxt; cA = nA; cB = nB; ++ui;
        if constexpr (ALIGN_EPI) { if (wr == 1) PG8_BAR; }
    }
    PG8_WAIT_V(0);
    if constexpr (!ALIGN_EPI) { if (wr == 0) PG8_BAR; }
    PG8_BAR;
    if constexpr (Epi::AFTER_DRAIN) { E.fused(acc, cur, wr, wc, fr, fq, lds, wid, lane); S.done(cur); }
#undef PG8_SA
#undef PG8_SB
#undef PG8_STAGE
#undef PG8_LDA
#undef PG8_LDB
#undef PG8_MMA
#undef PG8_WAIT_V
#undef PG8_WAIT_L
#undef PG8_BAR
#undef PG8_SCHED
}
}
DEV void ph_conv(const Params& p, int l, int tid, const bool st = true) {
    bf16_t* P = (bf16_t*)(p.ws + WS_P); const bf16_t* HALO = (const bf16_t*)(p.ws + WS_HALO);
    const float* cw = p.in[I_CW] + (size_t)l * 1536 * 4; const float* cb = p.in[I_CB] + (size_t)l * 1536;
    for (int task = BIDX * NTHREADS + tid; task < GCH * 768; task += GDIM * NTHREADS) {
        const int gc = task / 768, ch = (task % 768) * 2; const int r0 = gc * CH;
        const f32x4 w0 = *(const f32x4*)(cw + ch * 4), w1 = *(const f32x4*)(cw + ch * 4 + 4); const float b0 = cb[ch], b1 = cb[ch + 1];
        float a3 = 0.f, a2 = 0.f, a1 = 0.f, c3 = 0.f, c2 = 0.f, c1 = 0.f;
        if (gc % NCHUNK != 0) { const bf16_t* hp = HALO + (size_t)gc * 3 * 1536 + ch;
            const unsigned h0 = *(const unsigned*)(hp), h1 = *(const unsigned*)(hp + 1536), h2 = *(const unsigned*)(hp + 2 * 1536);
            a3 = bflo(h0); c3 = bfhi(h0); a2 = bflo(h1); c2 = bfhi(h1); a1 = bflo(h2); c1 = bfhi(h2); }
        unsigned* col = (unsigned*)(P + (size_t)r0 * PW + PXBC + ch);
#pragma unroll 1
        for (int i0 = 0; i0 < CH; i0 += 32) {
            unsigned raw[32];
#pragma unroll
            for (int i = 0; i < 32; ++i) raw[i] = col[(size_t)(i0 + i) * (PW / 2)];
#pragma unroll
            for (int i = 0; i < 32; ++i) {
                const float a0 = bflo(raw[i]), c0 = bfhi(raw[i]);
                const float ya = b0 + w0.x * a3 + w0.y * a2 + w0.z * a1 + w0.w * a0, yc = b1 + w1.x * c3 + w1.y * c2 + w1.z * c1 + w1.w * c0;
                { const unsigned w_ = pk2(siluf(ya), siluf(yc)); if (st) col[(size_t)(i0 + i) * (PW / 2)] = w_; else asm volatile("" :: "v"(w_)); }
                a3 = a2; a2 = a1; a1 = a0; c3 = c2; c2 = c1; c1 = c0;
            }
        }
    }
}

DEV void ssd_head_scalars(const Params& p, int l, int r0, int h, LAS float* s_dt, LAS float* s_ac, int tid, int wave, int lane) {
    const float* DT = (const float*)(p.ws + WS_DT);
    if (tid < CH) { const float dtv = softplusf(DT[(size_t)(r0 + tid) * 16 + h] + p.in[I_DTB][l * 16 + h]); s_dt[tid] = dtv; s_ac[tid] = dtv * (-__expf(p.in[I_ALOG][l * 16 + h])); }
    __syncthreads();
    if (wave == 0) { const float v0 = s_ac[2 * lane], v1 = s_ac[2 * lane + 1]; const float s = v0 + v1; const float inc = wave_incl_scan(s, lane); s_ac[2 * lane] = inc - s + v0; s_ac[2 * lane + 1] = inc; }
    __syncthreads();
}
DEV void ph_ssd_state(const Params& p, int l, LAS unsigned char* lds, int tid, int wave, int lane) {
    LAS bf16_t* Bs = (LAS bf16_t*)lds;
    LAS float* xdd = (LAS float*)(lds + 34816);
    LAS float* s_dt = (LAS float*)(lds + 34816 + 32768);
    LAS float* s_ac = s_dt + 128;
    const bf16_t* P = (const bf16_t*)(p.ws + WS_P); float* ST = (float*)(p.ws + WS_ST); float* CD = (float*)(p.ws + WS_CD);
    for (int unit = BIDX; unit < GCH * 16; unit += GDIM) {
        const int gc = unit >> 4, h = unit & 15, g = h >> 3, r0 = gc * CH;
        __syncthreads();
        ssd_head_scalars(p, l, r0, h, s_dt, s_ac, tid, wave, lane);
        { const int row = tid >> 2, c0 = (tid & 3) * 32; const bf16_t* src = P + (size_t)(r0 + row) * PW + PBM + g * 128 + c0;
#pragma unroll
          for (int q = 0; q < 4; ++q) *(LAS u32x4*)(Bs + row * 136 + c0 + q * 8) = *(const u32x4*)(src + q * 8); }
        { const int row = tid >> 2, p0 = (tid & 3) * 16; const bf16_t* src = P + (size_t)(r0 + row) * PW + PXS + h * 64 + p0; const float f = s_dt[row] * __expf(s_ac[127] - s_ac[row]);
#pragma unroll
          for (int q = 0; q < 2; ++q) { const u32x4 v = *(const u32x4*)(src + q * 8); LAS float* d = xdd + row * 64 + p0 + q * 8;
              d[0] = bflo(v.x) * f; d[1] = bfhi(v.x) * f; d[2] = bflo(v.y) * f; d[3] = bfhi(v.y) * f; d[4] = bflo(v.z) * f; d[5] = bfhi(v.z) * f; d[6] = bflo(v.w) * f; d[7] = bfhi(v.w) * f; } }
        __syncthreads();
        const int pp = tid >> 3, ng = tid & 7; float acc[16];
#pragma unroll
        for (int j = 0; j < 16; ++j) acc[j] = 0.f;
        for (int ll = 0; ll < CH; ++ll) { const float xv = xdd[ll * 64 + pp]; const u32x4 b0 = *(const LAS u32x4*)(Bs + ll * 136 + ng * 16), b1 = *(const LAS u32x4*)(Bs + ll * 136 + ng * 16 + 8);
            acc[0] += xv * bflo(b0.x); acc[1] += xv * bfhi(b0.x); acc[2] += xv * bflo(b0.y); acc[3] += xv * bfhi(b0.y); acc[4] += xv * bflo(b0.z); acc[5] += xv * bfhi(b0.z); acc[6] += xv * bflo(b0.w); acc[7] += xv * bfhi(b0.w);
            acc[8] += xv * bflo(b1.x); acc[9] += xv * bfhi(b1.x); acc[10] += xv * bflo(b1.y); acc[11] += xv * bfhi(b1.y); acc[12] += xv * bflo(b1.z); acc[13] += xv * bfhi(b1.z); acc[14] += xv * bflo(b1.w); acc[15] += xv * bfhi(b1.w); }
        float* dst = ST + (((size_t)gc * 16 + h) * 64 + pp) * 128 + ng * 16;
#pragma unroll
        for (int q = 0; q < 4; ++q) *(f32x4*)(dst + q * 4) = (f32x4){acc[q * 4], acc[q * 4 + 1], acc[q * 4 + 2], acc[q * 4 + 3]};
        if (tid == 0) CD[gc * 16 + h] = __expf(s_ac[127]);
    }
}
DEV void ph_ssd_scan(const Params& p, int tid, const bool st = true) {
    float* ST = (float*)(p.ws + WS_ST); const float* CD = (const float*)(p.ws + WS_CD);
    for (int e = BIDX * NTHREADS + tid; e < NB * 16 * 64 * 128; e += GDIM * NTHREADS) {
        const int b = e >> 17, h = (e >> 13) & 15, pn = e & 8191; float hc = 0.f; float t[NCHUNK];
        float* base = ST + ((size_t)(b * NCHUNK) * 16 + h) * 8192 + pn;
#pragma unroll
        for (int c = 0; c < NCHUNK; ++c) t[c] = base[(size_t)c * 16 * 8192];
#pragma unroll
        for (int c = 0; c < NCHUNK; ++c) { if (st) base[(size_t)c * 16 * 8192] = hc; else asm volatile("" :: "v"(hc)); hc = hc * CD[(b * NCHUNK + c) * 16 + h] + t[c]; }
    }
}
DEV void ph_ssd_out(const Params& p, int l, LAS unsigned char* lds, int tid, int wave, int lane) {
    LAS bf16_t* Cs = (LAS bf16_t*)lds;
    LAS bf16_t* Bs = (LAS bf16_t*)(lds + 34816);
    LAS float* prev = (LAS float*)(lds + 34816);
    LAS bf16_t* CBs = (LAS bf16_t*)(lds + 2 * 34816);
    LAS float* xd = (LAS float*)(lds + 3 * 34816);
    LAS float* s_dt = (LAS float*)(lds + 4 * 34816); LAS float* s_ac = s_dt + 128; LAS float* s_ss = s_dt + 256;
    bf16_t* P = (bf16_t*)(p.ws + WS_P); const float* ST = (const float*)(p.ws + WS_ST); float* ROWSS = (float*)(p.ws + WS_ROWSS);
    for (int unit = BIDX; unit < GCH * 2; unit += GDIM) {
        const int gc = unit >> 1, g = unit & 1, r0 = gc * CH;
        __syncthreads();
        { const int row = tid >> 2, c0 = (tid & 3) * 32; const bf16_t* sc = P + (size_t)(r0 + row) * PW + PCM + g * 128 + c0; const bf16_t* sb = P + (size_t)(r0 + row) * PW + PBM + g * 128 + c0;
#pragma unroll
          for (int q = 0; q < 4; ++q) { *(LAS u32x4*)(Cs + row * 136 + c0 + q * 8) = *(const u32x4*)(sc + q * 8); *(LAS u32x4*)(Bs + row * 136 + c0 + q * 8) = *(const u32x4*)(sb + q * 8); } }
        if (tid < CH) s_ss[tid] = 0.f;
        __syncthreads();
        { const int lr = tid >> 2, s0 = (tid & 3) * 32; float acc[32];
#pragma unroll
          for (int j = 0; j < 32; ++j) acc[j] = 0.f;
          for (int n = 0; n < 128; n += 8) { const u32x4 cv = *(const LAS u32x4*)(Cs + lr * 136 + n);
              const float c0 = bflo(cv.x), c1 = bfhi(cv.x), c2 = bflo(cv.y), c3 = bfhi(cv.y), c4 = bflo(cv.z), c5 = bfhi(cv.z), c6 = bflo(cv.w), c7 = bfhi(cv.w);
#pragma unroll
              for (int j = 0; j < 32; ++j) { const u32x4 bv = *(const LAS u32x4*)(Bs + (s0 + j) * 136 + n);
                  acc[j] += c0 * bflo(bv.x) + c1 * bfhi(bv.x) + c2 * bflo(bv.y) + c3 * bfhi(bv.y) + c4 * bflo(bv.z) + c5 * bfhi(bv.z) + c6 * bflo(bv.w) + c7 * bfhi(bv.w); } }
#pragma unroll
          for (int j = 0; j < 32; j += 2) *(LAS unsigned*)(CBs + lr * 136 + s0 + j) = pk2(acc[j], acc[j + 1]); }
        for (int e = 0; e < 8; ++e) {
            const int h = g * 8 + e;
            __syncthreads();
            ssd_head_scalars(p, l, r0, h, s_dt, s_ac, tid, wave, lane);
            { const int pp = tid >> 3, n0 = (tid & 7) * 16; const float* src = ST + (((size_t)gc * 16 + h) * 64 + pp) * 128 + n0;
#pragma unroll
              for (int q = 0; q < 4; ++q) { const f32x4 v = *(const f32x4*)(src + q * 4); LAS float* d = prev + pp * 129 + n0 + q * 4; d[0] = v.x; d[1] = v.y; d[2] = v.z; d[3] = v.w; } }
            const int lr = tid >> 2, p0 = (tid & 3) * 16; float xraw[16];
            { const bf16_t* src = P + (size_t)(r0 + lr) * PW + PXS + h * 64 + p0; const float f = s_dt[lr];
#pragma unroll
              for (int q = 0; q < 2; ++q) { const u32x4 v = *(const u32x4*)(src + q * 8);
                  xraw[q * 8 + 0] = bflo(v.x); xraw[q * 8 + 1] = bfhi(v.x); xraw[q * 8 + 2] = bflo(v.y); xraw[q * 8 + 3] = bfhi(v.y); xraw[q * 8 + 4] = bflo(v.z); xraw[q * 8 + 5] = bfhi(v.z); xraw[q * 8 + 6] = bflo(v.w); xraw[q * 8 + 7] = bfhi(v.w); }
#pragma unroll
              for (int j = 0; j < 16; ++j) xd[lr * 68 + p0 + j] = xraw[j] * f; }
            __syncthreads();
            float y[16], yo[16];
#pragma unroll
            for (int j = 0; j < 16; ++j) { y[j] = 0.f; yo[j] = 0.f; }
            const float al = s_ac[lr];
            for (int s = 0; s <= lr; ++s) { const float cb = bf2f(CBs[lr * 136 + s]) * __expf(al - s_ac[s]);
#pragma unroll
                for (int q = 0; q < 4; ++q) { const f32x4 xv = *(const LAS f32x4*)(xd + s * 68 + p0 + q * 4); y[q * 4] += cb * xv.x; y[q * 4 + 1] += cb * xv.y; y[q * 4 + 2] += cb * xv.z; y[q * 4 + 3] += cb * xv.w; } }
            for (int n = 0; n < 128; ++n) { const float c = bf2f(Cs[lr * 136 + n]);
#pragma unroll
                for (int j = 0; j < 16; ++j) yo[j] += c * prev[(p0 + j) * 129 + n]; }
            const float ea = __expf(al), dh = p.in[I_SD][l * 16 + h];
            bf16_t* zp = P + (size_t)(r0 + lr) * PW + PZ + h * 64 + p0; float ssl = 0.f; unsigned ow[8];
            { const u32x4 z0 = *(const u32x4*)zp, z1 = *(const u32x4*)(zp + 8); float zz[16];
              zz[0] = bflo(z0.x); zz[1] = bfhi(z0.x); zz[2] = bflo(z0.y); zz[3] = bfhi(z0.y); zz[4] = bflo(z0.z); zz[5] = bfhi(z0.z); zz[6] = bflo(z0.w); zz[7] = bfhi(z0.w);
              zz[8] = bflo(z1.x); zz[9] = bfhi(z1.x); zz[10] = bflo(z1.y); zz[11] = bfhi(z1.y); zz[12] = bflo(z1.z); zz[13] = bfhi(z1.z); zz[14] = bflo(z1.w); zz[15] = bfhi(z1.w);
#pragma unroll
              for (int j = 0; j < 16; ++j) { const float v = (y[j] + ea * yo[j] + dh * xraw[j]) * siluf(zz[j]); ssl += v * v; y[j] = v; }
#pragma unroll
              for (int j = 0; j < 8; ++j) ow[j] = pk2(y[2 * j], y[2 * j + 1]); }
            *(u32x4*)zp = (u32x4){ow[0], ow[1], ow[2], ow[3]}; *(u32x4*)(zp + 8) = (u32x4){ow[4], ow[5], ow[6], ow[7]};
            ssl += lane_get(ssl, lane ^ 1); ssl += lane_get(ssl, lane ^ 2);
            if ((tid & 3) == 0) s_ss[lr] += ssl;
        }
        __syncthreads();
        if (tid < CH) ROWSS[(size_t)(r0 + tid) * 2 + g] = s_ss[tid];
    }
}
DEV void ph_mixfinal(const Params& p, int l, int gw, int ngw, int lane) {
    bf16_t* P = (bf16_t*)(p.ws + WS_P); const float* ng = p.in[I_SN] + (size_t)l * 1024 + 16 * lane;
    for (int row = gw; row < M; row += ngw) {
        u32x4* q = (u32x4*)(P + (size_t)row * PW + PZ + 16 * lane); const u32x4 a = q[0], b = q[1];
        float v[16] = {bflo(a.x), bfhi(a.x), bflo(a.y), bfhi(a.y), bflo(a.z), bfhi(a.z), bflo(a.w), bfhi(a.w), bflo(b.x), bfhi(b.x), bflo(b.y), bfhi(b.y), bflo(b.z), bfhi(b.z), bflo(b.w), bfhi(b.w)};
        float ss = 0.f;
#pragma unroll
        for (int j = 0; j < 16; ++j) ss += v[j] * v[j];
#pragma unroll
        for (int o = 1; o < 32; o <<= 1) ss += lane_get(ss, lane ^ o);
        const float rs = rsqrtf(ss * (1.f / 512.f) + EPS);
        u32x4 oa, ob;
        oa.x = pk2(v[0] * rs * ng[0], v[1] * rs * ng[1]); oa.y = pk2(v[2] * rs * ng[2], v[3] * rs * ng[3]); oa.z = pk2(v[4] * rs * ng[4], v[5] * rs * ng[5]); oa.w = pk2(v[6] * rs * ng[6], v[7] * rs * ng[7]);
        ob.x = pk2(v[8] * rs * ng[8], v[9] * rs * ng[9]); ob.y = pk2(v[10] * rs * ng[10], v[11] * rs * ng[11]); ob.z = pk2(v[12] * rs * ng[12], v[13] * rs * ng[13]); ob.w = pk2(v[14] * rs * ng[14], v[15] * rs * ng[15]);
        q[0] = oa; q[1] = ob;
    }
}

DEV void ph_sb_attn(const Params& p, LAS unsigned char* lds, int gw, int ngw, int wave, int lane) {
    LAS float* qs = (LAS float*)(lds + 65536 + wave * 512);
    bf16_t* P = (bf16_t*)(p.ws + WS_P);
    for (int task = gw; task < NB * 8 * S; task += ngw) {
        const int t = task % S, bh = task / S, h = bh & 7, b = bh >> 3; const size_t rowb = (size_t)b * S;
        bf16_t* qp = P + (rowb + t) * PW + PSQ + h * 64;
        qs[lane] = bf2f(qp[lane]) * 0.125f; LDS_WAIT();
        float o = 0.f, R = 0.f;
        for (int k1 = t - 1; k1 >= 0; k1 -= 64) {
            const int s = k1 - lane; const bool valid = s >= 0; float z = 0.f;
            if (valid) { const bf16_t* kp = P + (rowb + s) * PW + PSK + h * 64;
#pragma unroll
                for (int q = 0; q < 8; ++q) { const u32x4 kv = *(const u32x4*)(kp + q * 8); const LAS float* qq = qs + q * 8;
                    z += qq[0] * bflo(kv.x) + qq[1] * bfhi(kv.x) + qq[2] * bflo(kv.y) + qq[3] * bfhi(kv.y) + qq[4] * bflo(kv.z) + qq[5] * bfhi(kv.z) + qq[6] * bflo(kv.w) + qq[7] * bfhi(kv.w); } }
            const float Lg = valid ? -softplusf(z) : 0.f;
            const float cum = wave_incl_scan(Lg, lane);
            const float w = valid ? __expf(z + R + cum) : 0.f;
            const int nv = (k1 + 1 < 64) ? k1 + 1 : 64;
            for (int i = 0; i < nv; ++i) { const float wi = lane_get(w, i); o += wi * bf2f(P[(rowb + (k1 - i)) * PW + PSV + h * 64 + lane]); }
            R += lane_get(cum, 63);
            if (R < -104.f) break;
        }
        qp[lane] = (bf16_t)f2bf(o);
        LDS_WAIT();
    }
}
DEV void ph_diff_attn(const Params& p, int l, LAS unsigned char* lds, int gw, int ngw, int wave, int lane) {
    LAS float* qs = (LAS float*)(lds + 65536 + 4096 + wave * 512);
    bf16_t* P = (bf16_t*)(p.ws + WS_P); const float* misc = (const float*)(p.ws + WS_MISC);
    const float lam = misc[l]; const float linit = lambda_init_of(l);
    for (int task = gw; task < NB * 4 * S; task += ngw) {
        const int t = task % S, bh = task / S, h = bh & 3, b = bh >> 2; const size_t rowb = (size_t)b * S;
        bf16_t* qp = P + (rowb + t) * PW + PDQ + h * 128;
        qs[lane] = bf2f(qp[lane]) * 0.125f; qs[64 + lane] = bf2f(qp[64 + lane]) * 0.125f; LDS_WAIT();
        const float* bt = misc + 64 + h * 128;
        float m0 = -INFINITY, m1 = -INFINITY, l0 = 0.f, l1 = 0.f, o0a = 0.f, o0b = 0.f, o1a = 0.f, o1b = 0.f;
        for (int k1 = t; k1 >= 0; k1 -= 64) {
            const int s = k1 - lane; const bool valid = s >= 0; float z0 = 0.f, z1 = 0.f;
            if (valid) { const bf16_t* kp = P + (rowb + s) * PW + PDK + h * 128;
#pragma unroll
                for (int q = 0; q < 8; ++q) { const u32x4 kv = *(const u32x4*)(kp + q * 8); const LAS float* qq = qs + q * 8;
                    z0 += qq[0] * bflo(kv.x) + qq[1] * bfhi(kv.x) + qq[2] * bflo(kv.y) + qq[3] * bfhi(kv.y) + qq[4] * bflo(kv.z) + qq[5] * bfhi(kv.z) + qq[6] * bflo(kv.w) + qq[7] * bfhi(kv.w); }
#pragma unroll
                for (int q = 0; q < 8; ++q) { const u32x4 kv = *(const u32x4*)(kp + 64 + q * 8); const LAS float* qq = qs + 64 + q * 8;
                    z1 += qq[0] * bflo(kv.x) + qq[1] * bfhi(kv.x) + qq[2] * bflo(kv.y) + qq[3] * bfhi(kv.y) + qq[4] * bflo(kv.z) + qq[5] * bfhi(kv.z) + qq[6] * bflo(kv.w) + qq[7] * bfhi(kv.w); } }
            const int dist = t - s; const float bias = bt[dist < 127 ? dist : 127];
            z0 = valid ? z0 + bias : -INFINITY; z1 = valid ? z1 + bias : -INFINITY;
            const float n0 = fmaxf(m0, wave_max(z0, lane)), n1 = fmaxf(m1, wave_max(z1, lane));
            const float sc0 = __expf(m0 - n0), sc1 = __expf(m1 - n1);
            const float p0 = valid ? __expf(z0 - n0) : 0.f, p1 = valid ? __expf(z1 - n1) : 0.f;
            l0 = l0 * sc0 + wave_sum(p0, lane); l1 = l1 * sc1 + wave_sum(p1, lane); o0a *= sc0; o0b *= sc0; o1a *= sc1; o1b *= sc1; m0 = n0; m1 = n1;
            const int nv = (k1 + 1 < 64) ? k1 + 1 : 64;
            for (int i = 0; i < nv; ++i) { const float a = lane_get(p0, i), c = lane_get(p1, i); const unsigned vv = *(const unsigned*)(P + (rowb + (k1 - i)) * PW + PDV + h * 128 + 2 * lane);
                const float va = bflo(vv), vb = bfhi(vv); o0a += a * va; o0b += a * vb; o1a += c * va; o1b += c * vb; }
        }
        const float ya = o0a / l0 - lam * o1a / l1, yb = o0b / l0 - lam * o1b / l1;
        const float rs = rsqrtf(wave_sum(ya * ya + yb * yb, lane) * (1.f / 128.f) + EPS) * (1.f - linit);
        const float* sg = p.in[I_SUB] + (size_t)l * 128 + 2 * lane;
        *(unsigned*)(qp + 2 * lane) = pk2(ya * rs * sg[0], yb * rs * sg[1]);
        LDS_WAIT();
    }
}


#include <hip/hip_bf16.h>
#include <cmath>
namespace attn_body {
using bf16=__hip_bfloat16;
using bf16x8=__attribute__((ext_vector_type(8)))short;
using s16x4=__attribute__((ext_vector_type(4)))short;
using f32x16=__attribute__((ext_vector_type(16)))float;
using u32x4=__attribute__((ext_vector_type(4)))unsigned;
constexpr int BATCH=4,SEQ=4096,D=64,DM=5632,OPITCH=1024;
constexpr int NW=8,QBLK=32,QB=QBLK*NW,KVBLK=64,NQB=SEQ/QB;
constexpr int ATTN_PITCH=DM, ATTN_UNIT_ROWS=QB; constexpr int TAB_PAD=264, TAB_N=720;
__device__ __forceinline__ int crow(int r,int hi){return (r&3)+8*(r>>2)+4*hi;}
#define SBAR() __builtin_amdgcn_sched_barrier(0)
__device__ __forceinline__ void cmask(f32x16&p0,f32x16&p1,int jb,int qrel,int hi){
  const float NEG=-INFINITY; int kb=64*jb+4*hi; asm volatile("":"+v"(kb));
  #pragma unroll
  for(int r=0;r<16;++r){int kv=kb+(r&3)+8*(r>>2); if(kv>qrel)p0[r]=NEG; if(kv+32>qrel)p1[r]=NEG;}
}

constexpr int NSLOT=3, SLOTB=8192;
constexpr int LDS_K=0, LDS_V=NSLOT*SLOTB, LDS_WS=2*NSLOT*SLOTB, LDS_OST=LDS_WS+NW*64*4, LDS_BYTES=LDS_OST+NW*4096;
constexpr float C2=0.125f*1.4426950408889634f;
__device__ __forceinline__ void glds16(const void*gsrc,unsigned lds_dst){unsigned keep;
  asm volatile("s_mov_b32 %0, m0\n\ts_mov_b32 m0, %2\n\ts_nop 0\n\tglobal_load_lds_dwordx4 %1, off\n\ts_mov_b32 m0, %0":"=&s"(keep):"v"(gsrc),"s"(lds_dst):"memory");}
__device__ __forceinline__ float max3f(float a,float b,float c){float r;asm("v_max3_f32 %0, %1, %2, %3":"=v"(r):"v"(a),"v"(b),"v"(c));return r;}
__device__ __forceinline__ float max2f(float a,float b){float r;asm("v_max_f32_e32 %0, %1, %2":"=v"(r):"v"(a),"v"(b));return r;}
__device__ __forceinline__ float fadd_s(float a,float b){float r;asm("v_add_f32_e32 %0, %1, %2":"=v"(r):"v"(a),"v"(b));return r;}
__device__ __forceinline__ float fsub_s(float a,float b){float r;asm("v_sub_f32_e32 %0, %1, %2":"=v"(r):"v"(a),"v"(b));return r;}
typedef float f32x2_t __attribute__((ext_vector_type(2))); typedef __bf16 bf16x2_t __attribute__((ext_vector_type(2)));
__device__ __forceinline__ unsigned cvtpk_s(float lo,float hi){f32x2_t v={lo,hi};bf16x2_t b=__builtin_convertvector(v,bf16x2_t);return __builtin_bit_cast(unsigned,b);}
#define WAIT_BAR(N) asm volatile("s_waitcnt vmcnt(" #N ") lgkmcnt(0)\n\ts_barrier":::"memory")

__device__ __forceinline__ void qkt(f32x16&p0,f32x16&p1,const char*Kslot,const bf16x8*qr,int r32,int hi){ const f32x16 zc_={};
  const char*kb=Kslot+hi*1024+r32*16;
  #pragma unroll
  for(int d0=0;d0<4;++d0){
    const bf16x8 b0=*reinterpret_cast<const bf16x8*>(kb+d0*2048);
    const bf16x8 b1=*reinterpret_cast<const bf16x8*>(kb+d0*2048+512);
    if(d0==0){p0=__builtin_amdgcn_mfma_f32_32x32x16_bf16(b0,qr[0],zc_,0,0,0);p1=__builtin_amdgcn_mfma_f32_32x32x16_bf16(b1,qr[0],zc_,0,0,0);}
    else{p0=__builtin_amdgcn_mfma_f32_32x32x16_bf16(b0,qr[d0],p0,0,0,0);p1=__builtin_amdgcn_mfma_f32_32x32x16_bf16(b1,qr[d0],p1,0,0,0);}}
}
typedef __attribute__((address_space(3))) const char* lds_cptr;
typedef short v4i16_t __attribute__((ext_vector_type(4)));
__device__ __forceinline__ void kload8(bf16x8*kf,lds_cptr kp){
  kf[0]=*(const __attribute__((address_space(3))) bf16x8*)(kp);      kf[1]=*(const __attribute__((address_space(3))) bf16x8*)(kp+512);
  kf[2]=*(const __attribute__((address_space(3))) bf16x8*)(kp+2048); kf[3]=*(const __attribute__((address_space(3))) bf16x8*)(kp+2560);
  kf[4]=*(const __attribute__((address_space(3))) bf16x8*)(kp+4096); kf[5]=*(const __attribute__((address_space(3))) bf16x8*)(kp+4608);
  kf[6]=*(const __attribute__((address_space(3))) bf16x8*)(kp+6144); kf[7]=*(const __attribute__((address_space(3))) bf16x8*)(kp+6656);
}
__device__ __forceinline__ void kload2(bf16x8*kf,lds_cptr kp,int j){ kf[2*j]=*(const __attribute__((address_space(3))) bf16x8*)(kp+j*2048); kf[2*j+1]=*(const __attribute__((address_space(3))) bf16x8*)(kp+j*2048+512); }
__device__ __forceinline__ s16x4 vtr(lds_cptr p){ return __builtin_bit_cast(s16x4,__builtin_amdgcn_ds_read_tr16_b64_v4i16((__attribute__((address_space(3))) v4i16_t*)p)); }
__device__ __forceinline__ float rowmax(const f32x16&p0,const f32x16&p1){
  float a=max3f(p0[0],p0[1],p1[0]),b=max3f(p0[2],p0[3],p1[1]);a=max3f(a,p1[2],p1[3]);
  #pragma unroll
  for(int r=4;r<16;r+=4){a=max3f(a,p0[r],p0[r+1]);b=max3f(b,p0[r+2],p0[r+3]);a=max3f(a,p1[r],p1[r+1]);b=max3f(b,p1[r+2],p1[r+3]);}
  const float m=max2f(a,b);
  auto rr=__builtin_amdgcn_permlane32_swap(__float_as_uint(m),__float_as_uint(m),false,false);
  return max2f(__uint_as_float(rr[0]),__uint_as_float(rr[1]));
}
__device__ __forceinline__ void pv(f32x16*o,int vb,bf16x8 pa0,bf16x8 pa1,bf16x8 pa2,bf16x8 pa3){
  #pragma unroll
  for(int d0=0;d0<2;++d0){s16x4 lo[4],hi[4];
    #pragma unroll
    for(int ks=0;ks<4;++ks){
      asm volatile("ds_read_b64_tr_b16 %0,%1 offset:%c2":"=&v"(lo[ks]):"v"(vb),"i"(d0*4096+ks*1024):"memory");
      asm volatile("ds_read_b64_tr_b16 %0,%1 offset:%c2":"=&v"(hi[ks]):"v"(vb),"i"(d0*4096+ks*1024+512):"memory");}
    asm volatile("s_waitcnt lgkmcnt(0)":::"memory");SBAR();
    #define PK(k) (bf16x8){lo[k][0],lo[k][1],lo[k][2],lo[k][3],hi[k][0],hi[k][1],hi[k][2],hi[k][3]}
    o[d0]=__builtin_amdgcn_mfma_f32_32x32x16_bf16(pa0,PK(0),o[d0],0,0,0);
    o[d0]=__builtin_amdgcn_mfma_f32_32x32x16_bf16(pa1,PK(1),o[d0],0,0,0);
    o[d0]=__builtin_amdgcn_mfma_f32_32x32x16_bf16(pa2,PK(2),o[d0],0,0,0);
    o[d0]=__builtin_amdgcn_mfma_f32_32x32x16_bf16(pa3,PK(3),o[d0],0,0,0);
    #undef PK
  }
}

#ifndef ATTN_STORE16
#define ATTN_STORE16(p,v) (*(u32x4*)(p)=(v))
#endif
template<int THRL> __device__ __forceinline__ void attn_unit(int b,int qb,const bf16*Q,const bf16*__restrict__ K,const bf16*__restrict__ V,bf16*O,char*shm,const __attribute__((address_space(3))) float*tabl,const int tid){
  const int lane=tid&63,r32=lane&31,hi=lane>>5; const int wid=__builtin_amdgcn_readfirstlane(tid>>6);
  const long rowbase=(long)b*SEQ; const int q0=qb*QB;
  const bf16*Qw=Q+(rowbase+q0+wid*QBLK)*DM;
  const bf16*Kh=K+rowbase*DM,*Vh=V+rowbase*DM;
  const unsigned lds0=(unsigned)(uintptr_t)shm;
  float*wsf=(float*)(shm+LDS_WS)+wid*64;
  const bf16*ksrc=Kh+(long)lane*DM+wid*8;
  const bf16*vsrc=Vh+(long)(16*(wid&3)+(lane>>2))*DM+(wid>>2)*32+(lane&3)*8;
  const unsigned kdst=lds0+LDS_K+wid*1024, vdst=lds0+LDS_V+wid*1024;
  #define DMA_K(t,slot) glds16(ksrc+(long)(t)*KVBLK*DM,(unsigned)__builtin_amdgcn_readfirstlane(kdst+(slot)))
  #define DMA_V(t,slot) glds16(vsrc+(long)(t)*KVBLK*DM,(unsigned)__builtin_amdgcn_readfirstlane(vdst+(slot)))
  const int vb0=(int)(lds0+LDS_V)+((lane>>4)&1)*32+(lane&3)*8+(4*hi+((lane&15)>>2))*64;
  const char*Kbase=shm+LDS_K; bf16x8 kf[8];
  const lds_cptr shm3=(lds_cptr)shm; const lds_cptr kp0=shm3+LDS_K+hi*1024+r32*16; const lds_cptr vp0=shm3+LDS_V+((lane>>4)&1)*32+(lane&3)*8+(4*hi+((lane&15)>>2))*64;
  const int NT=(q0+QB)/KVBLK;
  DMA_K(0,0);DMA_V(0,0);DMA_K(1,SLOTB);
  bf16x8 qr[4];
  #pragma unroll
  for(int d0=0;d0<4;++d0)qr[d0]=*reinterpret_cast<const bf16x8*>(&Qw[(long)r32*DM+d0*16+hi*8]);
  float z0_=0.f;asm volatile("":"+v"(z0_));
  float mhat=z0_,l_reg=z0_;f32x16 o[2]; const f32x16 zc_={};
  _Pragma("unroll") for(int r=0;r<16;++r){o[0][r]=z0_;o[1][r]=z0_;}
  const int qrel=wid*QBLK+r32;
  #define CMASK(P0,P1,t) do{int jb_=(t)-(NT-4); if(jb_>=0)cmask(P0,P1,jb_,qrel,hi);}while(0)
  #define BIASADD(P0,P1,t) do{ const __attribute__((address_space(3))) float*tp_=tabl+(q0+qrel-64*(t)-4*hi+(TAB_PAD-63)); \
    _Pragma("unroll") for(int r=0;r<16;++r){ const int c_=(r&3)+8*(r>>2); P0[r]+=tp_[63-c_]; P1[r]+=tp_[31-c_]; if((r&1)==1){SBAR();} } }while(0)
  bool resc=false;
  #define START(P0,P1) do{ const float rm=rowmax(P0,P1); resc=false; \
    { const float dl=rm; mhat=fadd_s(mhat,dl); \
      _Pragma("unroll") for(int r=0;r<16;++r){P0[r]=fsub_s(P0[r],dl);P1[r]=fsub_s(P1[r],dl);} \
      } \
    _Pragma("unroll") for(int r=0;r<16;++r)P0[r]=__builtin_amdgcn_exp2f(P0[r]); }while(0)
  #define RESC() do{ if(resc){ asm volatile("s_waitcnt lgkmcnt(0)":::"memory"); \
      _Pragma("unroll") for(int d_=0;d_<2;++d_) _Pragma("unroll") for(int r=0;r<16;++r)o[d_][r]*=wsf[crow(r,hi)]; } }while(0)
  f32x16 pA0,pA1,pB0,pB1;
  int sl_prev=0,sl_cur=0,sl_next=SLOTB;
  #define ROT() do{sl_prev=sl_cur;sl_cur=sl_next;sl_next=(sl_next==(NSLOT-1)*SLOTB)?0:sl_next+SLOTB;}while(0)
  DMA_K(2,2*SLOTB);
  WAIT_BAR(3);
  qkt(pA0,pA1,Kbase,qr,r32,hi);asm volatile("s_nop 15\n\ts_nop 7":"+v"(pA0),"+v"(pA1)); if(NT<=6){BIASADD(pA0,pA1,0);} CMASK(pA0,pA1,0);
  START(pA0,pA1);
  _Pragma("unroll") for(int r=0;r<16;++r)pA1[r]=__builtin_amdgcn_exp2f(pA1[r]);
  WAIT_BAR(0);
  DMA_K(3,0);DMA_V(1,SLOTB);
  ROT();
  kload8(kf,kp0+sl_cur);
  WAIT_BAR(2);
  s16x4 vlo[8],vhi[8]; u32x4 pw0,pw1,pw2,pw3;
  #define PKW(P,B) cvtpk_s(P[B],P[B+1])
  #define PAF(k) __builtin_bit_cast(bf16x8,pw##k)
  #define VFR(i) (bf16x8){vlo[i][0],vlo[i][1],vlo[i][2],vlo[i][3],vhi[i][0],vhi[i][1],vhi[i][2],vhi[i][3]}
  #define PIN(x) asm volatile("":"+v"(x))
  #define MX3(a,b,c) __builtin_fmaxf(__builtin_fmaxf((a),(b)),(c))
  #define GAPA(MF,A0,A1,A2,A3,W0,W1,PW) do{ MF; sacc+=A0; sacc+=A1; sacc+=A2; sacc+=A3; PIN(sacc); W0; W1; PIN(PW); SBAR(); }while(0)
  #define EX(v) __builtin_amdgcn_exp2f(v)
  #define GAPB(MF,X,B) do{ MF; X[B]=EX(X[B]); X[B+1]=EX(X[B+1]); X[B+2]=EX(X[B+2]); X[B+3]=EX(X[B+3]); PIN(X); SBAR(); }while(0)
  #define VRD(i) do{ vlo[i]=vtr(vp_+(((i)>>2)*4096+((i)&3)*1024)); vhi[i]=vtr(vp_+(((i)>>2)*4096+((i)&3)*1024+512)); }while(0)
  #define KRD(G,j) do{ if(G){ kload2(kf,kp0+sl_next,j); SBAR(); } }while(0)
  #define STEP(C0,C1,P0,P1,t,GK,GV,GL) do{ SBAR(); \
    const lds_cptr vp_=vp0+sl_prev; \
    VRD(0); SBAR(); float sacc=(P0[0]+P0[1]); \
    GAPA(C0=__builtin_amdgcn_mfma_f32_32x32x16_bf16(kf[0],qr[0],zc_,0,0,0), P0[2],P0[3],P0[4],P0[5],     pw0[0]=PKW(P0,0), pw0[1]=PKW(P0,2), pw0); \
    VRD(4); SBAR(); GAPA(C1=__builtin_amdgcn_mfma_f32_32x32x16_bf16(kf[1],qr[0],zc_,0,0,0), P0[6],P0[7],P0[8],P0[9],     pw0[2]=PKW(P0,4), pw0[3]=PKW(P0,6), pw0); \
    VRD(1); SBAR(); GAPA(C0=__builtin_amdgcn_mfma_f32_32x32x16_bf16(kf[2],qr[1],C0,0,0,0),   P0[10],P0[11],P0[12],P0[13], pw1[0]=PKW(P0,8), pw1[1]=PKW(P0,10), pw1); \
    VRD(5); SBAR(); GAPA(C1=__builtin_amdgcn_mfma_f32_32x32x16_bf16(kf[3],qr[1],C1,0,0,0),   P0[14],P0[15],P1[0],P1[1],   pw1[2]=PKW(P0,12),pw1[3]=PKW(P0,14), pw1); \
    VRD(2); SBAR(); GAPA(C0=__builtin_amdgcn_mfma_f32_32x32x16_bf16(kf[4],qr[2],C0,0,0,0),   P1[2],P1[3],P1[4],P1[5],     pw2[0]=PKW(P1,0), pw2[1]=PKW(P1,2), pw2); \
    VRD(6); SBAR(); GAPA(C1=__builtin_amdgcn_mfma_f32_32x32x16_bf16(kf[5],qr[2],C1,0,0,0),   P1[6],P1[7],P1[8],P1[9],     pw2[2]=PKW(P1,4), pw2[3]=PKW(P1,6), pw2); \
    VRD(3); SBAR(); GAPA(C0=__builtin_amdgcn_mfma_f32_32x32x16_bf16(kf[6],qr[3],C0,0,0,0),   P1[10],P1[11],P1[12],P1[13], pw3[0]=PKW(P1,8), pw3[1]=PKW(P1,10), pw3); \
    VRD(7); SBAR(); GAPA(C1=__builtin_amdgcn_mfma_f32_32x32x16_bf16(kf[7],qr[3],C1,0,0,0),   P1[14],P1[15],0.f,0.f,       pw3[2]=PKW(P1,12),pw3[3]=PKW(P1,14), pw3); \
    l_reg+=sacc; \
    if(GK){DMA_K((t)+3,sl_cur);} if(GV){DMA_V((t)+1,sl_next);} \
    BIASQ(C0,C1,t); CMASK(C0,C1,t); \
    { float a=MX3(C0[0],C0[1],C1[0]),b=MX3(C0[2],C0[3],C1[1]); a=MX3(a,C1[2],C1[3]); \
      _Pragma("unroll") for(int r=4;r<16;r+=4){a=MX3(a,C0[r],C0[r+1]);b=MX3(b,C0[r+2],C0[r+3]);a=MX3(a,C1[r],C1[r+1]);b=MX3(b,C1[r+2],C1[r+3]);} \
      float rm=__builtin_fmaxf(a,b); { auto rr=__builtin_amdgcn_permlane32_swap(__float_as_uint(rm),__float_as_uint(rm),false,false); rm=__builtin_fmaxf(__uint_as_float(rr[0]),__uint_as_float(rr[1])); } \
      rm-=mhat; resc=false; \
      if(__builtin_expect(__any(rm>(float)THRL),0)){ const float dl=__builtin_fmaxf(rm,0.f); mhat+=dl; \
        const float f=__builtin_amdgcn_exp2f(-dl); l_reg*=f; if(hi==0)wsf[r32]=f; resc=true; } \
      _Pragma("unroll") for(int r=0;r<16;++r){C0[r]-=mhat;C1[r]-=mhat;} } \
    SBAR(); \
    GAPB(o[0]=__builtin_amdgcn_mfma_f32_32x32x16_bf16(PAF(0),VFR(0),o[0],0,0,0), C0,0); \
    GAPB(o[1]=__builtin_amdgcn_mfma_f32_32x32x16_bf16(PAF(0),VFR(4),o[1],0,0,0), C0,4); \
    KRD(GL,0); GAPB(o[0]=__builtin_amdgcn_mfma_f32_32x32x16_bf16(PAF(1),VFR(1),o[0],0,0,0), C0,8); \
    KRD(GL,1); GAPB(o[1]=__builtin_amdgcn_mfma_f32_32x32x16_bf16(PAF(1),VFR(5),o[1],0,0,0), C0,12); \
    KRD(GL,2); GAPB(o[0]=__builtin_amdgcn_mfma_f32_32x32x16_bf16(PAF(2),VFR(2),o[0],0,0,0), C1,0); \
    KRD(GL,3); GAPB(o[1]=__builtin_amdgcn_mfma_f32_32x32x16_bf16(PAF(2),VFR(6),o[1],0,0,0), C1,4); \
    GAPB(o[0]=__builtin_amdgcn_mfma_f32_32x32x16_bf16(PAF(3),VFR(3),o[0],0,0,0), C1,8); \
    GAPB(o[1]=__builtin_amdgcn_mfma_f32_32x32x16_bf16(PAF(3),VFR(7),o[1],0,0,0), C1,12); \
    }while(0)
  int t=1;
  #undef CMASK
  #define CMASK(P0,P1,t) do{}while(0)
  #define BIASQ(P0,P1,t) do{}while(0)
  for(;t+7<NT;t+=2){
    STEP(pB0,pB1,pA0,pA1,t,true,true,true);     WAIT_BAR(2); RESC(); ROT();
    STEP(pA0,pA1,pB0,pB1,t+1,true,true,true);   WAIT_BAR(2); RESC(); ROT();
  }
  #undef CMASK
  #undef BIASQ
  #define CMASK(P0,P1,t) do{int jb_=(t)-(NT-4); if(jb_>=0)cmask(P0,P1,jb_,qrel,hi);}while(0)
  #define BIASQ(P0,P1,t) BIASADD(P0,P1,t)
  #define ENDW(tt) do{ if((tt)+3<NT){WAIT_BAR(2);} else if((tt)+2<NT){WAIT_BAR(1);} else {WAIT_BAR(0);} }while(0)
  for(;t+1<NT;t+=2){
    STEP(pB0,pB1,pA0,pA1,t,(t+3<NT),(t+1<NT),(t+1<NT));       ENDW(t);   RESC(); ROT();
    STEP(pA0,pA1,pB0,pB1,t+1,(t+4<NT),(t+2<NT),(t+2<NT));     ENDW(t+1); RESC(); ROT();
  }
  STEP(pB0,pB1,pA0,pA1,NT-1,false,false,false); RESC();
  { float sacc=pB0[0]+pB0[1]; _Pragma("unroll") for(int r=2;r<16;++r)sacc+=pB0[r]; _Pragma("unroll") for(int r=0;r<16;++r)sacc+=pB1[r]; l_reg+=sacc;
    pw0=(u32x4){PKW(pB0,0),PKW(pB0,2),PKW(pB0,4),PKW(pB0,6)};pw1=(u32x4){PKW(pB0,8),PKW(pB0,10),PKW(pB0,12),PKW(pB0,14)};pw2=(u32x4){PKW(pB1,0),PKW(pB1,2),PKW(pB1,4),PKW(pB1,6)};pw3=(u32x4){PKW(pB1,8),PKW(pB1,10),PKW(pB1,12),PKW(pB1,14)};
    SBAR(); pv(o,vb0+sl_cur,PAF(0),PAF(1),PAF(2),PAF(3)); }
  #undef PKW
  #undef PAF
  #undef VFR
  #undef PIN
  #undef MX3
  #undef GAPA
  #undef GAPB
  #undef EX
  #undef VRD
  #undef KRD
  #undef STEP
  #undef ENDW
  {auto rr=__builtin_amdgcn_permlane32_swap(__float_as_uint(l_reg),__float_as_uint(l_reg),false,false);l_reg=__uint_as_float(rr[0])+__uint_as_float(rr[1]);}
  int lane_e=lane; asm volatile("":"+v"(lane_e)); const int r32e=lane_e&31,hie=lane_e>>5;
  float*wsfe=(float*)(shm+LDS_WS)+wid*64;
  if(hie==0)wsfe[32+r32e]=l_reg;asm volatile("s_waitcnt lgkmcnt(0)":::"memory");
  float rli[16];
  #pragma unroll
  for(int r=0;r<16;++r)rli[r]=__builtin_amdgcn_rcpf(wsfe[32+crow(r,hie)]);
  bf16*Ow=O+(rowbase+q0+wid*QBLK)*OPITCH;
  { bf16*stg=(bf16*)(shm+LDS_OST)+wid*2048;
    #pragma unroll
    for(int r=0;r<16;++r){const int orow=crow(r,hie);
      #pragma unroll
      for(int d0=0;d0<2;++d0)stg[orow*64+d0*32+r32e]=__float2bfloat16(o[d0][r]*rli[r]);}
    asm volatile("s_waitcnt lgkmcnt(0)":::"memory");
    #pragma unroll
    for(int i=0;i<4;++i){const int row=i*8+(lane_e>>3),ch=lane_e&7; const u32x4 v=*(const u32x4*)(stg+row*64+ch*8); ATTN_STORE16(Ow+(long)row*OPITCH+ch*8,v);} }
  asm volatile("s_waitcnt lgkmcnt(0)\n\ts_barrier":::"memory");
  #undef DMA_K
  #undef DMA_V
  #undef CMASK
  #undef BIASQ
  #undef BIASADD
  #undef START
  #undef RESC
  #undef ROT
}
constexpr int ATTN_LDS_BYTES=LDS_BYTES;
constexpr int SB_KB=0, SB_VB=16384, SB_FLG=32768, SB_OST=33024, SB_LDS=SB_OST+NW*4096;
__device__ __forceinline__ void sb_unit(int b,int qb,bf16*Qp,const bf16*__restrict__ Kp,const bf16*__restrict__ Vp,char*shm,const int tid,const bool st){
  const int lane=tid&63,r32=lane&31,hi=lane>>5; const int wid=__builtin_amdgcn_readfirstlane(tid>>6);
  const long rowbase=(long)b*SEQ; const int q0=qb*QB;
  bf16*Qw=Qp+(rowbase+q0+wid*QBLK)*DM;
  bf16x8 qr[4];
  #pragma unroll
  for(int d0=0;d0<4;++d0)qr[d0]=*reinterpret_cast<const bf16x8*>(&Qw[(long)r32*DM+d0*16+hi*8]);
  bf16x8 UA,UB,ONES;
  #pragma unroll
  for(int j=0;j<8;++j){ const int kvp=8*(j>>2)+4*hi+(j&3); UA[j]=(kvp>r32)?(short)0x3F80:(short)0; UB[j]=(kvp+16>r32)?(short)0x3F80:(short)0; ONES[j]=(short)0x3F80; }
  float z0_=0.f;asm volatile("":"+v"(z0_));
  f32x16 o[2]; float R=z0_;
  #pragma unroll
  for(int r=0;r<16;++r){o[0][r]=z0_;o[1][r]=z0_;}
  const int qw0=q0+wid*QBLK, qabs=qw0+r32;
  const int NT=(q0+QB)/KVBLK;
  const bf16*ksrc=Kp+(rowbase+lane)*DM+wid*8;
  const bf16*vsrc=Vp+(rowbase+16*(wid&3)+(lane>>2))*DM+(wid>>2)*32+(lane&3)*8;
  typedef __attribute__((address_space(3))) u32x4* lds_u4p;
  const lds_cptr shm3=(lds_cptr)shm;
  const unsigned lds0=(unsigned)(uintptr_t)shm;
  volatile __attribute__((address_space(3))) int*flg=(volatile __attribute__((address_space(3))) int*)(shm3+SB_FLG);
  u32x4 kreg,vreg; int kt=NT-1,cur=0;
  kreg=*(const u32x4*)(ksrc+(long)kt*KVBLK*DM); vreg=*(const u32x4*)(vsrc+(long)kt*KVBLK*DM);
  bool done_w=false;
  for(;;){
    *(lds_u4p)(shm3+SB_KB+cur*8192+wid*1024+lane*16)=kreg; *(lds_u4p)(shm3+SB_VB+cur*8192+wid*1024+lane*16)=vreg;
    __syncthreads();
    if(kt>0){ kreg=*(const u32x4*)(ksrc+(long)(kt-1)*KVBLK*DM); vreg=*(const u32x4*)(vsrc+(long)(kt-1)*KVBLK*DM); }
    if(64*kt<qw0+31 && !done_w){
      f32x16 p0,p1; qkt(p0,p1,shm+SB_KB+cur*8192,qr,r32,hi);
      const int kv0=64*kt+4*hi;
      f32x16 L0,L1;
      #pragma unroll
      for(int r=0;r<16;++r){ const int kv=kv0+(r&3)+8*(r>>2);
        { const float z=p0[r]; const float sp=__builtin_fmaxf(z,0.f)+__builtin_amdgcn_logf(1.f+__builtin_amdgcn_exp2f(-__builtin_fabsf(z))); L0[r]=(kv<qabs)?-sp:0.f; }
        { const float z=p1[r]; const float sp=__builtin_fmaxf(z,0.f)+__builtin_amdgcn_logf(1.f+__builtin_amdgcn_exp2f(-__builtin_fabsf(z))); L1[r]=(kv+32<qabs)?-sp:0.f; } }
      u32x4 lh[4],ll[4];
      #pragma unroll
      for(int s=0;s<4;++s)
        #pragma unroll
        for(int e=0;e<4;++e){ const float a=(s<2)?L0[8*s+2*e]:L1[8*(s-2)+2*e], c=(s<2)?L0[8*s+2*e+1]:L1[8*(s-2)+2*e+1];
          const unsigned h2=cvtpk_s(a,c); lh[s][e]=h2; ll[s][e]=cvtpk_s(a-__uint_as_float(h2<<16),c-__uint_as_float(h2&0xffff0000u)); }
      #define BF8(x) __builtin_bit_cast(bf16x8,x)
      const f32x16 zc_={};
      f32x16 T0=__builtin_amdgcn_mfma_f32_32x32x16_bf16(UA,BF8(lh[0]),zc_,0,0,0);
      T0=__builtin_amdgcn_mfma_f32_32x32x16_bf16(UA,BF8(ll[0]),T0,0,0,0);
      T0=__builtin_amdgcn_mfma_f32_32x32x16_bf16(UB,BF8(lh[1]),T0,0,0,0); T0=__builtin_amdgcn_mfma_f32_32x32x16_bf16(UB,BF8(ll[1]),T0,0,0,0);
      T0=__builtin_amdgcn_mfma_f32_32x32x16_bf16(ONES,BF8(lh[2]),T0,0,0,0); T0=__builtin_amdgcn_mfma_f32_32x32x16_bf16(ONES,BF8(ll[2]),T0,0,0,0);
      T0=__builtin_amdgcn_mfma_f32_32x32x16_bf16(ONES,BF8(lh[3]),T0,0,0,0); T0=__builtin_amdgcn_mfma_f32_32x32x16_bf16(ONES,BF8(ll[3]),T0,0,0,0);
      f32x16 T1=__builtin_amdgcn_mfma_f32_32x32x16_bf16(UA,BF8(lh[2]),zc_,0,0,0);
      T1=__builtin_amdgcn_mfma_f32_32x32x16_bf16(UA,BF8(ll[2]),T1,0,0,0);
      T1=__builtin_amdgcn_mfma_f32_32x32x16_bf16(UB,BF8(lh[3]),T1,0,0,0); T1=__builtin_amdgcn_mfma_f32_32x32x16_bf16(UB,BF8(ll[3]),T1,0,0,0);
      float tot=T0[0]+L0[0]; { auto rr=__builtin_amdgcn_permlane32_swap(__float_as_uint(tot),__float_as_uint(tot),false,false); tot=__uint_as_float(rr[0]); }
      #pragma unroll
      for(int r=0;r<16;++r){ const int kv=kv0+(r&3)+8*(r>>2);
        p0[r]=(kv<qabs)?__builtin_amdgcn_exp2f(p0[r]+L0[r]+T0[r]+R):0.f; p1[r]=(kv+32<qabs)?__builtin_amdgcn_exp2f(p1[r]+L1[r]+T1[r]+R):0.f; }
      R+=tot;
      u32x4 pw0,pw1,pw2,pw3;
      pw0=(u32x4){cvtpk_s(p0[0],p0[1]),cvtpk_s(p0[2],p0[3]),cvtpk_s(p0[4],p0[5]),cvtpk_s(p0[6],p0[7])}; pw1=(u32x4){cvtpk_s(p0[8],p0[9]),cvtpk_s(p0[10],p0[11]),cvtpk_s(p0[12],p0[13]),cvtpk_s(p0[14],p0[15])};
      pw2=(u32x4){cvtpk_s(p1[0],p1[1]),cvtpk_s(p1[2],p1[3]),cvtpk_s(p1[4],p1[5]),cvtpk_s(p1[6],p1[7])}; pw3=(u32x4){cvtpk_s(p1[8],p1[9]),cvtpk_s(p1[10],p1[11]),cvtpk_s(p1[12],p1[13]),cvtpk_s(p1[14],p1[15])};
      SBAR();
      const int vb=(int)(lds0+SB_VB+cur*8192)+((lane>>4)&1)*32+(lane&3)*8+(4*hi+((lane&15)>>2))*64;
      pv(o,vb,BF8(pw0),BF8(pw1),BF8(pw2),BF8(pw3));
      #undef BF8
      done_w=__all(R<-150.f);
    }
    if(lane==0)flg[wid]=done_w?1:0;
    __syncthreads();
    int alld=1;
    #pragma unroll
    for(int w=0;w<NW;++w)alld&=flg[w];
    if(alld||kt==0)break;
    --kt;cur^=1;
  }
  { int lane_e=lane; asm volatile("":"+v"(lane_e)); const int r32e=lane_e&31,hie=lane_e>>5;
    bf16*stg=(bf16*)(shm+SB_OST)+wid*2048;
    #pragma unroll
    for(int r=0;r<16;++r){const int orow=crow(r,hie);
      #pragma unroll
      for(int d0=0;d0<2;++d0)stg[orow*64+d0*32+r32e]=__float2bfloat16(o[d0][r]);}
    asm volatile("s_waitcnt lgkmcnt(0)":::"memory");
    #pragma unroll
    for(int i=0;i<4;++i){const int row=i*8+(lane_e>>3),ch=lane_e&7; const u32x4 v=*(const u32x4*)(stg+row*64+ch*8); if(st)*(u32x4*)(Qw+(long)row*DM+ch*8)=v; else asm volatile(""::"v"(v));} }
  __syncthreads();
}
__device__ __forceinline__ void sb_attn_phase(char*lds,bf16*P,int vcu,int G,const int tid,const bool st=true){
  #pragma unroll 1
  for(int u=vcu;u<512;u+=G){ int u_=u; asm volatile("":"+s"(u_)); int tid_=tid; asm volatile("":"+v"(tid_));
    const int qb=u_&15,bh=u_>>4,h=bh&7,b=bh>>3;
    sb_unit(b,qb,P+1024+h*64,P+2048+h*64,P+2560+h*64,lds,tid_,st); }
}
constexpr int SO_CBT=0, SO_XD=40960, SO_PV=73728, SO_SC=106496, SO_STG=108544, SO_END=SO_STG+8*2048;
__device__ __forceinline__ bf16x8 vfrag(lds_cptr vb,int i){ const s16x4 lo=vtr(vb+((i>>2)*4096+(i&3)*1024)), hh=vtr(vb+((i>>2)*4096+(i&3)*1024+512)); return (bf16x8){lo[0],lo[1],lo[2],lo[3],hh[0],hh[1],hh[2],hh[3]}; }
__device__ __forceinline__ float bfl(unsigned w){return __uint_as_float(w<<16);} __device__ __forceinline__ float bfh(unsigned w){return __uint_as_float(w&0xffff0000u);}
__device__ __forceinline__ float lane_get_f(float v,int src){ return __int_as_float(__builtin_amdgcn_ds_bpermute(src<<2,__float_as_int(v))); }
__device__ __forceinline__ void ssd_scalars(__attribute__((address_space(3))) float*sc,const float*DT,int r0,int h,float dtb,float alog,int lane){
  const float a2=-__expf(alog)*1.4426950408889634f;
  float d0=DT[(size_t)(r0+2*lane)*16+h]+dtb, d1=DT[(size_t)(r0+2*lane+1)*16+h]+dtb;
  d0=__builtin_fmaxf(d0,0.f)+__logf(1.f+__expf(-__builtin_fabsf(d0))); d1=__builtin_fmaxf(d1,0.f)+__logf(1.f+__expf(-__builtin_fabsf(d1)));
  const float v0=d0*a2,v1=d1*a2; float s=v0+v1;
  #pragma unroll
  for(int o=1;o<64;o<<=1){ const float t=lane_get_f(s,lane-o); if(lane>=o)s+=t; }
  sc[2*lane]=s-v1; sc[2*lane+1]=s; sc[128+2*lane]=d0; sc[128+2*lane+1]=d1;
  asm volatile("s_waitcnt lgkmcnt(0)":::"memory");
}
__device__ __forceinline__ void ssd_out_unit(int gc,int g,bf16*P,const float*ST,const float*DT,const float*dtb,const float*alog,const float*dsk,char*shm,const int tid,const bool st=true,const int skip=0){
  const int lane=tid&63,r32=lane&31,hi=lane>>5; const int wid=__builtin_amdgcn_readfirstlane(tid>>6); const int e=wid>>2,q4=wid&3,pr=q4>>1,pb=q4&1;
  const int r0=gc*128; const lds_cptr s3=(lds_cptr)shm;
  typedef __attribute__((address_space(3))) u32x4* lds_u4p; typedef __attribute__((address_space(3))) float* lds_fp; typedef __attribute__((address_space(3))) unsigned short* lds_hp;
  #define MF(a,b,c) __builtin_amdgcn_mfma_f32_32x32x16_bf16(a,b,c,0,0,0)
  for(int blk=wid;blk<10;blk+=8){ const int lb=(blk<1)?0:(blk<3)?1:(blk<6)?2:3, sb=blk-lb*(lb+1)/2; f32x16 acc={};
    const bf16*bp=P+(size_t)(r0+32*sb+r32)*DM+5120+g*128+8*hi; const bf16*cp=P+(size_t)(r0+32*lb+r32)*DM+5376+g*128+8*hi;
    #pragma unroll
    for(int ks=0;ks<8;++ks){ const bf16x8 a=*reinterpret_cast<const bf16x8*>(bp+16*ks); const bf16x8 b=*reinterpret_cast<const bf16x8*>(cp+16*ks); acc=MF(a,b,acc); }
    #pragma unroll
    for(int r=0;r<16;++r)*(lds_fp)(s3+SO_CBT+blk*4096+r*256+lane*4)=acc[r]; }
  #pragma unroll 1
  for(int rd=0;rd<4;++rd){
    __syncthreads();
    const int h=8*g+2*rd+e;
    const lds_fp sc=(lds_fp)(s3+SO_SC+e*1024);
    ssd_scalars(sc,DT,r0,h,dtb[h],alog[h],lane);
    #pragma unroll
    for(int j=0;j<4;++j){ const int row=64*pr+16*j+(lane>>2); const u32x4 v=*(const u32x4*)(P+(size_t)(r0+row)*DM+4096+h*64+pb*32+(lane&3)*8); const float f=sc[128+row];
      u32x4 w; w.x=cvtpk_s(bfl(v.x)*f,bfh(v.x)*f); w.y=cvtpk_s(bfl(v.y)*f,bfh(v.y)*f); w.z=cvtpk_s(bfl(v.z)*f,bfh(v.z)*f); w.w=cvtpk_s(bfl(v.w)*f,bfh(v.w)*f);
      *(lds_u4p)(s3+SO_XD+e*16384+pr*8192+(4*pb+j)*1024+lane*16)=w; }
    { const float*sp=ST+(((size_t)gc*16+h)*64+lane)*128+32*q4;
      #pragma unroll
      for(int j=0;j<4;++j){ const f32x4 x0=*(const f32x4*)(sp+8*j),x1=*(const f32x4*)(sp+8*j+4); u32x4 w; w.x=cvtpk_s(x0[0],x0[1]); w.y=cvtpk_s(x0[2],x0[3]); w.z=cvtpk_s(x1[0],x1[1]); w.w=cvtpk_s(x1[2],x1[3]);
        *(lds_u4p)(s3+SO_PV+e*16384+(4*q4+j)*1024+lane*16)=w; } }
    __syncthreads();
    const float dh=dsk[h];
    const lds_cptr stg=s3+SO_STG+wid*2048;
    #pragma unroll 1
    for(int li=0;li<2;++li){ const int lb=pr?(1+li):(3*li);
      bf16*zt=P+(size_t)(r0+32*lb+(lane>>2))*DM+h*64+32*pb+(lane&3)*8; u32x4 zr[2];
      #pragma unroll
      for(int i=0;i<2;++i)zr[i]=*(const u32x4*)(zt+(size_t)i*16*DM);
      f32x16 acc=f32x16{};
      const bf16*cp=P+(size_t)(r0+32*lb+r32)*DM+5376+g*128+8*hi;
      if(!(skip&2))
      #pragma unroll
      for(int ks=0;ks<8;++ks){ const bf16x8 a=*reinterpret_cast<const bf16x8*>(cp+16*ks); const bf16x8 bq=*(const __attribute__((address_space(3))) bf16x8*)(s3+SO_PV+e*16384+(2*ks+hi)*1024+(32*pb+r32)*16); acc=MF(a,bq,acc); }
      #pragma unroll
      for(int r=0;r<16;++r)acc[r]*=__builtin_amdgcn_exp2f(sc[32*lb+crow(r,hi)]);
      const float al=sc[32*lb+r32];
      if(!(skip&4))for(int sb=0;sb<=lb;++sb){ const int blk=lb*(lb+1)/2+sb; float gv[16];
        #pragma unroll
        for(int r=0;r<16;++r){ const float c=*(lds_fp)(s3+SO_CBT+blk*4096+r*256+lane*4); const int sr=crow(r,hi);
          const float v=c*__builtin_amdgcn_exp2f(al-sc[32*sb+sr]); gv[r]=(sb==lb&&sr>r32)?0.f:v; }
        u32x4 w0,w1; w0.x=cvtpk_s(gv[0],gv[1]); w0.y=cvtpk_s(gv[2],gv[3]); w0.z=cvtpk_s(gv[4],gv[5]); w0.w=cvtpk_s(gv[6],gv[7]);
        w1.x=cvtpk_s(gv[8],gv[9]); w1.y=cvtpk_s(gv[10],gv[11]); w1.z=cvtpk_s(gv[12],gv[13]); w1.w=cvtpk_s(gv[14],gv[15]);
        const lds_cptr vb=s3+SO_XD+e*16384+(sb>>1)*8192+((lane>>4)&1)*32+(lane&3)*8+(4*hi+((lane&15)>>2))*64;
        acc=MF(__builtin_bit_cast(bf16x8,w0),vfrag(vb,(sb&1)*2+4*pb),acc); acc=MF(__builtin_bit_cast(bf16x8,w1),vfrag(vb,(sb&1)*2+1+4*pb),acc); }
      if(skip&8){ asm volatile(""::"v"(acc),"v"(zr[0]),"v"(zr[1])); continue; }
      #pragma unroll
      for(int i=0;i<2;++i)*(lds_u4p)(stg+(i*16+(lane>>2))*64+(lane&3)*16)=zr[i];
      asm volatile("s_waitcnt lgkmcnt(0)":::"memory");
      const lds_cptr xim=s3+SO_XD+e*16384+(lb>>1)*8192+pb*4096+(32*(lb&1))*64+r32*2;
      float vv[16];
      #pragma unroll
      for(int r=0;r<16;++r){ const int rr=crow(r,hi); const float z=__uint_as_float((unsigned)*(const lds_hp)(stg+rr*64+r32*2)<<16);
        const float xd=__uint_as_float((unsigned)*(const lds_hp)(xim+rr*64)<<16); const float x=xd*__builtin_amdgcn_rcpf(sc[128+32*lb+rr]);
        vv[r]=(acc[r]+dh*x)*z*__builtin_amdgcn_rcpf(1.f+__expf(-z)); }
      #pragma unroll
      for(int r=0;r<16;++r)*(lds_hp)(stg+crow(r,hi)*64+r32*2)=(unsigned short)(cvtpk_s(vv[r],0.f)&0xffffu);
      asm volatile("s_waitcnt lgkmcnt(0)":::"memory");
      #pragma unroll
      for(int i=0;i<2;++i){ const u32x4 v=*(const lds_u4p)(stg+(i*16+(lane>>2))*64+(lane&3)*16); if(st)*(u32x4*)(zt+(size_t)i*16*DM)=v; else asm volatile(""::"v"(v)); }
    }
  }
  #undef MF
  __syncthreads();
}
constexpr int SS_B=0, SS_X=32768, SS_SC=98304, SS_END=SS_SC+4096;
__device__ __forceinline__ void ssd_state_unit(int gc,int g,const bf16*P,float*ST,float*CD,const float*DT,const float*dtb,const float*alog,char*shm,const int tid){
  const int lane=tid&63,r32=lane&31,hi=lane>>5; const int wid=__builtin_amdgcn_readfirstlane(tid>>6); const int e=wid>>1,pr=wid&1;
  const int r0=gc*128; const lds_cptr s3=(lds_cptr)shm;
  typedef __attribute__((address_space(3))) u32x4* lds_u4p; typedef __attribute__((address_space(3))) float* lds_fp;
  #pragma unroll
  for(int i=0;i<4;++i){ const int row=64*(i>>1)+16*(wid&3)+(lane>>2),col=64*(i&1)+(wid>>2)*32+(lane&3)*8;
    *(lds_u4p)(s3+SS_B+i*8192+wid*1024+lane*16)=*(const u32x4*)(P+(size_t)(r0+row)*DM+5120+g*128+col); }
  const int voff=((lane>>4)&1)*32+(lane&3)*8+(4*hi+((lane&15)>>2))*64;
  #pragma unroll 1
  for(int rd=0;rd<2;++rd){
    __syncthreads();
    const int h=8*g+4*rd+e;
    const lds_fp sc=(lds_fp)(s3+SS_SC+e*1024);
    ssd_scalars(sc,DT,r0,h,dtb[h],alog[h],lane);
    const float aend=sc[127];
    #pragma unroll
    for(int i=0;i<8;++i){ const int row=64*pr+16*(i&3)+(lane>>2); const u32x4 v=*(const u32x4*)(P+(size_t)(r0+row)*DM+4096+h*64+(i>>2)*32+(lane&3)*8); const float f=sc[128+row]*__builtin_amdgcn_exp2f(aend-sc[row]);
      u32x4 w; w.x=cvtpk_s(bfl(v.x)*f,bfh(v.x)*f); w.y=cvtpk_s(bfl(v.y)*f,bfh(v.y)*f); w.z=cvtpk_s(bfl(v.z)*f,bfh(v.z)*f); w.w=cvtpk_s(bfl(v.w)*f,bfh(v.w)*f);
      *(lds_u4p)(s3+SS_X+e*16384+pr*8192+i*1024+lane*16)=w; }
    __syncthreads();
    f32x16 acc[4]; acc[0]=f32x16{}; acc[1]=f32x16{}; acc[2]=f32x16{}; acc[3]=f32x16{};
    #pragma unroll
    for(int ks=0;ks<8;++ks){ const int rh=ks>>2,kk=ks&3;
      const bf16x8 a=vfrag(s3+SS_X+e*16384+rh*8192+voff,kk+4*pr);
      #pragma unroll
      for(int nb=0;nb<4;++nb){ const bf16x8 bq=vfrag(s3+SS_B+(rh*2+(nb>>1))*8192+voff,kk+4*(nb&1)); acc[nb]=__builtin_amdgcn_mfma_f32_32x32x16_bf16(a,bq,acc[nb],0,0,0); } }
    float*dst=ST+(((size_t)gc*16+h)*64+32*pr)*128+r32;
    #pragma unroll
    for(int nb=0;nb<4;++nb)
      #pragma unroll
      for(int r=0;r<16;++r)dst[(size_t)crow(r,hi)*128+32*nb]=acc[nb][r];
    if(pr==0&&lane==0)CD[gc*16+h]=__builtin_amdgcn_exp2f(aend);
  }
  __syncthreads();
}
template<int THRL=8> __device__ __forceinline__ void diff_attn_phase(char*lds,const bf16*P,bf16*OD,const __attribute__((address_space(3))) float*tab,int vcu,int G,const int tid){
  for(int st=vcu;st<256;st+=G){
    #pragma unroll 1
    for(int i=0;i<4;++i){ int st_=st; asm volatile("":"+s"(st_)); int tid_=tid; asm volatile("":"+v"(tid_));
      const int bhv=st_>>2,s=st_&3,b=bhv>>4,hv=bhv&15,h=hv>>2,m=(hv>>1)&1,vh=hv&1;
      const bf16*Q=P+1536+h*128+m*64,*K=P+3072+h*128+m*64,*V=P+3584+h*128+vh*64; bf16*O=OD+hv*64;
      const int qb=(i==0)?s:(i==1)?7-s:(i==2)?8+s:15-s; attn_unit<THRL>(b,qb,Q,K,V,O,lds,tab+h*TAB_N,tid_); } }
}
#undef SBAR
#undef WAIT_BAR
}
#define GAS __attribute__((address_space(1)))
typedef GAS unsigned gu32;
#define RLX_AGENT __ATOMIC_RELAXED, __HIP_MEMORY_SCOPE_AGENT
#define XB_TMO      128
#define XB_XCNT(j)  (256  + 64 * (j))
#define XB_XSUB(j)  (1280 + 64 * (j))
#define XB_XGEN(j)  (2304 + 64 * (j))
#define XB_TOP      3328
#define XB_TOPGEN   3392
#define XCD_BAR_WORDS 3456
#define XB_SPIN_CAP (1u << 18)

__device__ __forceinline__ unsigned xb_ld(unsigned* p)              { return __hip_atomic_load(p, __ATOMIC_RELAXED, __HIP_MEMORY_SCOPE_AGENT); }
__device__ __forceinline__ unsigned xb_add(unsigned* p, unsigned v) { return __hip_atomic_fetch_add(p, v, __ATOMIC_RELAXED, __HIP_MEMORY_SCOPE_AGENT); }
__device__ __forceinline__ unsigned xb_xcc_id() { return (unsigned)__builtin_amdgcn_s_getreg((3 << 11) | 20) & 0xFu; }
#define XB_SPIN(cond, bar) do { unsigned _sp = 0; while (cond) { __builtin_amdgcn_s_sleep(1); \
    if ((++_sp & 255u) == 0u) { if (xb_ld(&(bar)[XB_TMO])) break; if (_sp > XB_SPIN_CAP) { atomicAdd(&(bar)[XB_TMO], 1u); break; } } } } while (0)

struct XcdBarrier {
    unsigned* bar; unsigned x; bool lead;
    volatile LAS unsigned* st;
};

__device__ __forceinline__ XcdBarrier xcd_barrier_post(unsigned* bar, volatile LAS unsigned* st) {
    XcdBarrier b; b.bar = bar; b.x = xb_xcc_id(); b.st = st; b.lead = threadIdx.x == 0;
    if (threadIdx.x == 0) (void)xb_add(&bar[XB_XCNT(b.x)], 1u);
    return b;
}
__device__ __forceinline__ void xcd_barrier_complete(unsigned* bar, unsigned x, unsigned& nloc, unsigned& nx) {
    const unsigned G = gridDim.x * gridDim.y * gridDim.z;
    unsigned sum, cnt, mine, sp = 0u;
    for (;;) {
        sum = 0u; cnt = 0u; mine = 0u;
#pragma unroll
        for (unsigned j = 0; j < 16; ++j) { const unsigned c = xb_ld(&bar[XB_XCNT(j)]); sum += c; cnt += (c > 0u) ? 1u : 0u; mine = (j == x) ? c : mine; }
        if (sum == G) break;
        __builtin_amdgcn_s_sleep(1);
        if ((++sp & 255u) == 0u) { if (xb_ld(&bar[XB_TMO])) break; if (sp > XB_SPIN_CAP) { atomicAdd(&bar[XB_TMO], 1u); break; } }
    }
    nloc = mine > 0u ? mine : 1u; nx = cnt > 0u ? cnt : 1u;
}

__device__ __forceinline__ void xcd_barrier(const XcdBarrier& b) {
    asm volatile("s_waitcnt vmcnt(0)" ::: "memory");
    __syncthreads();
    if (b.lead) {
        unsigned* bar = b.bar;
        __builtin_amdgcn_s_waitcnt(0);
        unsigned nloc = b.st[0], nx = b.st[1];
        if (nloc == 0u) { xcd_barrier_complete(bar, b.x, nloc, nx); b.st[0] = nloc; b.st[1] = nx; }
        const unsigned old = xb_add(&bar[XB_XSUB(b.x)], 1u);
        const unsigned gen = old / nloc;
        if (old + 1u == (gen + 1u) * nloc) {
            __builtin_amdgcn_fence(__ATOMIC_RELEASE, "agent");
            asm volatile("s_waitcnt vmcnt(0)" ::: "memory");
            const unsigned og = xb_add(&bar[XB_TOP], 1u);
            const unsigned tg = og / nx;
            if (og + 1u == (tg + 1u) * nx) xb_add(&bar[XB_TOPGEN], 1u);
            else XB_SPIN(xb_ld(&bar[XB_TOPGEN]) == tg, bar);
            __builtin_amdgcn_fence(__ATOMIC_ACQUIRE, "agent");
            xb_add(&bar[XB_XGEN(b.x)], 1u);
            asm volatile("s_waitcnt vmcnt(0)" ::: "memory");
        } else {
            XB_SPIN(xb_ld(&bar[XB_XGEN(b.x)]) == gen, bar);
            __builtin_amdgcn_fence(__ATOMIC_ACQUIRE, "agent");
            asm volatile("s_waitcnt vmcnt(0)" ::: "memory");
        }
    }
    __syncthreads();
}
DEV void ph_diff_combine(const Params& p, int l, int gw, int ngw, int lane) {
    bf16_t* P = (bf16_t*)(p.ws + WS_P); const bf16_t* OD = (const bf16_t*)(p.ws + WS_OD); const float* misc = (const float*)(p.ws + WS_MISC);
    const float lam = misc[l]; const float linit = lambda_init_of(l);
    const float g0 = p.in[I_SUB][(size_t)l * 128 + 2 * lane] * (1.f - linit), g1 = p.in[I_SUB][(size_t)l * 128 + 2 * lane + 1] * (1.f - linit);
    for (int row = gw; row < M; row += ngw) {
#pragma unroll
        for (int h = 0; h < 4; ++h) { const unsigned o0 = *(const unsigned*)(OD + (size_t)row * 1024 + h * 256 + 2 * lane), o1 = *(const unsigned*)(OD + (size_t)row * 1024 + h * 256 + 128 + 2 * lane);
            const float ya = bflo(o0) - lam * bflo(o1), yb = bfhi(o0) - lam * bfhi(o1);
            const float rs = rsqrtf(wave_sum(ya * ya + yb * yb, lane) * (1.f / 128.f) + EPS);
            *(unsigned*)(P + (size_t)row * PW + PDQ + h * 128 + 2 * lane) = pk2(ya * rs * g0, yb * rs * g1); }
    }
}
constexpr int LDS_TAB_OFF = 86016;
DEV void ph_diff_table(const Params& p, LAS unsigned char* lds, int tid) {
    LAS float* tab = (LAS float*)(lds + LDS_TAB_OFF); const float* bt = (const float*)(p.ws + WS_MISC) + 64;
    for (int j = tid; j < 4 * attn_body::TAB_N; j += NTHREADS) { const int h = j / attn_body::TAB_N, d = j % attn_body::TAB_N - attn_body::TAB_PAD;
        tab[j] = (d >= 0 && d < 127) ? (bt[h * 128 + d] - bt[h * 128 + 127]) * 1.4426950408889634f : 0.f; }
}
constexpr int LDS_MISC_OFF = 147456 - 64;
DEV Params load_params(const __attribute__((address_space(4))) Params* pp) { Params q;
#pragma unroll
    for (int i = 0; i < 26; ++i) q.in[i] = pp->in[i];
    q.out = pp->out; q.ws = pp->ws; return q; }
#define KARGS() const __attribute__((address_space(4))) Params* pp_ = (const __attribute__((address_space(4))) Params*)__builtin_amdgcn_kernarg_segment_ptr(); asm volatile("" : "+s"(pp_)); const Params p = load_params(pp_)
__global__ void __launch_bounds__(NTHREADS, 2) mk_fwd(Params p_arg) {
    extern __shared__ __attribute__((aligned(16))) unsigned char lds_raw[];
    LAS unsigned char* lds = (LAS unsigned char*)lds_raw;
    volatile LAS unsigned* MISC = (volatile LAS unsigned*)(lds + LDS_MISC_OFF);
    const int wave_s = __builtin_amdgcn_readfirstlane((int)threadIdx.x >> 6);
    if (threadIdx.x < 16) MISC[threadIdx.x] = 0u;
    __syncthreads();
    { KARGS(); (void)xcd_barrier_post((unsigned*)(p.ws + WS_BAR), MISC + 8); }
#define IDS() KARGS(); const int wave = wave_s; const int lane = olane(); const int tid = wave * 64 + lane; const int gw = BIDX * NWAVES + wave, ngw = GDIM * NWAVES; (void)lane; (void)gw; (void)ngw; \
    bf16_t* wt = (bf16_t*)(p.ws + WS_WT); bf16_t* XN = (bf16_t*)(p.ws + WS_XN); bf16_t* P = (bf16_t*)(p.ws + WS_P); bf16_t* H = (bf16_t*)(p.ws + WS_H); (void)wt; (void)XN; (void)P; (void)H; \
    const float* modl = (const float*)(p.ws + WS_MOD) + (size_t)l * NB * MODW; const float* xin = (l == 0) ? p.in[I_X] : p.out; (void)modl; (void)xin;
#define GEMM(A_, lda_, W_, N_, K_, EPI, ...) do { pg8::Gemm g{A_, W_, M, N_, K_, lda_}; pg8::StaticOrder So; So.init(M, N_, (int)GDIM, (int)BIDX); pg8::EPI E{__VA_ARGS__}; \
        pg8::gemm_phase<pg8::EPI, pg8::StaticOrder, true, true>(lds, g, So, E, tid); } while (0)
#define SYNC() do { KARGS(); XcdBarrier bar_; bar_.bar = (unsigned*)(p.ws + WS_BAR); bar_.x = xb_xcc_id(); bar_.st = (volatile LAS unsigned*)(lds + LDS_MISC_OFF) + 8; bar_.lead = (wave_s == 0) && (olane() == 0); xcd_barrier(bar_); if (PROBE == 7) xcd_barrier(bar_); } while (0)
#ifndef PROBE
#define PROBE 0
#endif
#ifndef PROBE_SKIP
#define PROBE_SKIP 0
#endif
#pragma unroll 1
    for (int l = 0; l < NL; ++l) {
        { IDS(); ph_convert(p, l, lds, gw, ngw, wave, lane); if (l == 0) ph_mod(p, lds, tid, wave, lane); }
#if PROBE == 5
        { IDS(); __syncthreads(); ph_convert(p, l, lds, gw, ngw, wave, lane); }
#endif
        SYNC();
        { IDS(); ph_norm(xin, p.in[I_N1] + (size_t)l * D, modl, 0, 1, XN, gw, ngw, lane); }
#if PROBE == 4
        { IDS(); ph_norm(xin, p.in[I_N1] + (size_t)l * D, modl, 0, 1, XN, gw, ngw, lane); }
#endif
        SYNC();
        { IDS(); GEMM(XN, D, wt + WT_13A / 2, 2 * DFF, D, EpiSwigluT, H); }
#if PROBE == 1
        { IDS(); GEMM(XN, D, wt + WT_13A / 2, 2 * DFF, D, EpiSwigluT, H); }
#endif
        SYNC();
        { IDS(); GEMM(H, DFF, wt + WT_2A / 2, D, DFF, EpiResidT, xin, p.out, modl + 2 * D, 0.5f); }
        SYNC();
        { IDS(); ph_norm(p.out, p.in[I_NM] + (size_t)l * D, modl, 3, 4, XN, gw, ngw, lane); }
        SYNC();
        { IDS(); GEMM(XN, D, wt + WT_IN / 2, NIN, D, EpiInT, P, (float*)(p.ws + WS_DT), (bf16_t*)(p.ws + WS_HALO)); }
#if PROBE == 2
        { IDS(); GEMM(XN, D, wt + WT_IN / 2, NIN, D, EpiInT, P, (float*)(p.ws + WS_DT), (bf16_t*)(p.ws + WS_HALO)); }
#endif
        SYNC();
#if PROBE == 11
        { IDS(); ph_conv(p, l, tid, false); }
#endif
        { IDS(); ph_conv(p, l, tid); }
        SYNC();
        { IDS(); const int G = GDIM;
#pragma unroll 1
          for (int rep_ = (PROBE == 6 ? 0 : 1); rep_ < 2; ++rep_)
          for (int unit = BIDX; unit < GCH * 2; unit += G) { int u_ = unit; asm volatile("" : "+s"(u_)); int tid_ = tid; asm volatile("" : "+v"(tid_));
            attn_body::ssd_state_unit(u_ >> 1, u_ & 1, (const attn_body::bf16*)P, (float*)(p.ws + WS_ST), (float*)(p.ws + WS_CD), (const float*)(p.ws + WS_DT), p.in[I_DTB] + l * 16, p.in[I_ALOG] + l * 16, (char*)lds_raw, tid_); } }
        { IDS(); const int G = GDIM, bid = BIDX; const int vcu = (G % 8 == 0) ? (bid % 8) * (G / 8) + bid / 8 : bid;
#if PROBE == 8
          attn_body::sb_attn_phase((char*)lds_raw, (attn_body::bf16*)P, vcu, G, tid, false);
#endif
          attn_body::sb_attn_phase((char*)lds_raw, (attn_body::bf16*)P, vcu, G, tid); }
        { IDS(); __syncthreads(); ph_diff_table(p, lds, tid); __syncthreads(); const int G = GDIM, bid = BIDX; const int vcu = (G % 8 == 0) ? (bid % 8) * (G / 8) + bid / 8 : bid;
          attn_body::diff_attn_phase<8>((char*)lds_raw, (const attn_body::bf16*)P, (attn_body::bf16*)(p.ws + WS_OD), (const LAS float*)(lds + LDS_TAB_OFF), vcu, G, tid); }
#if PROBE == 3
        { IDS(); __syncthreads(); ph_diff_table(p, lds, tid); __syncthreads(); const int G = GDIM, bid = BIDX; const int vcu = (G % 8 == 0) ? (bid % 8) * (G / 8) + bid / 8 : bid;
          attn_body::diff_attn_phase<8>((char*)lds_raw, (const attn_body::bf16*)P, (attn_body::bf16*)(p.ws + WS_OD), (const LAS float*)(lds + LDS_TAB_OFF), vcu, G, tid); }
#endif
        SYNC();
#if PROBE == 10
        { IDS(); ph_ssd_scan(p, tid, false); }
#endif
        { IDS(); ph_ssd_scan(p, tid); }
        SYNC();
        { IDS(); const int G = GDIM;
#pragma unroll 1
          for (int rep_ = (PROBE == 9 ? 0 : 1); rep_ < 2; ++rep_)
          for (int unit = BIDX; unit < GCH * 2; unit += G) { int u_ = unit; asm volatile("" : "+s"(u_)); int tid_ = tid; asm volatile("" : "+v"(tid_));
            attn_body::ssd_out_unit(u_ >> 1, u_ & 1, (attn_body::bf16*)P, (const float*)(p.ws + WS_ST), (const float*)(p.ws + WS_DT), p.in[I_DTB] + l * 16, p.in[I_ALOG] + l * 16, p.in[I_SD] + l * 16, (char*)lds_raw, tid_, rep_ == 1, rep_ == 1 ? 0 : PROBE_SKIP); } }
        SYNC();
        { IDS(); ph_mixfinal(p, l, gw, ngw, lane); ph_diff_combine(p, l, gw, ngw, lane); }
        SYNC();
        { IDS(); GEMM(P, PW, wt + WT_OUT / 2, D, 2048, EpiResidT, p.out, p.out, modl + 5 * D, 1.0f); }
        SYNC();
        { IDS(); ph_norm(p.out, p.in[I_N2] + (size_t)l * D, modl, 6, 7, XN, gw, ngw, lane); }
        SYNC();
        { IDS(); GEMM(XN, D, wt + WT_13B / 2, 2 * DFF, D, EpiSwigluT, H); }
        SYNC();
        { IDS(); GEMM(H, DFF, wt + WT_2B / 2, D, DFF, EpiResidT, p.out, p.out, modl + 8 * D, 0.5f); }
        SYNC();
    }
    { const int l = 0; IDS(); ph_final_norm(p.out, p.in[I_FN], gw, ngw, lane); }
}

constexpr int LDS_BYTES = 147456;
extern "C" void kernel_launch(void* const* d_in, const int* in_sizes, int n_in, void* d_out, int out_size, void* d_ws, size_t ws_size, hipStream_t stream) {
    static int grid = 0;
    if (grid == 0) {
        if (n_in != 26 || out_size != M * D || ws_size < WS_END) { fprintf(stderr, "kernel_launch: unexpected shapes (n_in %d out %d ws %zu)\n", n_in, out_size, ws_size); grid = -1; return; }
        int dev = 0, cus = 0;
        if (hipGetDevice(&dev) != hipSuccess || hipDeviceGetAttribute(&cus, hipDeviceAttributeMultiprocessorCount, dev) != hipSuccess) { grid = -1; return; }
        if (hipFuncSetAttribute((const void*)mk_fwd, hipFuncAttributeMaxDynamicSharedMemorySize, LDS_BYTES) != hipSuccess) { grid = -1; return; }
        grid = cus;
    }
    if (grid < 0) return;
    Params p{};
    for (int i = 0; i < 26; ++i) p.in[i] = (const float*)d_in[i];
    p.out = (float*)d_out; p.ws = (unsigned char*)d_ws;
    (void)hipMemsetAsync((char*)d_ws + WS_BAR, 0, 64 * KiB, stream);
    hipLaunchKernelGGL(mk_fwd, dim3(grid), dim3(NTHREADS), LDS_BYTES, stream, p);

}
```
